# Optimizing an MI355X kernel written in HIP

```python
import math, functools
import jax, jax.numpy as jnp
from jax import lax
import numpy as np

D_MODEL = 1024
BATCH = 8
SEQ = 2048
DEPTH = 4

CHUNK = 64
N_MIXERS = 2
N_MLSTM_LAYERS = (DEPTH + 1) // 2
N_CONV_LAYERS = DEPTH // 2

M_HEADS = 4
M_DK = 128
M_DV = 256
M_QK = M_HEADS * M_DK
M_V = M_HEADS * M_DV
M_PROJ = 2 * M_QK + 2 * M_V + 2 * M_HEADS

CONV_K = 3

N_GROUPS = 4
E_PER_GROUP = 8
N_EXPERTS = N_GROUPS * E_PER_GROUP
TOP_K = 2
D_FF = 512
ROW_BLOCK = 128

EPS = 1e-6

kernel_name = "hybrid_mlstm_shortconv_hmoe_adaln"


def rmsnorm(x, g):
    xf = x.astype(jnp.float32)
    y = xf * lax.rsqrt(jnp.mean(xf * xf, axis=-1, keepdims=True) + EPS)
    return (y * g.astype(jnp.float32)).astype(x.dtype)


def adaln(c, w_ada, b_ada):
    mod = jax.nn.silu(c) @ w_ada + b_ada
    shift, scale, gate = jnp.split(mod, 3, axis=-1)
    return shift[:, None, :], scale[:, None, :], gate[:, None, :]


def mlstm_mixer(h, w_in, b_gates, norm_g, w_out):
    B, S, _ = h.shape
    nc = S // CHUNK
    proj = h @ w_in
    q, k, v, o, ig, fg = jnp.split(
        proj, [M_QK, 2 * M_QK, 2 * M_QK + M_V, 2 * M_QK + 2 * M_V,
               2 * M_QK + 2 * M_V + M_HEADS], axis=-1)
    f32 = jnp.float32

    def heads_to_chunks(t, d):
        return t.astype(f32).reshape(B, nc, CHUNK, M_HEADS, d).transpose(1, 0, 3, 2, 4)

    def gates_to_chunks(t):
        return t.reshape(B, nc, CHUNK, M_HEADS).transpose(1, 0, 3, 2)

    qc = heads_to_chunks(q, M_DK) * (M_DK ** -0.5)
    kc = heads_to_chunks(k, M_DK)
    vc = heads_to_chunks(v, M_DV)
    b_g = b_gates.astype(f32)
    i_pre = gates_to_chunks(ig.astype(f32) + b_g[:M_HEADS])
    log_f = gates_to_chunks(jax.nn.log_sigmoid(fg.astype(f32) + b_g[M_HEADS:]))
    causal = jnp.tril(jnp.ones((CHUNK, CHUNK), dtype=bool))

    def step(carry, xs):
        C, n, m = carry
        q_, k_, v_, i_, lf_ = xs
        bcum = jnp.cumsum(lf_, axis=-1)
        dlog = bcum[..., :, None] - bcum[..., None, :] + i_[..., None, :]
        dlog = jnp.where(causal, dlog, -jnp.inf)
        inter_log = bcum + m[..., None]
        m_t = jnp.maximum(inter_log, jnp.max(dlog, axis=-1))
        w_intra = jnp.exp(dlog - m_t[..., None])
        w_inter = jnp.exp(inter_log - m_t)
        scores = jnp.einsum('bhtd,bhsd->bhts', q_, k_) * w_intra
        num = (jnp.einsum('bhts,bhsv->bhtv', scores, v_)
               + w_inter[..., None] * jnp.einsum('bhvd,bhtd->bhtv', C, q_))
        den = scores.sum(-1) + w_inter * jnp.einsum('bhd,bhtd->bht', n, q_)
        h_out = num / jnp.maximum(jnp.abs(den), jnp.exp(-m_t))[..., None]
        b_last = bcum[..., -1]
        log_src = b_last[..., None] - bcum + i_
        m_new = jnp.maximum(b_last + m, jnp.max(log_src, axis=-1))
        w_src = jnp.exp(log_src - m_new[..., None])
        decay = jnp.exp(b_last + m - m_new)
        C_new = decay[..., None, None] * C + jnp.einsum('bhsv,bhsd->bhvd', v_ * w_src[..., None], k_)
        n_new = decay[..., None] * n + jnp.einsum('bhs,bhsd->bhd', w_src, k_)
        return (C_new, n_new, m_new), h_out

    init = (jnp.zeros((B, M_HEADS, M_DV, M_DK), f32),
            jnp.zeros((B, M_HEADS, M_DK), f32),
            jnp.zeros((B, M_HEADS), f32))
    _, hc = lax.scan(step, init, (qc, kc, vc, i_pre, log_f))
    hs = hc.transpose(1, 0, 3, 2, 4).reshape(B, S, M_HEADS, M_DV)
    hs = hs * lax.rsqrt(jnp.mean(hs * hs, axis=-1, keepdims=True) + EPS)
    hs = hs.reshape(B, S, M_V) * norm_g.astype(f32) * jax.nn.sigmoid(o.astype(f32))
    return hs.astype(h.dtype) @ w_out


def short_conv_mixer(h, w_in, conv_w, w_out):
    b_gate, c_gate, xb = jnp.split(h @ w_in, 3, axis=-1)
    u = c_gate * xb
    y = lax.conv_general_dilated(
        u, conv_w[:, None, :].astype(u.dtype), window_strides=(1,),
        padding=[(CONV_K - 1, 0)], dimension_numbers=('NWC', 'WIO', 'NWC'),
        feature_group_count=D_MODEL)
    return (b_gate * y) @ w_out


def hier_moe(h, w_group, b_group, w_expert, b_expert, w_gate, w_up, w_down):
    B, S, D = h.shape
    N = B * S
    xt = h.reshape(N, D)
    f32 = jnp.float32
    g_logits = (xt @ w_group).astype(f32) + b_group.astype(f32)
    g_prob = jax.nn.softmax(g_logits, axis=-1)
    g_sel = jnp.argmax(g_logits, axis=-1).astype(jnp.int32)
    p_sel = jnp.take_along_axis(g_prob, g_sel[:, None], axis=-1)[:, 0]
    e_logits = ((xt @ w_expert).astype(f32) + b_expert.astype(f32)).reshape(N, N_GROUPS, E_PER_GROUP)
    e_sel = jnp.take_along_axis(e_logits, g_sel[:, None, None], axis=1)[:, 0]
    top_l, top_i = lax.top_k(e_sel, TOP_K)
    combine = jax.nn.softmax(top_l, axis=-1) * p_sel[:, None]
    eid = g_sel[:, None] * E_PER_GROUP + top_i.astype(jnp.int32)

    A = N * TOP_K
    flat_e = eid.reshape(A)
    flat_w = combine.reshape(A)
    flat_tok = jnp.repeat(jnp.arange(N, dtype=jnp.int32), TOP_K)
    order = jnp.argsort(flat_e)
    se, stok, sw = flat_e[order], flat_tok[order], flat_w[order]
    counts = jax.ops.segment_sum(jnp.ones((A,), jnp.int32), flat_e, num_segments=N_EXPERTS)
    starts = jnp.cumsum(counts) - counts
    pcounts = (counts + ROW_BLOCK - 1) // ROW_BLOCK * ROW_BLOCK
    pends = jnp.cumsum(pcounts)
    pstarts = pends - pcounts
    dest = pstarts[se] + (jnp.arange(A, dtype=jnp.int32) - starts[se])
    n_blocks = (A + N_EXPERTS * (ROW_BLOCK - 1) + ROW_BLOCK - 1) // ROW_BLOCK
    P = n_blocks * ROW_BLOCK
    row_tok = jnp.zeros((P,), jnp.int32).at[dest].set(stok)
    row_w = jnp.zeros((P,), f32).at[dest].set(sw)
    blk_e = jnp.clip(jnp.searchsorted(pends, jnp.arange(n_blocks, dtype=jnp.int32) * ROW_BLOCK,
                                      side='right'), 0, N_EXPERTS - 1).astype(jnp.int32)
    xr = xt[row_tok].reshape(n_blocks, ROW_BLOCK, D)

    def expert_block(args):
        xb, e = args
        return (jax.nn.silu(xb @ w_gate[e]) * (xb @ w_up[e])) @ w_down[e]

    yr = lax.map(expert_block, (xr, blk_e)).reshape(P, D)
    out = jax.ops.segment_sum(yr.astype(f32) * row_w[:, None], row_tok, num_segments=N)
    return out.astype(h.dtype).reshape(B, S, D)


def setup_inputs(seed: int = 0) -> dict:
    key = jax.random.key(seed)
    ks = jax.random.split(key, 24)
    f32 = jnp.float32

    def nrm(k, shape, fan_in, mult=1.0):
        return jax.random.normal(k, shape, f32) * (mult * fan_in ** -0.5)

    D = D_MODEL
    x = jax.random.normal(ks[0], (BATCH, SEQ, D), f32)
    c = jax.random.normal(ks[1], (BATCH, D), f32)
    ada_w = nrm(ks[2], (DEPTH, 2, D, 3 * D), D, 0.5)
    ada_b = 0.02 * jax.random.normal(ks[3], (DEPTH, 2, 3 * D), f32)
    norm_g = 1.0 + 0.02 * jax.random.normal(ks[4], (DEPTH, 2, D), f32)
    final_g = 1.0 + 0.02 * jax.random.normal(ks[5], (D,), f32)
    m_w_in = nrm(ks[6], (N_MLSTM_LAYERS, D, M_PROJ), D)
    m_b_gates = jnp.concatenate([
        0.1 * jax.random.normal(ks[7], (N_MLSTM_LAYERS, M_HEADS), f32),
        3.0 + 0.1 * jax.random.normal(ks[8], (N_MLSTM_LAYERS, M_HEADS), f32)], axis=-1)
    m_norm_g = 1.0 + 0.02 * jax.random.normal(ks[9], (N_MLSTM_LAYERS, M_V), f32)
    m_w_out = nrm(ks[10], (N_MLSTM_LAYERS, M_V, D), M_V)
    s_w_in = nrm(ks[11], (N_CONV_LAYERS, D, 3 * D), D)
    s_conv_w = nrm(ks[12], (N_CONV_LAYERS, CONV_K, D), CONV_K)
    s_w_out = nrm(ks[13], (N_CONV_LAYERS, D, D), D)
    r_w_group = nrm(ks[14], (DEPTH, D, N_GROUPS), D)
    r_b_group = 0.01 * jax.random.normal(ks[15], (DEPTH, N_GROUPS), f32)
    r_w_expert = nrm(ks[16], (DEPTH, D, N_EXPERTS), D)
    r_b_expert = 0.01 * jax.random.normal(ks[17], (DEPTH, N_EXPERTS), f32)
    e_w_gate = nrm(ks[18], (DEPTH, N_EXPERTS, D, D_FF), D)
    e_w_up = nrm(ks[19], (DEPTH, N_EXPERTS, D, D_FF), D)
    e_w_down = nrm(ks[20], (DEPTH, N_EXPERTS, D_FF, D), D_FF)
    return {"x": x, "c": c, "ada_w": ada_w, "ada_b": ada_b, "norm_g": norm_g,
            "final_g": final_g, "m_w_in": m_w_in, "m_b_gates": m_b_gates,
            "m_norm_g": m_norm_g, "m_w_out": m_w_out, "s_w_in": s_w_in,
            "s_conv_w": s_conv_w, "s_w_out": s_w_out, "r_w_group": r_w_group,
            "r_b_group": r_b_group, "r_w_expert": r_w_expert, "r_b_expert": r_b_expert,
            "e_w_gate": e_w_gate, "e_w_up": e_w_up, "e_w_down": e_w_down}


def reference(x, c, ada_w, ada_b, norm_g, final_g, m_w_in, m_b_gates, m_norm_g,
              m_w_out, s_w_in, s_conv_w, s_w_out, r_w_group, r_b_group,
              r_w_expert, r_b_expert, e_w_gate, e_w_up, e_w_down):
    for i in range(DEPTH):
        shift, scale, gate = adaln(c, ada_w[i, 0], ada_b[i, 0])
        h = rmsnorm(x, norm_g[i, 0]) * (1.0 + scale) + shift
        j = i // N_MIXERS
        if i % N_MIXERS == 0:
            y = mlstm_mixer(h, m_w_in[j], m_b_gates[j], m_norm_g[j], m_w_out[j])
        else:
            y = short_conv_mixer(h, s_w_in[j], s_conv_w[j], s_w_out[j])
        x = x + gate * y
        shift, scale, gate = adaln(c, ada_w[i, 1], ada_b[i, 1])
        h = rmsnorm(x, norm_g[i, 1]) * (1.0 + scale) + shift
        y = hier_moe(h, r_w_group[i], r_b_group[i], r_w_expert[i], r_b_expert[i],
                     e_w_gate[i], e_w_up[i], e_w_down[i])
        x = x + gate * y
    return rmsnorm(x, final_g)
```

```cpp
#include <hip/hip_runtime.h>
#include <cstdio>
#include <cstdint>

#ifndef SCAN_MFMA
#define SCAN_MFMA 1
#endif
#ifndef N_LAUNCH_SPLIT
#define N_LAUNCH_SPLIT 0
#endif

namespace pg8 {
#define PG8_LAS __attribute__((address_space(3)))
typedef unsigned short bf16_t;
typedef short bf16x8 __attribute__((ext_vector_type(8)));
typedef float f32x4 __attribute__((ext_vector_type(4)));
typedef unsigned u32x4 __attribute__((ext_vector_type(4)));
constexpr int BM = 256, BK = 64, HALF = 128, HTB = HALF * BK * 2, STAGE_BYTES = 8 * HTB, NXCD = 8, WGM = 8;

__host__ __device__ __forceinline__ int lds_byte(int r, int c) { const int st = (r >> 4) * 2 + (c >> 5), rr = r & 15, cc = c & 31, ob = rr * 64 + cc * 2; return st * 1024 + (ob ^ (((ob >> 9) & 1) << 5)); }
__host__ __device__ __forceinline__ void stage_rc(int b, int& R, int& C) { const int st = b / 1024, sb = b % 1024, swz = sb ^ (((sb >> 9) & 1) << 5); R = (st >> 1) * 16 + swz / 64; C = (st & 1) * 32 + (swz % 64) / 2; }
__host__ __device__ __forceinline__ int perm32(int rho) { const int n = rho >> 4, i = rho & 15; return 8 * (i >> 2) + 4 * n + (i & 3); }

__device__ __forceinline__ int opaque_v(int x) { asm volatile("" : "+v"(x)); return x; }
__device__ __forceinline__ int opaque_s(int x) { asm volatile("" : "+s"(x)); return x; }
struct Unit { int pm, pn, e, r0, half; };

struct TileOrder {
    int nM, nN, nwg, G, c, wgm;
    __device__ __forceinline__ void init(int nM_, int nN_, int G_, int c_, int wgm_ = WGM) { nM = nM_; nN = nN_; nwg = nM * nN; G = G_; c = c_; wgm = wgm_; }
    __device__ __forceinline__ bool map(int i, int& pm, int& pn) const {
        const long L = (long)i * G + c; if (L >= nwg) return false;
        int wgid = (int)L; { const int q = nwg / NXCD, r = nwg % NXCD, xcd = wgid % NXCD, off = wgid / NXCD; wgid = (xcd < r ? xcd * (q + 1) : r * (q + 1) + (xcd - r) * q) + off; }
        const int nig = wgm * nN, gid = wgid / nig, fm = gid * wgm, gsz = (nM - fm) < wgm ? (nM - fm) : wgm;
        pm = fm + ((wgid % nig) % gsz); pn = (wgid % nig) / gsz; return true;
    }
};
struct DenseSched {
    static constexpr bool GATHER = false;
    TileOrder T; const char* A; const char* Bt; int K;
    __device__ __forceinline__ bool next(int i, Unit& u) const { u.e = 0; u.r0 = 0; u.half = 0; return T.map(i, u.pm, u.pn); }
    __device__ __forceinline__ const char* a_base(const Unit& u) const { return A + (size_t)u.pm * 256 * K * 2; }
    __device__ __forceinline__ const char* b_base(const Unit& u) const { return Bt + (size_t)u.pn * 256 * K * 2; }
    __device__ __forceinline__ void a_voff(const Unit&, int tid, unsigned (&v)[2][2]) const {
#pragma unroll
        for (int i = 0; i < 2; ++i) { int R, C; stage_rc(tid * 16 + i * 8192, R, C); v[0][i] = (unsigned)(R * K + C) * 2u; v[1][i] = v[0][i]; }
    }
};
struct GuSched {
    static constexpr bool GATHER = true;
    TileOrder T; const char* A; const char* Bt; const int* slot_tok; const PG8_LAS int* toff; const PG8_LAS int* cnt; const PG8_LAS int* soff; const PG8_LAS int* sexp; int K;
    __device__ __forceinline__ bool next(int i, Unit& u) const {
        if (T.map(i, u.pm, u.pn)) {
            int e = 0;
#pragma unroll
            for (int j = 1; j < 32; ++j) e += (toff[j] <= u.pm) ? 1 : 0;
            u.e = e; u.r0 = (u.pm - toff[e]) * 256; u.half = 0; return true;
        }
        const long sidx = (long)i * T.G + T.c - T.nwg; if (sidx >= 4 * soff[32]) return false;
        const int t = (int)sidx >> 2; u.pn = (int)sidx & 3; u.pm = toff[32] + t; u.e = sexp[t]; u.r0 = (toff[u.e + 1] - toff[u.e]) * 256; u.half = 1; return true;
    }
    __device__ __forceinline__ const char* a_base(const Unit&) const { return A; }
    __device__ __forceinline__ const char* b_base(const Unit& u) const { return Bt + ((size_t)u.e * 1024 + (size_t)u.pn * 256) * K * 2; }
    __device__ __forceinline__ void a_voff(const Unit& u, int tid, unsigned (&v)[2][2]) const {
        const int c1 = cnt[u.e] - 1;
#pragma unroll
        for (int h = 0; h < 2; ++h)
#pragma unroll
            for (int i = 0; i < 2; ++i) { int R, C; stage_rc(tid * 16 + i * 8192, R, C); int idx = u.r0 + h * 128 + R; idx = idx < c1 ? idx : c1;
                const int tok = slot_tok[u.e * 16384 + idx]; v[h][i] = (unsigned)(tok * K + C) * 2u; }
    }
};
struct DnSched {
    static constexpr bool GATHER = false;
    TileOrder T; const char* A; const char* Bt; const PG8_LAS int* toff; const PG8_LAS int* soff; const PG8_LAS int* sexp; int K;
    __device__ __forceinline__ bool next(int i, Unit& u) const {
        u.r0 = 0;
        if (T.map(i, u.pm, u.pn)) {
            int e = 0;
#pragma unroll
            for (int j = 1; j < 32; ++j) e += (toff[j] <= u.pm) ? 1 : 0;
            u.e = e; u.half = 0; return true;
        }
        const long sidx = (long)i * T.G + T.c - T.nwg; if (sidx >= 4 * soff[32]) return false;
        const int t = (int)sidx >> 2; u.pn = (int)sidx & 3; u.pm = toff[32] + t; u.e = sexp[t]; u.half = 1; return true;
    }
    __device__ __forceinline__ const char* a_base(const Unit& u) const { return A + (size_t)u.pm * 256 * K * 2; }
    __device__ __forceinline__ const char* b_base(const Unit& u) const { return Bt + ((size_t)u.e * 1024 + (size_t)u.pn * 256) * K * 2; }
    __device__ __forceinline__ void a_voff(const Unit&, int tid, unsigned (&v)[2][2]) const {
#pragma unroll
        for (int i = 0; i < 2; ++i) { int R, C; stage_rc(tid * 16 + i * 8192, R, C); v[0][i] = (unsigned)(R * K + C) * 2u; v[1][i] = v[0][i]; }
    }
};

typedef __bf16 bf16x2_t __attribute__((ext_vector_type(2)));
__device__ __forceinline__ unsigned cvt_pk_bf16(float lo, float hi) { bf16x2_t v; v[0] = (__bf16)lo; v[1] = (__bf16)hi; return __builtin_bit_cast(unsigned, v); }
__device__ __forceinline__ u32x4 pack8(const f32x4 a, const f32x4 b) { u32x4 w; w.x = cvt_pk_bf16(a[0], a[1]); w.y = cvt_pk_bf16(a[2], a[3]); w.z = cvt_pk_bf16(b[0], b[1]); w.w = cvt_pk_bf16(b[2], b[3]); return w; }

struct EpiStoreBf16 {
    static constexpr bool PERM = true;
    bf16_t* O; int ldc; float sc;
    __device__ __forceinline__ void operator()(const f32x4 (&acc)[2][2][4][2], const Unit& u, int wr, int wc, int fr, int fq) const {
        const int row0 = u.pm * BM + wr * 64 + fr, col0 = u.pn * BM + wc * 32 + 8 * fq;
#pragma unroll
        for (int ai = 0; ai < 2; ++ai) { if (ai == 1 && u.half) break;
#pragma unroll
            for (int m = 0; m < 4; ++m) { bf16_t* rowp = O + (size_t)(row0 + ai * HALF + m * 16) * ldc + col0;
#pragma unroll
                for (int bj = 0; bj < 2; ++bj) *(u32x4*)(rowp + bj * HALF) = pack8(acc[ai][bj][m][0] * sc, acc[ai][bj][m][1] * sc); } }
    }
};
struct EpiConvIn {
    static constexpr bool PERM = true;
    bf16_t* O; int ldc;
    __device__ __forceinline__ void operator()(const f32x4 (&acc)[2][2][4][2], const Unit& u, int wr, int wc, int fr, int fq) const {
        const int row0 = u.pm * BM + wr * 64 + fr;
        if (u.pn < 8) {
            const int col0 = u.pn * HALF + wc * 32 + 8 * fq;
#pragma unroll
            for (int ai = 0; ai < 2; ++ai)
#pragma unroll
                for (int m = 0; m < 4; ++m) { bf16_t* rowp = O + (size_t)(row0 + ai * HALF + m * 16) * ldc + col0;
                    *(u32x4*)rowp = pack8(acc[ai][0][m][0] * acc[ai][1][m][0], acc[ai][0][m][1] * acc[ai][1][m][1]); }
        } else {
            const int col0 = 1024 + (u.pn - 8) * BM + wc * 32 + 8 * fq;
#pragma unroll
            for (int ai = 0; ai < 2; ++ai)
#pragma unroll
                for (int m = 0; m < 4; ++m) { bf16_t* rowp = O + (size_t)(row0 + ai * HALF + m * 16) * ldc + col0;
#pragma unroll
                    for (int bj = 0; bj < 2; ++bj) *(u32x4*)(rowp + bj * HALF) = pack8(acc[ai][bj][m][0], acc[ai][bj][m][1]); }
        }
    }
};
__device__ __forceinline__ float silu_f(float g) { return g * __builtin_amdgcn_rcpf(1.0f + __expf(-g)); }
__device__ __forceinline__ unsigned pk4_fp8(float a, float b, float c, float d) { unsigned w = 0; w = __builtin_amdgcn_cvt_pk_fp8_f32(a, b, w, false); w = __builtin_amdgcn_cvt_pk_fp8_f32(c, d, w, true); return w; }
constexpr float W8_INV = 1.0f / 32.0f;
struct EpiGateUp {
    static constexpr bool PERM = true;
    unsigned char* O;
    __device__ __forceinline__ void operator()(const f32x4 (&acc)[2][2][4][2], const Unit& u, int wr, int wc, int fr, int fq) const {
        const int row0 = u.pm * BM + wr * 64 + fr, col0 = u.pn * HALF + wc * 32 + 8 * fq;
        typedef unsigned u32x2 __attribute__((ext_vector_type(2)));
#pragma unroll
        for (int ai = 0; ai < 2; ++ai) { if (ai == 1 && u.half) break;
#pragma unroll
            for (int m = 0; m < 4; ++m) { unsigned char* rowp = O + (size_t)(row0 + ai * HALF + m * 16) * 512 + col0;
                f32x4 h0, h1;
#pragma unroll
                for (int j = 0; j < 4; ++j) { h0[j] = silu_f(acc[ai][0][m][0][j] * W8_INV) * (acc[ai][1][m][0][j] * W8_INV); h1[j] = silu_f(acc[ai][0][m][1][j] * W8_INV) * (acc[ai][1][m][1][j] * W8_INV); }
                u32x2 w; w.x = pk4_fp8(h0[0], h0[1], h0[2], h0[3]); w.y = pk4_fp8(h1[0], h1[1], h1[2], h1[3]); *(u32x2*)rowp = w; } }
    }
};
struct EpiResid {
    static constexpr bool PERM = true;
    const float* xin32; bf16_t* xs; const float* gatev;
    __device__ __forceinline__ void operator()(const f32x4 (&acc)[2][2][4][2], const Unit& u, int wr, int wc, int fr, int fq) const {
        const int row0 = u.pm * BM + wr * 64 + fr, col0 = u.pn * BM + wc * 32 + 8 * fq, b = u.pm >> 3;
        f32x4 gv[2][2];
#pragma unroll
        for (int bj = 0; bj < 2; ++bj)
#pragma unroll
            for (int n = 0; n < 2; ++n) gv[bj][n] = *(const f32x4*)(gatev + b * 3072 + col0 + bj * HALF + n * 4);
#pragma unroll
        for (int ai = 0; ai < 2; ++ai)
#pragma unroll
            for (int m = 0; m < 4; ++m) { const size_t off = (size_t)(row0 + ai * HALF + m * 16) * 1024 + col0;
#pragma unroll
                for (int bj = 0; bj < 2; ++bj) {
                    f32x4 x0, x1;
                    if (xin32) { x0 = *(const f32x4*)(xin32 + off + bj * HALF); x1 = *(const f32x4*)(xin32 + off + bj * HALF + 4); }
                    else { const u32x4 w = *(const u32x4*)(xs + off + bj * HALF);
                        x0 = (f32x4){__builtin_bit_cast(float, w.x << 16), __builtin_bit_cast(float, w.x & 0xffff0000u), __builtin_bit_cast(float, w.y << 16), __builtin_bit_cast(float, w.y & 0xffff0000u)};
                        x1 = (f32x4){__builtin_bit_cast(float, w.z << 16), __builtin_bit_cast(float, w.z & 0xffff0000u), __builtin_bit_cast(float, w.w << 16), __builtin_bit_cast(float, w.w & 0xffff0000u)}; }
                    *(u32x4*)(xs + off + bj * HALF) = pack8(x0 + gv[bj][0] * acc[ai][bj][m][0], x1 + gv[bj][1] * acc[ai][bj][m][1]); } }
    }
};

typedef int i32x8 __attribute__((ext_vector_type(8)));
template <class Epi, class Sched, bool ALIGN_EPI, bool FP8 = false>
__device__ __forceinline__ void gemm_phase(PG8_LAS unsigned char* lds, const int K, const Sched& S, const Epi& E) {
    constexpr bool GATHER = Sched::GATHER;
    const int tid = opaque_v((int)threadIdx.x), wid = __builtin_amdgcn_readfirstlane(tid >> 6), lane = tid & 63, wr = wid >> 2, wc = wid & 3, fr = lane & 15, fq = lane >> 4;
    const int nt = opaque_s(K / BK);
    unsigned voffB[2];
#pragma unroll
    for (int i = 0; i < 2; ++i) { int R, C; stage_rc(tid * 16 + i * 8192, R, C); const int Rb = Epi::PERM ? ((R & ~31) + perm32(R & 31)) : R; voffB[i] = (unsigned)(Rb * K + C) * 2u; }
    const size_t kstep = (size_t)(BK * 2);
    const size_t hstepB = (size_t)HALF * K * 2;
    const size_t hstepA = GATHER ? (size_t)0 : hstepB;
    const unsigned ldsw = (unsigned)wid * 1024u;
    const int aoff = lds_byte(wr * 64 + fr, fq * 8), boff = lds_byte(wc * 32 + fr, fq * 8);
#define PG8_SA(b, h) (((b) * 2 + (h)) * HTB)
#define PG8_SB(b, h) ((4 + (b) * 2 + (h)) * HTB)
#define PG8_STAGE(bufoff, gbase, voff) do { _Pragma("unroll") for (int _i = 0; _i < 2; ++_i) \
        __builtin_amdgcn_global_load_lds((const unsigned*)((const char*)(gbase) + (voff)[_i]), (PG8_LAS unsigned*)(lds + (bufoff) + ldsw + _i * 8192), 16, 0, 0); } while (0)
#define PG8_LDA(dst, b, h) do { _Pragma("unroll") for (int m = 0; m < 4; ++m) _Pragma("unroll") for (int k = 0; k < 2; ++k) dst[m][k] = *(const PG8_LAS bf16x8*)(lds + PG8_SA(b, h) + aoff + m * 2048 + k * 1024); } while (0)
#define PG8_LDB(dst, b, h) do { _Pragma("unroll") for (int n = 0; n < 2; ++n) _Pragma("unroll") for (int k = 0; k < 2; ++k) dst[n][k] = *(const PG8_LAS bf16x8*)(lds + PG8_SB(b, h) + boff + n * 2048 + k * 1024); } while (0)
#define PG8_MMA16(ai, bj, At, Bt) do { __builtin_amdgcn_s_setprio(1); _Pragma("unroll") for (int m = 0; m < 4; ++m) _Pragma("unroll") for (int n = 0; n < 2; ++n) _Pragma("unroll") for (int k = 0; k < 2; ++k) \
        acc[ai][bj][m][n] = __builtin_amdgcn_mfma_f32_16x16x32_bf16(Bt[n][k], At[m][k], acc[ai][bj][m][n], 0, 0, 0); __builtin_amdgcn_s_setprio(0); } while (0)
#define PG8_LDA8(dst, b, h) do { _Pragma("unroll") for (int m = 0; m < 4; ++m) { const u32x4 _lo = *(const PG8_LAS u32x4*)(lds + PG8_SA(b, h) + aoff + m * 2048), _hi = *(const PG8_LAS u32x4*)(lds + PG8_SA(b, h) + aoff + m * 2048 + 1024); \
        dst[m] = __builtin_bit_cast(i32x8, __builtin_shufflevector(_lo, _hi, 0, 1, 2, 3, 4, 5, 6, 7)); } } while (0)
#define PG8_LDB8(dst, b, h) do { _Pragma("unroll") for (int n = 0; n < 2; ++n) { const u32x4 _lo = *(const PG8_LAS u32x4*)(lds + PG8_SB(b, h) + boff + n * 2048), _hi = *(const PG8_LAS u32x4*)(lds + PG8_SB(b, h) + boff + n * 2048 + 1024); \
        dst[n] = __builtin_bit_cast(i32x8, __builtin_shufflevector(_lo, _hi, 0, 1, 2, 3, 4, 5, 6, 7)); } } while (0)
#define PG8_MMA8(ai, bj, At, Bt) do { __builtin_amdgcn_s_setprio(1); asm volatile("s_nop 4"); _Pragma("unroll") for (int m = 0; m < 4; ++m) _Pragma("unroll") for (int n = 0; n < 2; ++n) \
        asm volatile("v_mfma_scale_f32_16x16x128_f8f6f4 %0, %1, %2, %0, %3, %3 op_sel_hi:[0,0,0]" : "+v"(acc[ai][bj][m][n]) : "v"(Bt[n]), "v"(At[m]), "v"(scale1)); __builtin_amdgcn_s_setprio(0); } while (0)
#define PG8_XLDA(b, h) do { if constexpr (FP8) PG8_LDA8(At8, b, h); else PG8_LDA(At, b, h); } while (0)
#define PG8_XLDB(w, b, h) do { if constexpr (FP8) PG8_LDB8(B##w##8, b, h); else PG8_LDB(B##w, b, h); } while (0)
#define PG8_XMMA(ai, bj, w) do { if constexpr (FP8) PG8_MMA8(ai, bj, At8, B##w##8); else PG8_MMA16(ai, bj, At, B##w); } while (0)
#define PG8_WAIT_V(n) asm volatile("s_waitcnt vmcnt(" #n ")" ::: "memory")
#define PG8_WAIT_L(n) asm volatile("s_waitcnt lgkmcnt(" #n ")" ::: "memory")
#define PG8_BAR __builtin_amdgcn_s_barrier()
#define PG8_SCHED __builtin_amdgcn_sched_barrier(0)
    Unit cur, nxt; int ui = 0;
    if (!S.next(0, cur)) return;
    f32x4 acc[2][2][4][2];
#pragma unroll
    for (int a = 0; a < 2; ++a)
#pragma unroll
        for (int b = 0; b < 2; ++b)
#pragma unroll
            for (int m = 0; m < 4; ++m)
#pragma unroll
                for (int n = 0; n < 2; ++n) acc[a][b][m][n] = (f32x4){0.f, 0.f, 0.f, 0.f};
    bf16x8 At[4][2], B0[2][2], B1[2][2]; i32x8 At8[4], B08[2], B18[2]; int scale1 = 0x7F7F7F7F; asm volatile("" : "+v"(scale1));
    const char* cA = S.a_base(cur); const char* cB = S.b_base(cur);
    unsigned vc[2][2], vn[2][2];
    S.a_voff(cur, tid, vc);
    PG8_STAGE(PG8_SB(0, 0), cB, voffB); PG8_STAGE(PG8_SB(0, 1), cB + hstepB, voffB); PG8_STAGE(PG8_SA(0, 0), cA, vc[0]); PG8_STAGE(PG8_SA(0, 1), cA + hstepA, vc[1]);
    if (wr == 1) PG8_BAR;
    PG8_WAIT_V(2); PG8_BAR;
    PG8_STAGE(PG8_SB(1, 0), cB + kstep, voffB); PG8_STAGE(PG8_SA(1, 0), cA + kstep, vc[0]); PG8_STAGE(PG8_SB(1, 1), cB + hstepB + kstep, voffB);
    PG8_WAIT_V(6); PG8_BAR;
    for (;;) {
        const bool has_next = S.next(ui + 1, nxt);
        const char* nA = has_next ? S.a_base(nxt) : cA; const char* nB = has_next ? S.b_base(nxt) : cB;
        if (GATHER && has_next) { S.a_voff(nxt, tid, vn); *(PG8_LAS u32x4*)(lds + STAGE_BYTES + tid * 16) = (u32x4){vn[0][0], vn[0][1], vn[1][0], vn[1][1]}; }
#pragma unroll 1
        for (int t = 0; t < nt; t += 2) {
            const bool last = (t == nt - 2);
            const char* a1 = cA + (size_t)(t + 1) * kstep;
            const char* a2 = last ? nA : cA + (size_t)(t + 2) * kstep; const char* b2 = last ? nB : cB + (size_t)(t + 2) * kstep;
            const char* a3 = a2 + kstep; const char* b3 = b2 + kstep;
            unsigned v2[2][2];
#pragma unroll
            for (int h = 0; h < 2; ++h)
#pragma unroll
                for (int i = 0; i < 2; ++i) v2[h][i] = vc[h][i];
            if (GATHER && last && has_next) { const u32x4 pk = *(const PG8_LAS u32x4*)(lds + STAGE_BYTES + tid * 16); v2[0][0] = pk[0]; v2[0][1] = pk[1]; v2[1][0] = pk[2]; v2[1][1] = pk[3]; }
            PG8_XLDB(0, 0, 0); PG8_XLDB(1, 0, 1); PG8_SCHED; PG8_XLDA(0, 0); PG8_STAGE(PG8_SA(1, 1), a1 + hstepA, vc[1]);
            PG8_WAIT_V(8); PG8_WAIT_L(0); PG8_BAR; PG8_XMMA(0, 0, 0); PG8_XMMA(0, 1, 1); PG8_BAR; PG8_SCHED;
            if (!cur.half) PG8_XLDA(0, 1); PG8_STAGE(PG8_SB(0, 0), b2, voffB); PG8_STAGE(PG8_SB(0, 1), b2 + hstepB, voffB); PG8_STAGE(PG8_SA(0, 0), a2, v2[0]);
            PG8_WAIT_V(8); PG8_WAIT_L(0); PG8_BAR; if (!cur.half) { PG8_XMMA(1, 0, 0); PG8_XMMA(1, 1, 1); } PG8_BAR; PG8_SCHED;
            PG8_XLDB(0, 1, 0); PG8_XLDB(1, 1, 1); PG8_SCHED; PG8_XLDA(1, 0); PG8_STAGE(PG8_SA(0, 1), a2 + hstepA, v2[1]);
            PG8_WAIT_V(8); PG8_WAIT_L(0); PG8_BAR; PG8_XMMA(0, 0, 0); PG8_XMMA(0, 1, 1); PG8_BAR; PG8_SCHED;
            if (!cur.half) PG8_XLDA(1, 1); PG8_STAGE(PG8_SB(1, 0), b3, voffB); PG8_STAGE(PG8_SB(1, 1), b3 + hstepB, voffB); PG8_STAGE(PG8_SA(1, 0), a3, v2[0]);
            PG8_WAIT_V(8); PG8_WAIT_L(0); PG8_BAR; if (!cur.half) { PG8_XMMA(1, 0, 0); PG8_XMMA(1, 1, 1); } PG8_BAR; PG8_SCHED;
        }
        if constexpr (ALIGN_EPI) { if (wr == 0) PG8_BAR; }
        if constexpr (FP8) asm volatile("s_nop 15\n\ts_nop 15" ::: "memory");
        E(acc, cur, wr, wc, fr, fq);
        if (!has_next) break;
#pragma unroll
        for (int a = 0; a < 2; ++a)
#pragma unroll
            for (int b = 0; b < 2; ++b)
#pragma unroll
                for (int m = 0; m < 4; ++m)
#pragma unroll
                    for (int n = 0; n < 2; ++n) acc[a][b][m][n] = (f32x4){0.f, 0.f, 0.f, 0.f};
        cur = nxt; cA = nA; cB = nB; ++ui;
        if (GATHER) { const u32x4 pk = *(const PG8_LAS u32x4*)(lds + STAGE_BYTES + tid * 16); vc[0][0] = pk[0]; vc[0][1] = pk[1]; vc[1][0] = pk[2]; vc[1][1] = pk[3]; }
        if constexpr (ALIGN_EPI) { if (wr == 1) PG8_BAR; }
    }
    PG8_WAIT_V(0);
    if constexpr (!ALIGN_EPI) { if (wr == 0) PG8_BAR; }
    PG8_BAR;
#undef PG8_SA
#undef PG8_SB
#undef PG8_STAGE
#undef PG8_LDA
#undef PG8_LDB
#undef PG8_MMA16
#undef PG8_LDA8
#undef PG8_LDB8
#undef PG8_MMA8
#undef PG8_XLDA
#undef PG8_XLDB
#undef PG8_XMMA
#undef PG8_WAIT_V
#undef PG8_WAIT_L
#undef PG8_BAR
#undef PG8_SCHED
}
}

constexpr int NWAVES = 8, NTHR = 512;
constexpr int D = 1024, BATCH = 8, SEQ = 2048, NTOK = BATCH * SEQ, DEPTH = 4;
constexpr int M_HEADS = 4, M_DK = 128, M_DV = 256, M_PROJ = 3080, NPROJ = 3072;
constexpr int N_EXP = 32, D_FF = 512;
constexpr float EPS = 1e-6f;
constexpr int PMAX = 40960;

constexpr size_t MiB = 1u << 20;
constexpr size_t WS_CTL = 0, CTL_ZERO_BYTES = 1 * MiB;
constexpr size_t WS_MOD = 1 * MiB;
constexpr size_t WS_GATES = 2 * MiB;
constexpr size_t WS_TOKPOS = 3 * MiB;
constexpr size_t WS_TOKW = 3 * MiB + 256 * 1024;
constexpr size_t WS_SLOTTOK = 4 * MiB;
constexpr size_t WS_WMIN = 8 * MiB;
constexpr size_t WS_WMOUT = 20 * MiB;
constexpr size_t WS_WSIN = 24 * MiB;
constexpr size_t WS_WSOUT = 36 * MiB;
constexpr size_t WS_WGU = 40 * MiB;
constexpr size_t WS_WDN = 296 * MiB;
constexpr size_t WS_H = 424 * MiB;
constexpr size_t WS_PROJ = 456 * MiB;
constexpr size_t WS_HS = 552 * MiB;
constexpr size_t WS_A2 = 616 * MiB;
constexpr size_t WS_HMID = 648 * MiB;
constexpr size_t WS_YR = 688 * MiB;
constexpr size_t WS_X = 768 * MiB;
constexpr size_t WS_END = 800 * MiB;
constexpr int CW_BAR = 4096;
constexpr int CW_CNT = 16384;

constexpr int LDS_BYTES = 163840;
constexpr int LDSCTL_OFF = 163840 - 1024;
constexpr int LC_TOFF = 16, LC_CNT = 64, LC_LCNT = 96, LC_LBASE = 128, LC_SOFF = 160, LC_SEXP = 200;

#define GAS __attribute__((address_space(1)))
#define LAS __attribute__((address_space(3)))
typedef unsigned short bf16;
typedef unsigned v4u __attribute__((ext_vector_type(4)));
typedef unsigned v2u __attribute__((ext_vector_type(2)));
typedef float f32x4 __attribute__((ext_vector_type(4)));
#define LDS_WAIT() asm volatile("s_waitcnt lgkmcnt(0)" ::: "memory")
__device__ __forceinline__ unsigned f2bf(float f) { unsigned u = __builtin_bit_cast(unsigned, f); return (u + 0x7fffu + ((u >> 16) & 1u)) >> 16; }
__device__ __forceinline__ unsigned pk2(float lo, float hi) { return f2bf(lo) | (f2bf(hi) << 16); }
__device__ __forceinline__ float bflo(unsigned w) { return __builtin_bit_cast(float, w << 16); }
__device__ __forceinline__ float bfhi(unsigned w) { return __builtin_bit_cast(float, w & 0xffff0000u); }
__device__ __forceinline__ float wave_sum(float v) {
#pragma unroll
    for (int o = 1; o < 64; o <<= 1) v += __shfl_xor(v, o);
    return v;
}

#define XB_TMO      128
#define XB_XCNT(j)  (256  + 64 * (j))
#define XB_XSUB(j)  (1280 + 64 * (j))
#define XB_XGEN(j)  (2304 + 64 * (j))
#define XB_TOP      3328
#define XB_TOPGEN   3392
#define XCD_BAR_WORDS 3456
#define XB_SPIN_CAP (1u << 18)
__device__ __forceinline__ unsigned xb_ld(unsigned* p)              { return __hip_atomic_load(p, __ATOMIC_RELAXED, __HIP_MEMORY_SCOPE_AGENT); }
__device__ __forceinline__ unsigned xb_add(unsigned* p, unsigned v) { return __hip_atomic_fetch_add(p, v, __ATOMIC_RELAXED, __HIP_MEMORY_SCOPE_AGENT); }
__device__ __forceinline__ unsigned xb_xcc_id() { return (unsigned)__builtin_amdgcn_s_getreg((3 << 11) | 20) & 0xFu; }
#define XB_SPIN(cond, bar) do { unsigned _sp = 0; while (cond) { __builtin_amdgcn_s_sleep(1); \
    if ((++_sp & 255u) == 0u) { if (xb_ld(&(bar)[XB_TMO])) break; if (_sp > XB_SPIN_CAP) { atomicAdd(&(bar)[XB_TMO], 1u); break; } } } } while (0)
struct XcdBarrier { unsigned* bar; unsigned x; volatile LAS unsigned* st; };
__device__ __forceinline__ XcdBarrier xcd_barrier_post(unsigned* bar, volatile LAS unsigned* st) {
    XcdBarrier b; b.bar = bar; b.x = xb_xcc_id(); b.st = st;
    if (threadIdx.x == 0) (void)xb_add(&bar[XB_XCNT(b.x)], 1u);
    return b;
}
__device__ __forceinline__ void xcd_barrier_complete(unsigned* bar, unsigned x, unsigned& nloc, unsigned& nx) {
    const unsigned G = gridDim.x * gridDim.y * gridDim.z;
    unsigned sum, cnt, mine, sp = 0u;
    for (;;) {
        sum = 0u; cnt = 0u; mine = 0u;
#pragma unroll
        for (unsigned j = 0; j < 16; ++j) { const unsigned c = xb_ld(&bar[XB_XCNT(j)]); sum += c; cnt += (c > 0u) ? 1u : 0u; mine = (j == x) ? c : mine; }
        if (sum == G) break;
        __builtin_amdgcn_s_sleep(1);
        if ((++sp & 255u) == 0u) { if (xb_ld(&bar[XB_TMO])) break; if (sp > XB_SPIN_CAP) { atomicAdd(&bar[XB_TMO], 1u); break; } }
    }
    nloc = mine > 0u ? mine : 1u; nx = cnt > 0u ? cnt : 1u;
}
__device__ __forceinline__ void xcd_barrier(const XcdBarrier& b) {
    asm volatile("s_waitcnt vmcnt(0)" ::: "memory");
    __syncthreads();
    if (threadIdx.x == 0) {
        unsigned* bar = b.bar;
        __builtin_amdgcn_s_waitcnt(0);
        unsigned nloc = b.st[0], nx = b.st[1];
        if (nloc == 0u) { xcd_barrier_complete(bar, b.x, nloc, nx); b.st[0] = nloc; b.st[1] = nx; }
        const unsigned old = xb_add(&bar[XB_XSUB(b.x)], 1u);
        const unsigned gen = old / nloc;
        if (old + 1u == (gen + 1u) * nloc) {
            __builtin_amdgcn_fence(__ATOMIC_RELEASE, "agent");
            asm volatile("s_waitcnt vmcnt(0)" ::: "memory");
            const unsigned og = xb_add(&bar[XB_TOP], 1u);
            const unsigned tg = og / nx;
            if (og + 1u == (tg + 1u) * nx) xb_add(&bar[XB_TOPGEN], 1u);
            else XB_SPIN(xb_ld(&bar[XB_TOPGEN]) == tg, bar);
            __builtin_amdgcn_fence(__ATOMIC_ACQUIRE, "agent");
            xb_add(&bar[XB_XGEN(b.x)], 1u);
            asm volatile("s_waitcnt vmcnt(0)" ::: "memory");
        } else {
            XB_SPIN(xb_ld(&bar[XB_XGEN(b.x)]) == gen, bar);
            __builtin_amdgcn_fence(__ATOMIC_ACQUIRE, "agent");
            asm volatile("s_waitcnt vmcnt(0)" ::: "memory");
        }
    }
    __syncthreads();
}

struct Args { const float* in[20]; float* out; unsigned char* ws; int ph_lo, ph_hi; };
enum InIdx { I_X = 0, I_C, I_ADAW, I_ADAB, I_NORMG, I_FINALG, I_MWIN, I_MBG, I_MNORMG, I_MWOUT, I_SWIN, I_SCONVW, I_SWOUT, I_RWG, I_RBG, I_RWE, I_RBE, I_EWG, I_EWU, I_EWD };

struct Frame {
    LAS unsigned char* lds;
    volatile LAS unsigned* LC;
    unsigned* ctl;
    int tid, lane, wave, G;
    float* out; unsigned char* ws;
};
typedef const __attribute__((address_space(4))) Args* KArgs;
__device__ __forceinline__ KArgs kargs() { auto p = __builtin_amdgcn_kernarg_segment_ptr(); asm volatile("" : "+s"(p)); return (KArgs)p; }
template <class T> __device__ __forceinline__ T* as_global(T* p) { __attribute__((address_space(1))) T* q = (__attribute__((address_space(1))) T*)p; asm volatile("" : "+s"(q)); return (T*)q; }
#define KIN(i) (as_global((const float*)kargs()->in[i]))
template <class T> __device__ __forceinline__ T* launder(T* p) { return as_global(p); }

__device__ __forceinline__ Frame fresh(const Frame& F) { Frame P = F; P.tid = pg8::opaque_v(F.tid); P.lane = P.tid & 63; P.wave = __builtin_amdgcn_readfirstlane(P.tid >> 6); P.G = pg8::opaque_s(F.G); return P; }
__device__ __forceinline__ void p_adaln(Frame& F) {
    LAS float* sc = (LAS float*)F.lds;
    LAS float* red = (LAS float*)(F.lds + 32768);
    const float* c = KIN(I_C); const float* adaw = KIN(I_ADAW); const float* adab = KIN(I_ADAB);
    float* mod = (float*)(F.ws + WS_MOD);
    for (int i = F.tid; i < 8192; i += NTHR) { const float v = c[i]; sc[i] = v / (1.0f + __expf(-v)); }
    __syncthreads();
    const int kq = F.lane >> 4, c4 = (F.lane & 15) * 4;
    for (int item = blockIdx.x; item < 8 * 48; item += F.G) {
        const int ls = item / 48, cg = item % 48;
        const float* W = adaw + (size_t)ls * 1024 * 3072 + cg * 64 + c4;
        float acc[8][4];
#pragma unroll
        for (int b = 0; b < 8; ++b) { acc[b][0] = 0.f; acc[b][1] = 0.f; acc[b][2] = 0.f; acc[b][3] = 0.f; }
#pragma unroll 8
        for (int i = 0; i < 32; ++i) {
            const int k = F.wave * 128 + i * 4 + kq;
            const f32x4 w = *(const f32x4*)(W + (size_t)k * 3072);
#pragma unroll
            for (int b = 0; b < 8; ++b) { const float s = sc[b * 1024 + k]; acc[b][0] += s * w[0]; acc[b][1] += s * w[1]; acc[b][2] += s * w[2]; acc[b][3] += s * w[3]; }
        }
#pragma unroll
        for (int b = 0; b < 8; ++b)
#pragma unroll
            for (int j = 0; j < 4; ++j) { float v = acc[b][j]; v += __shfl_xor(v, 16); v += __shfl_xor(v, 32); acc[b][j] = v; }
        if (kq == 0) {
#pragma unroll
            for (int b = 0; b < 8; ++b) *(LAS f32x4*)(red + (F.wave * 8 + b) * 64 + c4) = (f32x4){acc[b][0], acc[b][1], acc[b][2], acc[b][3]};
        }
        __syncthreads();
        { const int b = F.tid >> 6, col = F.tid & 63; float s = 0.f;
#pragma unroll
          for (int w = 0; w < 8; ++w) s += red[(w * 8 + b) * 64 + col];
          mod[((size_t)ls * 8 + b) * 3072 + cg * 64 + col] = s + adab[ls * 3072 + cg * 64 + col]; }
        __syncthreads();
    }
}

__device__ __forceinline__ void tr_item(const float* W, int ldw, bf16* WT, int ldt, LAS float* scr, int lane) {
#pragma unroll 8
    for (int i = 0; i < 32; ++i) { const int kk = 2 * i + (lane >> 5); scr[kk * 33 + (lane & 31)] = W[(size_t)kk * ldw + (lane & 31)]; }
    LDS_WAIT(); asm volatile("" ::: "memory");
    const int c = lane & 7;
#pragma unroll
    for (int j = 0; j < 4; ++j) { const int n = (lane >> 3) + 8 * j; const LAS float* s = scr + (8 * c) * 33 + n;
        v4u o; o.x = pk2(s[0 * 33], s[1 * 33]); o.y = pk2(s[2 * 33], s[3 * 33]); o.z = pk2(s[4 * 33], s[5 * 33]); o.w = pk2(s[6 * 33], s[7 * 33]);
        *(v4u*)(WT + (size_t)n * ldt + 8 * c) = o; }
    LDS_WAIT(); asm volatile("" ::: "memory");
}
__device__ __forceinline__ void tr_item8(const float* W, int ldw, unsigned char* WT, int ldt, LAS float* scr, int lane) {
#pragma unroll 8
    for (int i = 0; i < 64; ++i) { const int kk = 2 * i + (lane >> 5); scr[kk * 33 + (lane & 31)] = W[(size_t)kk * ldw + (lane & 31)] * 32.0f; }
    LDS_WAIT(); asm volatile("" ::: "memory");
    const int n = lane >> 1, kh = (lane & 1) * 64; const LAS float* sp = scr + kh * 33 + n;
    unsigned char* dst = WT + (size_t)n * ldt + kh;
#pragma unroll
    for (int q = 0; q < 4; ++q) { v4u o;
        o.x = pg8::pk4_fp8(sp[(16 * q + 0) * 33], sp[(16 * q + 1) * 33], sp[(16 * q + 2) * 33], sp[(16 * q + 3) * 33]); o.y = pg8::pk4_fp8(sp[(16 * q + 4) * 33], sp[(16 * q + 5) * 33], sp[(16 * q + 6) * 33], sp[(16 * q + 7) * 33]);
        o.z = pg8::pk4_fp8(sp[(16 * q + 8) * 33], sp[(16 * q + 9) * 33], sp[(16 * q + 10) * 33], sp[(16 * q + 11) * 33]); o.w = pg8::pk4_fp8(sp[(16 * q + 12) * 33], sp[(16 * q + 13) * 33], sp[(16 * q + 14) * 33], sp[(16 * q + 15) * 33]);
        *(v4u*)(dst + 16 * q) = o; }
    LDS_WAIT(); asm volatile("" ::: "memory");
}
__device__ __forceinline__ void p_convert(Frame& F) {
    LAS float* scr = (LAS float*)(F.lds + F.wave * 17408);
    const float* in_mwin = KIN(I_MWIN); const float* in_mwout = KIN(I_MWOUT); const float* in_swin = KIN(I_SWIN); const float* in_swout = KIN(I_SWOUT);
    const float* in_ewg = KIN(I_EWG); const float* in_ewu = KIN(I_EWU); const float* in_ewd = KIN(I_EWD);
    const int gw = blockIdx.x * NWAVES + F.wave, NGW = F.G * NWAVES;
    constexpr int I_A = 2 * 16 * 96, I_B = 2 * 16 * 32, I_C2 = I_A, I_D = I_B, I_E = 128 * 8 * 16, I_F = I_E, I_G = 128 * 4 * 32;
    constexpr int NITEMS = I_A + I_B + I_C2 + I_D + I_E + I_F + I_G;
    for (int it = gw; it < NITEMS; it += NGW) {
        int r = it;
        if (r < I_A) { const int j = r / 1536, q = r % 1536, kb = q / 96, nb = q % 96;
            tr_item(in_mwin + (size_t)j * 1024 * M_PROJ + (size_t)kb * 64 * M_PROJ + nb * 32, M_PROJ, (bf16*)(F.ws + WS_WMIN) + (size_t)j * 3072 * 1024 + (size_t)nb * 32 * 1024 + kb * 64, 1024, scr, F.lane); continue; } r -= I_A;
        if (r < I_B) { const int j = r / 512, q = r % 512, kb = q / 32, nb = q % 32;
            tr_item(in_mwout + (size_t)j * 1024 * 1024 + (size_t)kb * 64 * 1024 + nb * 32, 1024, (bf16*)(F.ws + WS_WMOUT) + (size_t)j * 1024 * 1024 + (size_t)nb * 32 * 1024 + kb * 64, 1024, scr, F.lane); continue; } r -= I_B;
        if (r < I_C2) { const int j = r / 1536, q = r % 1536, kb = q / 96, nb = q % 96, n0 = nb * 32;
            int drow; if (n0 < 1024) drow = 2048 + n0; else if (n0 < 2048) { const int cc = n0 - 1024; drow = 256 * (cc >> 7) + (cc & 127); } else { const int cc = n0 - 2048; drow = 256 * (cc >> 7) + 128 + (cc & 127); }
            tr_item(in_swin + (size_t)j * 1024 * 3072 + (size_t)kb * 64 * 3072 + n0, 3072, (bf16*)(F.ws + WS_WSIN) + (size_t)j * 3072 * 1024 + (size_t)drow * 1024 + kb * 64, 1024, scr, F.lane); continue; } r -= I_C2;
        if (r < I_D) { const int j = r / 512, q = r % 512, kb = q / 32, nb = q % 32;
            tr_item(in_swout + (size_t)j * 1024 * 1024 + (size_t)kb * 64 * 1024 + nb * 32, 1024, (bf16*)(F.ws + WS_WSOUT) + (size_t)j * 1024 * 1024 + (size_t)nb * 32 * 1024 + kb * 64, 1024, scr, F.lane); continue; } r -= I_D;
        if (r < I_E + I_F) { const bool up = r >= I_E; if (up) r -= I_E; const int mat = r / 128, q = r % 128, kb = q / 16, nb = q % 16, n0 = nb * 32;
            const int drow = 256 * (n0 >> 7) + (up ? 128 : 0) + (n0 & 127);
            tr_item8((up ? in_ewu : in_ewg) + (size_t)mat * 1024 * 512 + (size_t)kb * 128 * 512 + n0, 512, (unsigned char*)(F.ws + WS_WGU) + (size_t)mat * 1024 * 1024 + (size_t)drow * 1024 + kb * 128, 1024, scr, F.lane); continue; } r -= I_E + I_F;
        { const int mat = r / 128, q = r % 128, kb = q / 32, nb = q % 32;
            tr_item8(in_ewd + (size_t)mat * 512 * 1024 + (size_t)kb * 128 * 1024 + nb * 32, 1024, (unsigned char*)(F.ws + WS_WDN) + (size_t)mat * 1024 * 512 + (size_t)nb * 32 * 512 + kb * 128, 512, scr, F.lane); }
    }
}

__device__ __forceinline__ void moe_tables(Frame& F, int layer) {
    if (F.tid < 64) {
        const int e = F.tid & 31;
        const int c = (int)__hip_atomic_load(F.ctl + CW_CNT + (layer * 32 + e) * 16, __ATOMIC_RELAXED, __HIP_MEMORY_SCOPE_AGENT);
        const int tl = (c + 255) >> 8, rem = c - (tl - 1) * 256;
        const int sm = (tl > 0 && rem <= 128) ? 1 : 0, nb = tl - sm;
        int incb = (F.tid < 32) ? nb : 0, incs = (F.tid < 32) ? sm : 0;
#pragma unroll
        for (int o = 1; o < 32; o <<= 1) { const int vb = __shfl_up(incb, o), vs = __shfl_up(incs, o); if ((F.tid & 63) >= o) { incb += vb; incs += vs; } }
        if (F.tid < 32) { F.LC[LC_TOFF + e] = (unsigned)(incb - nb); F.LC[LC_SOFF + e] = (unsigned)(incs - sm); F.LC[LC_CNT + e] = (unsigned)c;
            if (sm) F.LC[LC_SEXP + (incs - sm)] = (unsigned)e;
            if (e == 31) { F.LC[LC_TOFF + 32] = (unsigned)incb; F.LC[LC_SOFF + 32] = (unsigned)incs; } }
    }
    __syncthreads();
}
__device__ __forceinline__ int moe_slot(Frame& F, int p) {
    const int e = p & 31, pos = p >> 5, k = pos >> 8, b0 = (int)F.LC[LC_TOFF + e], nb = (int)F.LC[LC_TOFF + e + 1] - b0;
    const int tile = (k < nb) ? b0 + k : (int)F.LC[LC_TOFF + 32] + (int)F.LC[LC_SOFF + e];
    return tile * 256 + (pos & 255);
}
template <int NC> __device__ __forceinline__ void wtab_put(LAS unsigned char* base, int k, int n, float v) {
    const unsigned hi = f2bf(v); const unsigned lo = f2bf(v - __builtin_bit_cast(float, hi << 16));
    const int off = ((k >> 3) * NC + n) * 16 + (k & 7) * 2;
    *(LAS unsigned short*)(base + off) = (unsigned short)hi; *(LAS unsigned short*)(base + NC * 2048 + off) = (unsigned short)lo;
}
typedef short rbf16x8 __attribute__((ext_vector_type(8)));
template <bool COMBINE, int AUX, bool FINAL, bool XF32 = false>
__device__ __forceinline__ void row_phase(Frame& F, const void* xsrc_, void* xdst_, const float* modn, const float* ng, const float* modprev, int prev_layer,
                                          const float* auxw0, const float* auxw1, const float* auxb0, const float* auxb1, int layer) {
    constexpr int NC = (AUX == 2) ? 36 : 8, NT = (NC + 15) / 16;
    constexpr int OFF_RINV = 147456, OFF_LOGIT = OFF_RINV + 256, OFF_ROWE = OFF_LOGIT + 64 * 36 * 4, OFF_ROWW = OFF_ROWE + 512, OFF_CB = OFF_ROWW + 512, OFF_R2 = OFF_CB + 256;
    static_assert(OFF_R2 + 14 * 36 * 4 <= LDSCTL_OFF && 64 * 8 * 4 <= 14 * 36 * 4 + 64, "row phase LDS map");
    const int lane = F.lane;
    const float* xsrc32 = (const float*)xsrc_; const bf16* xsrc16 = (const bf16*)xsrc_;
    float* xdst32 = (float*)xdst_; bf16* xdst16 = (bf16*)xdst_;
    if (COMBINE) moe_tables(F, prev_layer);
    const int* tokpos = (const int*)(F.ws + WS_TOKPOS); const float* tokw = (const float*)(F.ws + WS_TOKW);
    const bf16* YR = (const bf16*)(F.ws + WS_YR);
    bf16* H = (bf16*)(F.ws + WS_H);
    LAS float* rinvL = (LAS float*)(F.lds + OFF_RINV);
    LAS float* logit = (LAS float*)(F.lds + OFF_LOGIT);
    LAS int* rowE = (LAS int*)(F.lds + OFF_ROWE);
    LAS float* rowW = (LAS float*)(F.lds + OFF_ROWW);
    LAS float* cbL = (LAS float*)(F.lds + OFF_CB);
    LAS float* r2 = (LAS float*)(F.lds + OFF_R2);
    int tab_b = -1;
#ifdef SCAN_SELFCHECK
    const float FLAGSCALE = (FINAL && __hip_atomic_load(F.ctl + 64, __ATOMIC_RELAXED, __HIP_MEMORY_SCOPE_AGENT) != 0u) ? 2.0f : 1.0f;
#else
    const float FLAGSCALE = 1.0f;
#endif
    for (int rg = blockIdx.x; rg < NTOK / 64; rg += F.G) {
        const int b = rg >> 5;
        if (AUX != 0 && b != tab_b) {
            tab_b = b;
            const float* shp = modn + b * 3072; const float* scp = shp + 1024;
            LAS float* gsL = logit; LAS float* shL = logit + 1024;
            for (int k = F.tid; k < 1024; k += NTHR) { gsL[k] = ng[k] * (1.0f + scp[k]); shL[k] = shp[k]; }
            __syncthreads();
            constexpr int NQ = (AUX == 2) ? 14 : 4, NI = (AUX == 2) ? 10 : 1;
            if (AUX == 1) {
                float cs4[4] = {0.f, 0.f, 0.f, 0.f};
                if (F.tid < 256) { const int kc = F.tid >> 1, c4 = F.tid & 1; f32x4 wq[8];
#pragma unroll
                    for (int jj = 0; jj < 8; ++jj) wq[jj] = *(const f32x4*)(auxw0 + (size_t)(8 * kc + jj) * M_PROJ + NPROJ + 4 * c4);
#pragma unroll
                    for (int e = 0; e < 4; ++e) { float pv[8];
#pragma unroll
                        for (int jj = 0; jj < 8; ++jj) { const int k = 8 * kc + jj; cs4[e] += shL[k] * wq[jj][e]; pv[jj] = wq[jj][e] * gsL[k]; }
                        v4u hi, lo; unsigned* hp = (unsigned*)&hi; unsigned* lp = (unsigned*)&lo;
#pragma unroll
                        for (int q = 0; q < 4; ++q) { const unsigned w2 = pg8::cvt_pk_bf16(pv[2 * q], pv[2 * q + 1]); hp[q] = w2;
                            lp[q] = pg8::cvt_pk_bf16(pv[2 * q] - __builtin_bit_cast(float, w2 << 16), pv[2 * q + 1] - __builtin_bit_cast(float, w2 & 0xffff0000u)); }
                        *(LAS v4u*)(F.lds + (kc * NC + 4 * c4 + e) * 16) = hi; *(LAS v4u*)(F.lds + NC * 2048 + (kc * NC + 4 * c4 + e) * 16) = lo; } }
#pragma unroll
                for (int e = 0; e < 4; ++e) { float t = cs4[e]; t += __shfl_xor(t, 2); t += __shfl_xor(t, 4); t += __shfl_xor(t, 8); t += __shfl_xor(t, 16); t += __shfl_xor(t, 32); cs4[e] = t; }
                if (F.tid < 256 && lane < 2) {
#pragma unroll
                    for (int e = 0; e < 4; ++e) r2[F.wave * NC + 4 * lane + e] = cs4[e]; }
            } else {
            if (F.tid < NQ * NC) {
                const int n = F.tid % NC, kcq = F.tid / NC; float cs = 0.f;
                const float* wcol = (AUX == 1) ? auxw0 + NPROJ + n : ((n < 4) ? auxw0 + n : auxw1 + (n - 4));
                const int wstr = (AUX == 1) ? M_PROJ : ((n < 4) ? 4 : 32);
                constexpr int NB = (NI + 4) / 5;
#pragma unroll 1
                for (int bt = 0; bt < NB; ++bt) {
                    float wv[5][8];
#pragma unroll
                    for (int i = 0; i < 5; ++i) { const int kcr = kcq + NQ * (5 * bt + i); const int kc = kcr < 128 ? kcr : 127; const float* wp = wcol + (size_t)(8 * kc) * wstr;
#pragma unroll
                        for (int jj = 0; jj < 8; ++jj) wv[i][jj] = wp[jj * wstr]; }
#pragma unroll
                    for (int i = 0; i < 5; ++i) { const int kcr = kcq + NQ * (5 * bt + i); const bool valid = kcr < 128 && (5 * bt + i) < NI; const int kc = kcr < 128 ? kcr : 127;
                        float pv[8];
#pragma unroll
                        for (int jj = 0; jj < 8; ++jj) { const int k = 8 * kc + jj; cs += valid ? shL[k] * wv[i][jj] : 0.f; pv[jj] = wv[i][jj] * gsL[k]; }
                        v4u hi, lo; unsigned* hp = (unsigned*)&hi; unsigned* lp = (unsigned*)&lo;
#pragma unroll
                        for (int e = 0; e < 4; ++e) { const unsigned w2 = pg8::cvt_pk_bf16(pv[2 * e], pv[2 * e + 1]); hp[e] = w2;
                            lp[e] = pg8::cvt_pk_bf16(pv[2 * e] - __builtin_bit_cast(float, w2 << 16), pv[2 * e + 1] - __builtin_bit_cast(float, w2 & 0xffff0000u)); }
                        *(LAS v4u*)(F.lds + (kc * NC + n) * 16) = hi; *(LAS v4u*)(F.lds + NC * 2048 + (kc * NC + n) * 16) = lo;
                    }
                }
                r2[kcq * NC + n] = cs;
            }
            }
            __syncthreads();
            if (F.tid < NC) { float sacc = 0.f; for (int q = 0; q < NQ; ++q) sacc += r2[q * NC + F.tid]; cbL[F.tid] = sacc; }
            __syncthreads();
        }
        if (AUX != 0) { for (int i = F.tid; i < 64 * NC; i += NTHR) logit[i] = 0.f; if (AUX == 2 && F.tid < 32) F.LC[LC_LCNT + F.tid] = 0u; }
        {
            constexpr int RB = COMBINE ? 2 : 4;
            f32x4 gsv[4], shv[4], gtv[4];
#pragma unroll
            for (int j = 0; j < 4; ++j) {
                const f32x4 g = *((const f32x4*)ng + lane + 64 * j);
                if (FINAL) { gsv[j] = g; shv[j] = (f32x4){0.f, 0.f, 0.f, 0.f}; }
                else { const f32x4 scl = *((const f32x4*)(modn + b * 3072 + 1024) + lane + 64 * j); gsv[j] = g * (1.0f + scl); shv[j] = *((const f32x4*)(modn + b * 3072) + lane + 64 * j); }
                if (COMBINE) gtv[j] = *((const f32x4*)(modprev + b * 3072 + 2048) + lane + 64 * j);
            }
            for (int i0 = 0; i0 < 8; i0 += RB) {
                const int rowb = rg * 64 + F.wave * 8 + i0;
                f32x4 v[RB][4]; v2u y0[RB][4], y1[RB][4]; float w0[RB], w1[RB];
#pragma unroll
                for (int r = 0; r < RB; ++r) {
#pragma unroll
                    for (int j = 0; j < 4; ++j) {
                        if (XF32) v[r][j] = *((const f32x4*)(xsrc32 + (size_t)(rowb + r) * D) + lane + 64 * j);
                        else { const v2u w = *((const v2u*)(xsrc16 + (size_t)(rowb + r) * D) + lane + 64 * j); v[r][j] = (f32x4){bflo(w.x), bfhi(w.x), bflo(w.y), bfhi(w.y)}; } }
                    if (COMBINE) {
                        const int p0 = __builtin_amdgcn_readfirstlane(tokpos[(rowb + r) * 2]), p1 = __builtin_amdgcn_readfirstlane(tokpos[(rowb + r) * 2 + 1]);
                        w0[r] = tokw[(rowb + r) * 2]; w1[r] = tokw[(rowb + r) * 2 + 1];
                        const int s0 = moe_slot(F, p0), s1 = moe_slot(F, p1);
#pragma unroll
                        for (int j = 0; j < 4; ++j) { y0[r][j] = *((const v2u*)(YR + (size_t)s0 * D) + lane + 64 * j); y1[r][j] = *((const v2u*)(YR + (size_t)s1 * D) + lane + 64 * j); }
                    }
                }
#pragma unroll
                for (int r = 0; r < RB; ++r) {
                    const int row = rowb + r;
                    if (COMBINE) {
#pragma unroll
                        for (int j = 0; j < 4; ++j) {
                            v[r][j][0] += gtv[j][0] * (w0[r] * bflo(y0[r][j].x) + w1[r] * bflo(y1[r][j].x)); v[r][j][1] += gtv[j][1] * (w0[r] * bfhi(y0[r][j].x) + w1[r] * bfhi(y1[r][j].x));
                            v[r][j][2] += gtv[j][2] * (w0[r] * bflo(y0[r][j].y) + w1[r] * bflo(y1[r][j].y)); v[r][j][3] += gtv[j][3] * (w0[r] * bfhi(y0[r][j].y) + w1[r] * bfhi(y1[r][j].y));
                        }
                        if (!FINAL) {
#pragma unroll
                            for (int j = 0; j < 4; ++j) { v2u o; o.x = pk2(v[r][j][0], v[r][j][1]); o.y = pk2(v[r][j][2], v[r][j][3]); *((v2u*)(xdst16 + (size_t)row * D) + lane + 64 * j) = o;
                                v[r][j] = (f32x4){bflo(o.x), bfhi(o.x), bflo(o.y), bfhi(o.y)}; }
                        }
                    }
                    float ss = 0.f;
#pragma unroll
                    for (int j = 0; j < 4; ++j) ss += (v[r][j][0] * v[r][j][0] + v[r][j][1] * v[r][j][1]) + (v[r][j][2] * v[r][j][2] + v[r][j][3] * v[r][j][3]);
                    const float rinv = 1.0f / sqrtf(wave_sum(ss) * (1.0f / D) + EPS);
                    if (FINAL) {
#pragma unroll
                        for (int j = 0; j < 4; ++j) *((f32x4*)(xdst32 + (size_t)row * D) + lane + 64 * j) = v[r][j] * (rinv * FLAGSCALE) * gsv[j];
                    } else {
                        if (AUX != 0 && lane == 0) rinvL[F.wave * 8 + i0 + r] = rinv;
#pragma unroll
                        for (int j = 0; j < 4; ++j) { const f32x4 h = (v[r][j] * rinv) * gsv[j] + shv[j];
                            if (AUX == 2) *((unsigned*)((unsigned char*)H + (size_t)row * D) + lane + 64 * j) = pg8::pk4_fp8(h[0], h[1], h[2], h[3]);
                            else { v2u o; o.x = pk2(h[0], h[1]); o.y = pk2(h[2], h[3]); *((v2u*)(H + (size_t)row * D) + lane + 64 * j) = o; } }
                    }
                }
            }
        }
        if (AUX != 0) {
            __syncthreads();
            const int l15 = lane & 15, g4 = lane >> 4, tile = F.wave >> 1, kh = F.wave & 1;
            const int trow = rg * 64 + tile * 16 + l15;
            const float* xr32 = xsrc32 + (size_t)trow * D; const bf16* xr16 = (COMBINE ? (const bf16*)xdst16 : xsrc16) + (size_t)trow * D;
            f32x4 acc[NT];
#pragma unroll
            for (int nt = 0; nt < NT; ++nt) acc[nt] = (f32x4){0.f, 0.f, 0.f, 0.f};
#pragma unroll 8
            for (int ks = kh * 16; ks < kh * 16 + 16; ++ks) {
                const int k0 = 32 * ks + 8 * g4;
                v4u hi, lo = (v4u){0u, 0u, 0u, 0u};
                if (XF32) {
                    const f32x4 x0 = *(const f32x4*)(xr32 + k0), x1 = *(const f32x4*)(xr32 + k0 + 4);
                    const float hv[8] = {x0[0], x0[1], x0[2], x0[3], x1[0], x1[1], x1[2], x1[3]};
                    unsigned* hp = (unsigned*)&hi; unsigned* lp = (unsigned*)&lo;
#pragma unroll
                    for (int e = 0; e < 4; ++e) { const unsigned w2 = pg8::cvt_pk_bf16(hv[2 * e], hv[2 * e + 1]); hp[e] = w2;
                        lp[e] = pg8::cvt_pk_bf16(hv[2 * e] - __builtin_bit_cast(float, w2 << 16), hv[2 * e + 1] - __builtin_bit_cast(float, w2 & 0xffff0000u)); }
                } else hi = *(const v4u*)(xr16 + k0);
                const rbf16x8 Ahi = __builtin_bit_cast(rbf16x8, hi), Alo = __builtin_bit_cast(rbf16x8, lo);
#pragma unroll
                for (int nt = 0; nt < NT; ++nt) {
                    const int n = (16 * nt + l15) < NC ? (16 * nt + l15) : (NC - 1);
                    const LAS unsigned char* tp = F.lds + ((4 * ks + g4) * NC + n) * 16;
                    const rbf16x8 Bhi = *(const LAS rbf16x8*)tp, Blo = *(const LAS rbf16x8*)(tp + NC * 2048);
                    acc[nt] = __builtin_amdgcn_mfma_f32_16x16x32_bf16(Ahi, Bhi, acc[nt], 0, 0, 0);
                    if (XF32) acc[nt] = __builtin_amdgcn_mfma_f32_16x16x32_bf16(Alo, Bhi, acc[nt], 0, 0, 0);
                    acc[nt] = __builtin_amdgcn_mfma_f32_16x16x32_bf16(Ahi, Blo, acc[nt], 0, 0, 0);
                }
            }
#pragma unroll
            for (int nt = 0; nt < NT; ++nt) { const int n = 16 * nt + l15;
                if (n < NC) {
#pragma unroll
                    for (int r = 0; r < 4; ++r) (void)__hip_atomic_fetch_add(logit + (tile * 16 + 4 * g4 + r) * NC + n, acc[nt][r], __ATOMIC_RELAXED, __HIP_MEMORY_SCOPE_WORKGROUP);
                } }
            __syncthreads();
        }
        if (AUX == 1) {
            if (F.tid < 64) { const int row = rg * 64 + F.tid; const LAS float* lg = logit + F.tid * NC; const float ri = rinvL[F.tid]; float* gp = (float*)(F.ws + WS_GATES) + (size_t)row * 8;
                *(f32x4*)gp = (f32x4){lg[0] * ri + cbL[0], lg[1] * ri + cbL[1], lg[2] * ri + cbL[2], lg[3] * ri + cbL[3]};
                *(f32x4*)(gp + 4) = (f32x4){lg[4] * ri + cbL[4], lg[5] * ri + cbL[5], lg[6] * ri + cbL[6], lg[7] * ri + cbL[7]}; }
            __syncthreads();
        }
        if (AUX == 2) {
            if (F.tid < 64) {
                const LAS float* lg = logit + F.tid * NC; const float ri = rinvL[F.tid];
                float gl[4];
#pragma unroll
                for (int g = 0; g < 4; ++g) gl[g] = lg[g] * ri + cbL[g] + auxb0[g];
                int gs = 0; float gm = gl[0];
#pragma unroll
                for (int g = 1; g < 4; ++g) if (gl[g] > gm) { gm = gl[g]; gs = g; }
                float den = 0.f;
#pragma unroll
                for (int g = 0; g < 4; ++g) den += __expf(gl[g] - gm);
                const float psel = 1.0f / den;
                float el[8];
#pragma unroll
                for (int q = 0; q < 8; ++q) el[q] = lg[4 + gs * 8 + q] * ri + cbL[4 + gs * 8 + q] + auxb1[gs * 8 + q];
                int i1 = 0; float l1 = el[0];
#pragma unroll
                for (int q = 1; q < 8; ++q) if (el[q] > l1) { l1 = el[q]; i1 = q; }
                int i2 = -1; float l2 = -3.0e38f;
#pragma unroll
                for (int q = 0; q < 8; ++q) if (q != i1 && el[q] > l2) { l2 = el[q]; i2 = q; }
                const float ex = __expf(l2 - l1), w1 = psel / (1.0f + ex), w2 = psel * ex / (1.0f + ex);
                rowE[2 * F.tid] = gs * 8 + i1; rowE[2 * F.tid + 1] = gs * 8 + i2; rowW[2 * F.tid] = w1; rowW[2 * F.tid + 1] = w2;
            }
            __syncthreads();
            int e = 0, lp = 0;
            if (F.tid < 128) { e = rowE[F.tid]; lp = (int)__hip_atomic_fetch_add((LAS unsigned*)(F.LC + LC_LCNT + e), 1u, __ATOMIC_RELAXED, __HIP_MEMORY_SCOPE_WORKGROUP); }
            __syncthreads();
            if (F.tid < 32) F.LC[LC_LBASE + F.tid] = __hip_atomic_fetch_add(F.ctl + CW_CNT + (layer * 32 + F.tid) * 16, F.LC[LC_LCNT + F.tid], __ATOMIC_RELAXED, __HIP_MEMORY_SCOPE_AGENT);
            __syncthreads();
            if (F.tid < 128) { const int row = rg * 64 + (F.tid >> 1); const int pos = (int)F.LC[LC_LBASE + e] + lp;
                ((int*)(F.ws + WS_SLOTTOK))[e * 16384 + pos] = row; ((int*)(F.ws + WS_TOKPOS))[row * 2 + (F.tid & 1)] = pos * 32 + e; ((float*)(F.ws + WS_TOKW))[row * 2 + (F.tid & 1)] = rowW[F.tid]; }
            __syncthreads();
        }
    }
}

__device__ __forceinline__ float logsigmoid_f(float x) { return x < 0.f ? x - log1pf(__expf(x)) : -log1pf(__expf(-x)); }
__device__ __forceinline__ void p_scan(Frame& F, int j  ) {
    constexpr int QS = 132;
    LAS float* q = (LAS float*)F.lds;
    LAS float* k = q + 64 * QS;
    LAS float* Cm = k + 64 * QS;
    LAS float* vv = Cm + 32 * QS;
    LAS float* vw = vv + 64 * 32;
    LAS float* Sm = vw + 64 * 32;
    LAS float* nn = Sm + 64 * 68;
    LAS float* ga = nn + 128;
    LAS float* gM = ga + 64;
    LAS float* gb = gM + 64;
    LAS float* gden = gb + 64;
    LAS float* gm = gden + 64;
    const bf16* PROJ = (const bf16*)(F.ws + WS_PROJ);
    const float* GATES = (const float*)(F.ws + WS_GATES);
    float* HS = (float*)(F.ws + WS_HS);
    const float* bg = KIN(I_MBG) + j * 8;
    const int tid = F.tid;
    for (int item = blockIdx.x; item < 256; item += F.G) {
        const int b = item >> 5, hd = (item >> 3) & 3, vs = item & 7;
        for (int i = tid; i < 32 * QS; i += NTHR) Cm[i] = 0.f;
        if (tid < 128) nn[tid] = 0.f;
        if (tid == 0) gm[0] = 0.f;
        __syncthreads();
        for (int ch = 0; ch < 32; ++ch) {
            const int row0 = b * SEQ + ch * 64;
            for (int p = tid; p < 2048; p += NTHR) { const int isk = p >> 10, pp = p & 1023, r = pp >> 4, c8 = (pp & 15) * 8;
                const v4u w = *(const v4u*)(PROJ + (size_t)(row0 + r) * NPROJ + isk * 512 + hd * 128 + c8);
                const float sc = isk ? 1.0f : 0.08838834764831845f;
                LAS float* dst = (isk ? k : q) + r * QS + c8;
                *(LAS f32x4*)dst = (f32x4){bflo(w.x) * sc, bfhi(w.x) * sc, bflo(w.y) * sc, bfhi(w.y) * sc};
                *(LAS f32x4*)(dst + 4) = (f32x4){bflo(w.z) * sc, bfhi(w.z) * sc, bflo(w.w) * sc, bfhi(w.w) * sc}; }
            if (tid < 256) { const int r = tid >> 2, c8 = (tid & 3) * 8;
                const v4u w = *(const v4u*)(PROJ + (size_t)(row0 + r) * NPROJ + 1024 + hd * 256 + vs * 32 + c8);
                LAS float* dst = vv + r * 32 + c8;
                *(LAS f32x4*)dst = (f32x4){bflo(w.x), bfhi(w.x), bflo(w.y), bfhi(w.y)}; *(LAS f32x4*)(dst + 4) = (f32x4){bflo(w.z), bfhi(w.z), bflo(w.w), bfhi(w.w)}; }
            if (tid < 64) {
                const float ig = GATES[(size_t)(row0 + tid) * 8 + hd] + bg[hd];
                const float lf = logsigmoid_f(GATES[(size_t)(row0 + tid) * 8 + 4 + hd] + bg[4 + hd]);
                float bc = lf;
#pragma unroll
                for (int o = 1; o < 64; o <<= 1) { const float t = __shfl_up(bc, o); if (tid >= o) bc += t; }
                const float a = ig - bc;
                float pm = a;
#pragma unroll
                for (int o = 1; o < 64; o <<= 1) { const float t = __shfl_up(pm, o); if (tid >= o) pm = fmaxf(pm, t); }
                const float m = gm[0];
                ga[tid] = a; gM[tid] = fmaxf(m, pm); gb[tid] = bc;
            }
            __syncthreads();
            {
                const int s = tid & 63, t0 = (tid >> 6) * 8;
                float acc[8];
#pragma unroll
                for (int i = 0; i < 8; ++i) acc[i] = 0.f;
                for (int d4 = 0; d4 < 32; ++d4) {
                    const f32x4 kv = *(const LAS f32x4*)(k + s * QS + d4 * 4);
#pragma unroll
                    for (int i = 0; i < 8; ++i) { const f32x4 qv = *(const LAS f32x4*)(q + (t0 + i) * QS + d4 * 4); acc[i] += qv[0] * kv[0] + qv[1] * kv[1] + qv[2] * kv[2] + qv[3] * kv[3]; }
                }
                const float as = ga[s];
#pragma unroll
                for (int i = 0; i < 8; ++i) { const int t = t0 + i; Sm[t * 68 + s] = (s <= t) ? acc[i] * __expf(as - gM[t]) : 0.f; }
            }
            __syncthreads();
            {
                const int t = tid >> 3, part = tid & 7; float sden = 0.f, nq = 0.f;
#pragma unroll
                for (int s = 0; s < 8; ++s) sden += Sm[t * 68 + part * 8 + s];
#pragma unroll
                for (int d = 0; d < 16; ++d) nq += nn[part * 16 + d] * q[t * QS + part * 16 + d];
                float tot = sden + __expf(gm[0] - gM[t]) * nq;
                tot += __shfl_xor(tot, 1); tot += __shfl_xor(tot, 2); tot += __shfl_xor(tot, 4);
                if (part == 0) gden[t] = tot;
            }
            __syncthreads();
            {
                const int v = tid & 31, t0 = (tid >> 5) * 4;
                float a1[4] = {0.f, 0.f, 0.f, 0.f}, a2[4] = {0.f, 0.f, 0.f, 0.f};
                for (int s4 = 0; s4 < 16; ++s4) {
                    float vx[4];
#pragma unroll
                    for (int e = 0; e < 4; ++e) vx[e] = vv[(s4 * 4 + e) * 32 + v];
#pragma unroll
                    for (int i = 0; i < 4; ++i) { const f32x4 sv = *(const LAS f32x4*)(Sm + (t0 + i) * 68 + s4 * 4); a1[i] += sv[0] * vx[0] + sv[1] * vx[1] + sv[2] * vx[2] + sv[3] * vx[3]; }
                }
                for (int d4 = 0; d4 < 32; ++d4) {
                    const f32x4 cv = *(const LAS f32x4*)(Cm + v * QS + d4 * 4);
#pragma unroll
                    for (int i = 0; i < 4; ++i) { const f32x4 qv = *(const LAS f32x4*)(q + (t0 + i) * QS + d4 * 4); a2[i] += qv[0] * cv[0] + qv[1] * cv[1] + qv[2] * cv[2] + qv[3] * cv[3]; }
                }
                const float m = gm[0];
#pragma unroll
                for (int i = 0; i < 4; ++i) { const int t = t0 + i; const float Mt = gM[t];
                    const float num = a1[i] + __expf(m - Mt) * a2[i];
                    const float dn = fmaxf(fabsf(gden[t]), __expf(-(gb[t] + Mt)));
                    HS[(size_t)(row0 + t) * D + hd * 256 + vs * 32 + v] = num / dn; }
            }
            for (int p = tid; p < 2048; p += NTHR) { const int s = p >> 5; vw[p] = vv[p] * __expf(ga[s] - gM[63]); }
            __syncthreads();
            {
                const float decay = __expf(gm[0] - gM[63]);
                const int d = tid & 127, v0 = (tid >> 7) * 8;
                float acc[8];
#pragma unroll
                for (int i = 0; i < 8; ++i) acc[i] = decay * Cm[(v0 + i) * QS + d];
                for (int s = 0; s < 64; ++s) {
                    const float kv = k[s * QS + d];
                    const f32x4 w0 = *(const LAS f32x4*)(vw + s * 32 + v0), w1 = *(const LAS f32x4*)(vw + s * 32 + v0 + 4);
                    acc[0] += w0[0] * kv; acc[1] += w0[1] * kv; acc[2] += w0[2] * kv; acc[3] += w0[3] * kv;
                    acc[4] += w1[0] * kv; acc[5] += w1[1] * kv; acc[6] += w1[2] * kv; acc[7] += w1[3] * kv;
                }
                float nacc = 0.f;
                if (tid < 128) { nacc = decay * nn[d]; for (int s = 0; s < 64; ++s) nacc += __expf(ga[s] - gM[63]) * k[s * QS + d]; }
                __syncthreads();
#pragma unroll
                for (int i = 0; i < 8; ++i) Cm[(v0 + i) * QS + d] = acc[i];
                if (tid < 128) nn[d] = nacc;
                if (tid == 0) gm[0] = gb[63] + gM[63];
            }
            __syncthreads();
        }
    }
}

typedef short s16x4 __attribute__((ext_vector_type(4)));
typedef short sbf16x8 __attribute__((ext_vector_type(8)));
#define TR16(p) __builtin_amdgcn_ds_read_tr16_b64_v4i16((LAS s16x4*)(p))
__device__ __forceinline__ sbf16x8 cat4(s16x4 a, s16x4 b) { return __builtin_shufflevector(a, b, 0, 1, 2, 3, 4, 5, 6, 7); }
__device__ __forceinline__ f32x4 mfma16(sbf16x8 a, sbf16x8 b, f32x4 c) { return __builtin_amdgcn_mfma_f32_16x16x32_bf16(a, b, c, 0, 0, 0); }
__device__ __forceinline__ sbf16x8 pack8s(float a0, float a1, float a2, float a3, float a4, float a5, float a6, float a7) {
    v4u w; w.x = pg8::cvt_pk_bf16(a0, a1); w.y = pg8::cvt_pk_bf16(a2, a3); w.z = pg8::cvt_pk_bf16(a4, a5); w.w = pg8::cvt_pk_bf16(a6, a7); return __builtin_bit_cast(sbf16x8, w); }
__device__ __forceinline__ float bf_s(short x) { return __builtin_bit_cast(float, ((unsigned)(unsigned short)x) << 16); }
template <int NSB>
__device__ __forceinline__ void scan_chunk_body(LAS unsigned char* Qs, LAS unsigned char* Ks, LAS unsigned char* Vs, LAS unsigned char* Vw, LAS unsigned char* Cr, LAS unsigned char* Cw,
                                                const LAS float* WS, const LAS float* ETS, const LAS float* WI, const LAS float* EM, const LAS unsigned short* WSB, const LAS float* DEC,
                                                const int ch, const int tb, const int vt, const int w, const int l15, const int g, const int ql, const int pl, f32x4 (&accC)[3], bf16* orow) {
            constexpr int QB = 272, VB = 80;
            const sbf16x8 ones = (sbf16x8){0x3F80, 0x3F80, 0x3F80, 0x3F80, 0x3F80, 0x3F80, 0x3F80, 0x3F80};
            sbf16x8 qf[4];
#pragma unroll
            for (int kd = 0; kd < 4; ++kd) qf[kd] = *(const LAS sbf16x8*)(Qs + (tb * 16 + l15) * QB + (32 * kd + 8 * g) * 2);
            const int tt = tb * 16 + l15;
            const float ets = ETS[ch * 64 + tt];
            float P[4][4];
            {
                sbf16x8 kf[NSB][4]; f32x4 sacc[NSB];
#pragma unroll
                for (int sb = 0; sb < NSB; ++sb) { sacc[sb] = (f32x4){0.f, 0.f, 0.f, 0.f};
#pragma unroll
                    for (int kd = 0; kd < 4; ++kd) kf[sb][kd] = *(const LAS sbf16x8*)(Ks + (sb * 16 + l15) * QB + (32 * kd + 8 * g) * 2); }
#pragma unroll
                for (int kd = 0; kd < 4; ++kd)
#pragma unroll
                    for (int sb = 0; sb < NSB; ++sb) sacc[sb] = mfma16(kf[sb][kd], qf[kd], sacc[sb]);
#pragma unroll
                for (int sb = 0; sb < 4; ++sb) {
                    if (sb < NSB) { const f32x4 wv = *(const LAS f32x4*)(WS + ch * 64 + sb * 16 + 4 * g);
#pragma unroll
                        for (int r = 0; r < 4; ++r) P[sb][r] = ((sb * 16 + 4 * g + r) <= tt) ? sacc[sb < NSB ? sb : 0][r] * wv[r] * ets : 0.f; }
                    else {
#pragma unroll
                        for (int r = 0; r < 4; ++r) P[sb][r] = 0.f; }
                }
            }
            f32x4 pv = (f32x4){0.f, 0.f, 0.f, 0.f}, qc = pv, qn = pv, psum = pv;
#pragma unroll
            for (int ks = 0; ks < 2; ++ks) {
                const sbf16x8 pf = pack8s(P[2 * ks][0], P[2 * ks][1], P[2 * ks][2], P[2 * ks][3], P[2 * ks + 1][0], P[2 * ks + 1][1], P[2 * ks + 1][2], P[2 * ks + 1][3]);
                const s16x4 v0 = TR16(Vs + (32 * ks + 4 * g + ql) * VB + (16 * vt + 4 * pl) * 2), v1 = TR16(Vs + (32 * ks + 16 + 4 * g + ql) * VB + (16 * vt + 4 * pl) * 2);
                pv = mfma16(pf, cat4(v0, v1), pv); psum = mfma16(pf, ones, psum);
            }
#pragma unroll
            for (int kd = 0; kd < 4; ++kd) {
                const sbf16x8 cf = *(const LAS sbf16x8*)(Cr + (16 * vt + l15) * QB + (32 * kd + 8 * g) * 2);
                const sbf16x8 nf = *(const LAS sbf16x8*)(Cr + (32 + l15) * QB + (32 * kd + 8 * g) * 2);
                qc = mfma16(qf[kd], cf, qc); qn = mfma16(qf[kd], nf, qn);
            }
            {
                const f32x4 wiv = *(const LAS f32x4*)(WI + ch * 64 + tb * 16 + 4 * g), emv = *(const LAS f32x4*)(EM + ch * 64 + tb * 16 + 4 * g);
#pragma unroll
                for (int r = 0; r < 4; ++r) { const float den = psum[r] + wiv[r] * qn[r], num = pv[r] + wiv[r] * qc[r]; orow[(size_t)r * D] = (bf16)f2bf(num * __builtin_amdgcn_rcpf(fmaxf(fabsf(den), emv[r]))); }
            }
            const float decay = DEC[ch];
#pragma unroll
            for (int v = 0; v < 3; ++v) accC[v] = accC[v] * decay;
#pragma unroll
            for (int ks = 0; ks < 2; ++ks) {
                const int sr = 32 * ks + 8 * g;
                const s16x4 k0 = TR16(Ks + (sr + ql) * QB + (16 * w + 4 * pl) * 2), k1 = TR16(Ks + (sr + 4 + ql) * QB + (16 * w + 4 * pl) * 2);
                const sbf16x8 kf = cat4(k0, k1);
#pragma unroll
                for (int v = 0; v < 2; ++v) {
                    const s16x4 x0 = TR16(Vw + (sr + ql) * VB + (16 * v + 4 * pl) * 2), x1 = TR16(Vw + (sr + 4 + ql) * VB + (16 * v + 4 * pl) * 2);
                    accC[v] = mfma16(kf, cat4(x0, x1), accC[v]);
                }
                const sbf16x8 of = *(const LAS sbf16x8*)(WSB + ch * 64 + sr);
                accC[2] = mfma16(kf, of, accC[2]);
            }
#pragma unroll
            for (int v = 0; v < 3; ++v) { v2u o; o.x = pg8::cvt_pk_bf16(accC[v][0], accC[v][1]); o.y = pg8::cvt_pk_bf16(accC[v][2], accC[v][3]); *(LAS v2u*)(Cw + (16 * v + l15) * QB + (16 * w + 4 * g) * 2) = o; }
}
__device__ __forceinline__ void p_scan_mfma(Frame& F, int j, bf16* HS) {
    constexpr int QB = 272, VB = 80;
    constexpr int OFF_Q = 0, OFF_K = 2 * 64 * QB, OFF_V = 4 * 64 * QB, OFF_VW = OFF_V + 2 * 64 * VB, OFF_C = OFF_VW + 2 * 64 * VB;
    constexpr int OFF_WS = OFF_C + 2 * 48 * QB, OFF_ETS = OFF_WS + 8192, OFF_WI = OFF_ETS + 8192, OFF_EM = OFF_WI + 8192, OFF_WSB = OFF_EM + 8192, OFF_DEC = OFF_WSB + 4096, OFF_PM63 = OFF_DEC + 128, OFF_B63 = OFF_PM63 + 128;
    static_assert(OFF_B63 + 128 <= LDSCTL_OFF, "scan LDS map");
    LAS unsigned char* L = F.lds;
    const int tid = F.tid, lane = F.lane, w = F.wave, l15 = lane & 15, g = lane >> 4, ql = l15 >> 2, pl = l15 & 3, tb = w & 3, vt = w >> 2;
    LAS float* WS = (LAS float*)(L + OFF_WS); LAS float* ETS = (LAS float*)(L + OFF_ETS); LAS float* WI = (LAS float*)(L + OFF_WI); LAS float* EM = (LAS float*)(L + OFF_EM);
    LAS unsigned short* WSB = (LAS unsigned short*)(L + OFF_WSB); LAS float* DEC = (LAS float*)(L + OFF_DEC); LAS float* PM63 = (LAS float*)(L + OFF_PM63); LAS float* B63 = (LAS float*)(L + OFF_B63);
    const bf16* PROJ = (const bf16*)(F.ws + WS_PROJ);
    const float* GATES = (const float*)(F.ws + WS_GATES);
    const float* bg = KIN(I_MBG) + j * 8;
    const float scale = 0.08838834764831845f;
    const sbf16x8 ones = (sbf16x8){0x3F80, 0x3F80, 0x3F80, 0x3F80, 0x3F80, 0x3F80, 0x3F80, 0x3F80};
    for (int item0 = blockIdx.x; item0 < 256; item0 += F.G) {
        const int item = (((item0 & 7) * 4 + (item0 >> 6)) << 3) | ((item0 >> 3) & 7);
        const int b = item >> 5, hd = (item >> 3) & 3, vs = item & 7;
        const float bi = bg[hd], bfg = bg[4 + hd];
        const bf16* qbase = PROJ + (size_t)(b * SEQ) * NPROJ + hd * 128;
        const bf16* vbase = PROJ + (size_t)(b * SEQ) * NPROJ + 1024 + hd * 256 + vs * 32;
        const float* gbase = GATES + (size_t)(b * SEQ) * 8 + hd;
#ifdef SCAN_ZERO_LDS
        for (int i = tid; i < (OFF_B63 + 128) / 4; i += NTHR) ((LAS unsigned*)L)[i] = 0u;
        __syncthreads();
#endif
        for (int i = tid; i < 48 * QB / 4; i += NTHR) ((LAS unsigned*)(L + OFF_C))[i] = 0u;
#pragma unroll
        for (int cc = 0; cc < 4; ++cc) {
            const int c = 4 * w + cc, pos = c * 64 + lane;
            const float ipre = gbase[(size_t)pos * 8] + bi, lf = logsigmoid_f(gbase[(size_t)pos * 8 + 4] + bfg);
            float bc = lf;
#pragma unroll
            for (int o = 1; o < 64; o <<= 1) { const float t = __shfl_up(bc, o); if (lane >= o) bc += t; }
            const float a = ipre - bc;
            float pm = a;
#pragma unroll
            for (int o = 1; o < 64; o <<= 1) { const float t = __shfl_up(pm, o); if (lane >= o) pm = fmaxf(pm, t); }
            WS[pos] = a; ETS[pos] = bc; WI[pos] = pm;
            if (lane == 63) { PM63[c] = pm; B63[c] = bc; }
        }
        __syncthreads();
        {
            float mw[4] = {0.f, 0.f, 0.f, 0.f}; float mc = 0.f;
#pragma unroll
            for (int c = 0; c < 32; ++c) { if ((c >> 2) == w) mw[c & 3] = mc; mc = B63[c] + fmaxf(mc, PM63[c]); }
#pragma unroll
            for (int cc = 0; cc < 4; ++cc) {
                const int c = 4 * w + cc, pos = c * 64 + lane; const float m_c = mw[cc];
                const float a = WS[pos], bc = ETS[pos], pm = WI[pos];
                const float M63 = fmaxf(m_c, PM63[c]), Mt = fmaxf(m_c, pm);
                const float wsv = __expf(a - M63);
                WS[pos] = wsv; WSB[pos] = (unsigned short)f2bf(wsv); ETS[pos] = __expf(M63 - Mt) * scale; WI[pos] = __expf(m_c - Mt) * scale; EM[pos] = __expf(-(bc + Mt));
                if (lane == 0) DEC[c] = __expf(m_c - M63);
            }
        }
        __syncthreads();
        f32x4 accC[3];
#pragma unroll
        for (int v = 0; v < 3; ++v) accC[v] = (f32x4){0.f, 0.f, 0.f, 0.f};
        const int sr0 = tid >> 4, sc0 = (tid & 15) * 8, svr = (tid >> 2) & 63, svc = (tid & 3) * 8;
        const bf16* gq = qbase + (size_t)sr0 * NPROJ + sc0; const bf16* gv = vbase + (size_t)svr * NPROJ + svc;
        const int lq0 = sr0 * QB + sc0 * 2, lv0 = svr * VB + svc * 2;
        v4u qrA[2], krA[2], vrA = (v4u){0u, 0u, 0u, 0u}, qrB[2], krB[2], vrB = (v4u){0u, 0u, 0u, 0u};
#define SCAN_LOAD(QR, KR, VR, chn) do { const size_t nro = (size_t)((chn) * 64) * NPROJ; \
            _Pragma("unroll") for (int i = 0; i < 2; ++i) { QR[i] = *(const v4u*)(gq + nro + (size_t)(32 * i) * NPROJ); KR[i] = *(const v4u*)(gq + nro + (size_t)(32 * i) * NPROJ + 512); } \
            if (tid < 256) VR = *(const v4u*)(gv + nro); } while (0)
#define SCAN_STAGE(buf, chn, QR, KR, VR) do { \
            _Pragma("unroll") for (int i = 0; i < 2; ++i) { *(LAS v4u*)(L + OFF_Q + (buf) * 64 * QB + lq0 + 32 * i * QB) = QR[i]; *(LAS v4u*)(L + OFF_K + (buf) * 64 * QB + lq0 + 32 * i * QB) = KR[i]; } \
            if (tid < 256) { *(LAS v4u*)(L + OFF_V + (buf) * 64 * VB + lv0) = VR; const float wsr = WS[(chn) * 64 + svr]; \
                v4u sw; sw.x = pg8::cvt_pk_bf16(bflo(VR.x) * wsr, bfhi(VR.x) * wsr); sw.y = pg8::cvt_pk_bf16(bflo(VR.y) * wsr, bfhi(VR.y) * wsr); sw.z = pg8::cvt_pk_bf16(bflo(VR.z) * wsr, bfhi(VR.z) * wsr); sw.w = pg8::cvt_pk_bf16(bflo(VR.w) * wsr, bfhi(VR.w) * wsr); \
                *(LAS v4u*)(L + OFF_VW + (buf) * 64 * VB + lv0) = sw; } } while (0)
#define SCAN_ITER(chv, cb, LQ, LK, LV, WQ, WK, WV) do { const int ch = (chv); constexpr int nb = (cb) ^ 1; \
            LAS unsigned char* Qs = L + OFF_Q + (cb) * 64 * QB; LAS unsigned char* Ks = L + OFF_K + (cb) * 64 * QB; LAS unsigned char* Vs = L + OFF_V + (cb) * 64 * VB; LAS unsigned char* Vw = L + OFF_VW + (cb) * 64 * VB; \
            LAS unsigned char* Cr = L + OFF_C + (cb) * 48 * QB; LAS unsigned char* Cw = L + OFF_C + nb * 48 * QB; \
            SCAN_LOAD(LQ, LK, LV, (ch < 30 ? ch + 2 : 31));              \
            { bf16* orow = obase + (size_t)(ch * 64) * D; \
              if (tb == 0) scan_chunk_body<1>(Qs, Ks, Vs, Vw, Cr, Cw, WS, ETS, WI, EM, WSB, DEC, ch, tb, vt, w, l15, g, ql, pl, accC, orow); \
              else if (tb == 1) scan_chunk_body<2>(Qs, Ks, Vs, Vw, Cr, Cw, WS, ETS, WI, EM, WSB, DEC, ch, tb, vt, w, l15, g, ql, pl, accC, orow); \
              else if (tb == 2) scan_chunk_body<3>(Qs, Ks, Vs, Vw, Cr, Cw, WS, ETS, WI, EM, WSB, DEC, ch, tb, vt, w, l15, g, ql, pl, accC, orow); \
              else scan_chunk_body<4>(Qs, Ks, Vs, Vw, Cr, Cw, WS, ETS, WI, EM, WSB, DEC, ch, tb, vt, w, l15, g, ql, pl, accC, orow); } \
            SCAN_STAGE(nb, (ch < 31 ? ch + 1 : ch), WQ, WK, WV); \
            __syncthreads(); } while (0)
        SCAN_LOAD(qrA, krA, vrA, 0);
        SCAN_STAGE(0, 0, qrA, krA, vrA);
        SCAN_LOAD(qrA, krA, vrA, 1);
        __syncthreads();
        bf16* obase = HS + (size_t)(b * SEQ + tb * 16 + 4 * g) * D + hd * 256 + vs * 32 + vt * 16 + l15;
        for (int c2 = 0; c2 < 32; c2 += 2) {
            SCAN_ITER(c2, 0, qrB, krB, vrB, qrA, krA, vrA);
            SCAN_ITER(c2 + 1, 1, qrA, krA, vrA, qrB, krB, vrB);
        }
#undef SCAN_ITER
#undef SCAN_LOAD
#undef SCAN_STAGE
    }
}

__device__ __forceinline__ void p_mnorm(Frame& F, int j) {
    const bf16* HS = (const bf16*)(F.ws + WS_HS); const bf16* PROJ = (const bf16*)(F.ws + WS_PROJ); bf16* A2 = (bf16*)(F.ws + WS_A2);
    const float* ng = KIN(I_MNORMG) + j * 1024;
    const int gw = blockIdx.x * NWAVES + F.wave, NGW = F.G * NWAVES, lane = F.lane;
    f32x4 g[4];
#pragma unroll
    for (int hd = 0; hd < 4; ++hd) g[hd] = *((const f32x4*)ng + lane + 64 * hd);
    for (int row0 = gw * 2; row0 < NTOK; row0 += NGW * 2) {
        f32x4 v[2][4]; v2u ow[2][4];
#pragma unroll
        for (int r = 0; r < 2; ++r)
#pragma unroll
            for (int hd = 0; hd < 4; ++hd) { const v2u hw = *((const v2u*)(HS + (size_t)(row0 + r) * D) + lane + 64 * hd); v[r][hd] = (f32x4){bflo(hw.x), bfhi(hw.x), bflo(hw.y), bfhi(hw.y)}; ow[r][hd] = *((const v2u*)(PROJ + (size_t)(row0 + r) * NPROJ + 2048) + lane + 64 * hd); }
#pragma unroll
        for (int r = 0; r < 2; ++r)
#pragma unroll
            for (int hd = 0; hd < 4; ++hd) {
                const f32x4 x = v[r][hd];
                const float ss = wave_sum((x[0] * x[0] + x[1] * x[1]) + (x[2] * x[2] + x[3] * x[3]));
                const float rinv = 1.0f / sqrtf(ss * (1.0f / 256.0f) + EPS);
                const float o0 = bflo(ow[r][hd].x), o1 = bfhi(ow[r][hd].x), o2 = bflo(ow[r][hd].y), o3 = bfhi(ow[r][hd].y);
                f32x4 q;
                q[0] = x[0] * rinv * g[hd][0] * __builtin_amdgcn_rcpf(1.0f + __expf(-o0)); q[1] = x[1] * rinv * g[hd][1] * __builtin_amdgcn_rcpf(1.0f + __expf(-o1));
                q[2] = x[2] * rinv * g[hd][2] * __builtin_amdgcn_rcpf(1.0f + __expf(-o2)); q[3] = x[3] * rinv * g[hd][3] * __builtin_amdgcn_rcpf(1.0f + __expf(-o3));
                v2u o; o.x = pk2(q[0], q[1]); o.y = pk2(q[2], q[3]);
                *((v2u*)(A2 + (size_t)(row0 + r) * D) + lane + 64 * hd) = o;
            }
    }
}

__device__ __forceinline__ void p_conv(Frame& F, int j) {
    const bf16* PROJ = (const bf16*)(F.ws + WS_PROJ); bf16* A2 = (bf16*)(F.ws + WS_A2);
    const float* cw = KIN(I_SCONVW) + (size_t)j * 3 * 1024;
    for (int item = blockIdx.x * NTHR + F.tid; item < (NTOK / 16) * 128; item += F.G * NTHR) {
        const int cg = item & 127, rc = item >> 7, row0 = rc * 16, ch = cg * 8;
        float w0[8], w1[8], w2[8], um2[8], um1[8];
#pragma unroll
        for (int c = 0; c < 8; ++c) { w0[c] = cw[ch + c]; w1[c] = cw[1024 + ch + c]; w2[c] = cw[2048 + ch + c]; um2[c] = 0.f; um1[c] = 0.f; }
        if ((row0 & (SEQ - 1)) != 0) {
            const v4u a = *(const v4u*)(PROJ + (size_t)(row0 - 2) * NPROJ + ch), bq = *(const v4u*)(PROJ + (size_t)(row0 - 1) * NPROJ + ch);
            um2[0] = bflo(a.x); um2[1] = bfhi(a.x); um2[2] = bflo(a.y); um2[3] = bfhi(a.y); um2[4] = bflo(a.z); um2[5] = bfhi(a.z); um2[6] = bflo(a.w); um2[7] = bfhi(a.w);
            um1[0] = bflo(bq.x); um1[1] = bfhi(bq.x); um1[2] = bflo(bq.y); um1[3] = bfhi(bq.y); um1[4] = bflo(bq.z); um1[5] = bfhi(bq.z); um1[6] = bflo(bq.w); um1[7] = bfhi(bq.w);
        }
        for (int r = 0; r < 16; ++r) {
            const v4u uw = *(const v4u*)(PROJ + (size_t)(row0 + r) * NPROJ + ch), gw = *(const v4u*)(PROJ + (size_t)(row0 + r) * NPROJ + 1024 + ch);
            float u0[8], g[8], y[8];
            u0[0] = bflo(uw.x); u0[1] = bfhi(uw.x); u0[2] = bflo(uw.y); u0[3] = bfhi(uw.y); u0[4] = bflo(uw.z); u0[5] = bfhi(uw.z); u0[6] = bflo(uw.w); u0[7] = bfhi(uw.w);
            g[0] = bflo(gw.x); g[1] = bfhi(gw.x); g[2] = bflo(gw.y); g[3] = bfhi(gw.y); g[4] = bflo(gw.z); g[5] = bfhi(gw.z); g[6] = bflo(gw.w); g[7] = bfhi(gw.w);
#pragma unroll
            for (int c = 0; c < 8; ++c) { y[c] = g[c] * (w0[c] * um2[c] + w1[c] * um1[c] + w2[c] * u0[c]); um2[c] = um1[c]; um1[c] = u0[c]; }
            v4u o; o.x = pk2(y[0], y[1]); o.y = pk2(y[2], y[3]); o.z = pk2(y[4], y[5]); o.w = pk2(y[6], y[7]);
            *(v4u*)(A2 + (size_t)(row0 + r) * D + ch) = o;
        }
    }
}

constexpr int N_STEPS = 2 + 2 * (8 + 7);
__global__ void __launch_bounds__(NTHR, 2) trunk_fwd(Args args) {
    extern __shared__ __attribute__((aligned(16))) unsigned char lds_raw[];
    Frame F;
    F.lds = (LAS unsigned char*)lds_raw;
    F.LC = (volatile LAS unsigned*)(F.lds + LDSCTL_OFF);
    F.tid = threadIdx.x; F.lane = F.tid & 63; F.wave = __builtin_amdgcn_readfirstlane(F.tid >> 6); F.G = gridDim.x;
    F.out = as_global(args.out); F.ws = as_global(args.ws); F.ctl = as_global((unsigned*)(args.ws + WS_CTL));
    for (int u = F.tid; u < 256; u += NTHR) F.LC[u] = 0u;
    __syncthreads();
    if (!N_LAUNCH_SPLIT) (void)xcd_barrier_post(F.ctl + CW_BAR, F.LC);
    const int lo = N_LAUNCH_SPLIT ? args.ph_lo : 0, hi = N_LAUNCH_SPLIT ? args.ph_hi : N_STEPS;
    int step = 0;
#ifndef EN_MASK
#define EN_MASK 0xFFFFFFFFu
#endif
#define EN(k) (((EN_MASK) >> (k)) & 1u)
#ifndef OUTPROJ_WGM
#define OUTPROJ_WGM 4
#endif
#ifndef INPROJ_WGM
#define INPROJ_WGM 4
#endif
#ifndef MOE_WGM
#define MOE_WGM 4
#endif
#ifndef BAR_REP
#define BAR_REP 0
#endif
#ifndef REP_MASK
#define REP_MASK 0u
#endif
#define REP(k) for (int _r = 0; _r < 1 + (int)(((REP_MASK) >> (k)) & 1u); ++_r)
#define IN_STEP() (lo <= step && step < hi)
#define END_STEP() do { if (!N_LAUNCH_SPLIT) { XcdBarrier _b; _b.bar = (unsigned*)launder(F.ws) + CW_BAR; _b.x = xb_xcc_id(); _b.st = F.LC; xcd_barrier(_b); if (BAR_REP) xcd_barrier(_b); } ++step; } while (0)
#define X (launder(F.out))
#define WSB (launder(F.ws))
#define XS ((bf16*)(WSB + WS_X))
#define MOD ((const float*)(WSB + WS_MOD))
#define H ((bf16*)(WSB + WS_H))
#define PROJ ((bf16*)(WSB + WS_PROJ))
#define A2 ((bf16*)(WSB + WS_A2))

    if (EN(0) && IN_STEP()) { Frame P = fresh(F); REP(15) { p_adaln(P); __syncthreads(); } REP(0) { p_convert(P); } } END_STEP();
    if (EN(1) && IN_STEP()) REP(1) { Frame P = fresh(F); row_phase<false, 1, false, true>(P, KIN(I_X), nullptr, MOD, KIN(I_NORMG), nullptr, 0, KIN(I_MWIN), nullptr, nullptr, nullptr, 0); } END_STEP();

    for (int l = 0; l < DEPTH; ++l) {
        const int lp = l >> 1;
        if ((l & 1) == 0) {
            if (EN(2) && IN_STEP()) REP(2) { pg8::DenseSched S; S.T.init(NTOK / 256, NPROJ / 256, pg8::opaque_s(F.G), pg8::opaque_s((int)blockIdx.x), INPROJ_WGM); S.A = (const char*)H; S.Bt = (const char*)(WSB + WS_WMIN) + (size_t)lp * 3072 * 1024 * 2; S.K = 1024;
                pg8::EpiStoreBf16 E{PROJ, NPROJ, 1.0f}; pg8::gemm_phase<pg8::EpiStoreBf16, pg8::DenseSched, true>(F.lds, 1024, S, E); } END_STEP();
            if (EN(3) && IN_STEP()) REP(3) { Frame P = fresh(F); p_scan_mfma(P, lp, (bf16*)(P.ws + WS_HS));
#ifdef SCAN_SELFCHECK
                { float* H1 = (float*)(P.ws + WS_HMID); float* H2 = (float*)(P.ws + WS_END);
                  __syncthreads(); p_scan_mfma(P, lp, H1); __syncthreads(); p_scan_mfma(P, lp, H2); asm volatile("s_waitcnt vmcnt(0)" ::: "memory"); __syncthreads();
                  for (int item = blockIdx.x; item < 256; item += P.G) { const int b = item >> 5, hd = (item >> 3) & 3, vs = item & 7; int bad = 0;
                      for (int i = P.tid; i < 2048 * 32; i += NTHR) { const size_t o = (size_t)(b * SEQ + (i >> 5)) * D + hd * 256 + vs * 32 + (i & 31);
                          const unsigned a1 = __hip_atomic_load((const unsigned*)H1 + o, __ATOMIC_RELAXED, __HIP_MEMORY_SCOPE_AGENT), a2 = __hip_atomic_load((const unsigned*)H2 + o, __ATOMIC_RELAXED, __HIP_MEMORY_SCOPE_AGENT); if (a1 != a2) bad = 1; }
                      if (bad) __hip_atomic_fetch_or(P.ctl + 64, 1u, __ATOMIC_RELAXED, __HIP_MEMORY_SCOPE_AGENT); } }
#endif
#ifdef SCAN_BOTH
                __syncthreads(); p_scan(P, lp);
#endif
            } END_STEP();
            if (EN(4) && IN_STEP()) REP(4) { Frame P = fresh(F); p_mnorm(P, lp); } END_STEP();
            if (EN(5) && IN_STEP()) REP(5) { pg8::DenseSched S; S.T.init(NTOK / 256, 4, pg8::opaque_s(F.G), pg8::opaque_s((int)blockIdx.x), OUTPROJ_WGM); S.A = (const char*)A2; S.Bt = (const char*)(WSB + WS_WMOUT) + (size_t)lp * 1024 * 1024 * 2; S.K = 1024;
                pg8::EpiResid E{l == 0 ? KIN(I_X) : (const float*)nullptr, XS, MOD + (size_t)(l * 2) * 8 * 3072 + 2048}; pg8::gemm_phase<pg8::EpiResid, pg8::DenseSched, true>(F.lds, 1024, S, E); } END_STEP();
        } else {
            if (EN(10) && IN_STEP()) REP(10) { pg8::DenseSched S; S.T.init(NTOK / 256, NPROJ / 256, pg8::opaque_s(F.G), pg8::opaque_s((int)blockIdx.x), INPROJ_WGM); S.A = (const char*)H; S.Bt = (const char*)(WSB + WS_WSIN) + (size_t)lp * 3072 * 1024 * 2; S.K = 1024;
                pg8::EpiConvIn E{PROJ, NPROJ}; pg8::gemm_phase<pg8::EpiConvIn, pg8::DenseSched, true>(F.lds, 1024, S, E); } END_STEP();
            if (EN(11) && IN_STEP()) REP(11) { Frame P = fresh(F); p_conv(P, lp); } END_STEP();
            if (EN(12) && IN_STEP()) REP(12) { pg8::DenseSched S; S.T.init(NTOK / 256, 4, pg8::opaque_s(F.G), pg8::opaque_s((int)blockIdx.x), OUTPROJ_WGM); S.A = (const char*)A2; S.Bt = (const char*)(WSB + WS_WSOUT) + (size_t)lp * 1024 * 1024 * 2; S.K = 1024;
                pg8::EpiResid E{nullptr, XS, MOD + (size_t)(l * 2) * 8 * 3072 + 2048}; pg8::gemm_phase<pg8::EpiResid, pg8::DenseSched, true>(F.lds, 1024, S, E); } END_STEP();
        }
        if (EN(6) && IN_STEP()) REP(6) { Frame P = fresh(F); row_phase<false, 2, false>(P, XS, nullptr, MOD + (size_t)(l * 2 + 1) * 8 * 3072, KIN(I_NORMG) + (l * 2 + 1) * 1024, nullptr, 0,
                                                  KIN(I_RWG) + (size_t)l * 1024 * 4, KIN(I_RWE) + (size_t)l * 1024 * 32, KIN(I_RBG) + l * 4, KIN(I_RBE) + l * 32, l + 4 * _r); } END_STEP();
        if (EN(7) && IN_STEP()) REP(7) { Frame P = fresh(F); moe_tables(P, l); pg8::GuSched S; S.T.init((int)F.LC[LC_TOFF + 32], 4, pg8::opaque_s(F.G), pg8::opaque_s((int)blockIdx.x), MOE_WGM); S.A = (const char*)H; S.K = 512; S.Bt = (const char*)(WSB + WS_WGU) + (size_t)l * 32 * 1024 * 1024;
            S.slot_tok = (const int*)(WSB + WS_SLOTTOK); S.toff = (const PG8_LAS int*)(F.lds + LDSCTL_OFF + LC_TOFF * 4); S.cnt = (const PG8_LAS int*)(F.lds + LDSCTL_OFF + LC_CNT * 4); S.soff = (const PG8_LAS int*)(F.lds + LDSCTL_OFF + LC_SOFF * 4); S.sexp = (const PG8_LAS int*)(F.lds + LDSCTL_OFF + LC_SEXP * 4);
            pg8::EpiGateUp E{(unsigned char*)(WSB + WS_HMID)}; pg8::gemm_phase<pg8::EpiGateUp, pg8::GuSched, true, true>(F.lds, 512, S, E); } END_STEP();
        if (EN(8) && IN_STEP()) REP(8) { Frame P = fresh(F); moe_tables(P, l); pg8::DnSched S; S.T.init((int)F.LC[LC_TOFF + 32], 4, pg8::opaque_s(F.G), pg8::opaque_s((int)blockIdx.x), MOE_WGM); S.A = (const char*)(WSB + WS_HMID); S.K = 256; S.Bt = (const char*)(WSB + WS_WDN) + (size_t)l * 32 * 1024 * 512;
            S.toff = (const PG8_LAS int*)(F.lds + LDSCTL_OFF + LC_TOFF * 4); S.soff = (const PG8_LAS int*)(F.lds + LDSCTL_OFF + LC_SOFF * 4); S.sexp = (const PG8_LAS int*)(F.lds + LDSCTL_OFF + LC_SEXP * 4);
            pg8::EpiStoreBf16 E{(bf16*)(WSB + WS_YR), 1024, pg8::W8_INV}; pg8::gemm_phase<pg8::EpiStoreBf16, pg8::DnSched, true, true>(F.lds, 256, S, E); } END_STEP();
        if (l == 3) {
            if (EN(14) && IN_STEP()) REP(14) { Frame P = fresh(F); row_phase<true, 0, true>(P, XS, X, nullptr, KIN(I_FINALG), MOD + (size_t)(l * 2 + 1) * 8 * 3072, l, nullptr, nullptr, nullptr, nullptr, 0); } ++step;
        } else if (l == 1) {
            if (EN(13) && IN_STEP()) REP(13) { Frame P = fresh(F); row_phase<true, 1, false>(P, XS, XS, MOD + (size_t)((l + 1) * 2) * 8 * 3072, KIN(I_NORMG) + ((l + 1) * 2) * 1024, MOD + (size_t)(l * 2 + 1) * 8 * 3072, l,
                                                     KIN(I_MWIN) + (size_t)1 * 1024 * M_PROJ, nullptr, nullptr, nullptr, 0); } END_STEP();
        } else {
            if (EN(9) && IN_STEP()) REP(9) { Frame P = fresh(F); row_phase<true, 0, false>(P, XS, XS, MOD + (size_t)((l + 1) * 2) * 8 * 3072, KIN(I_NORMG) + ((l + 1) * 2) * 1024, MOD + (size_t)(l * 2 + 1) * 8 * 3072, l, nullptr, nullptr, nullptr, nullptr, 0); } END_STEP();
        }
    }
#undef IN_STEP
#undef END_STEP
#undef X
#undef WSB
#undef XS
#undef MOD
#undef H
#undef PROJ
#undef A2
}

extern "C" void kernel_launch(void* const* d_in, const int* in_sizes, int n_in, void* d_out, int out_size, void* d_ws, size_t ws_size, hipStream_t stream) {
    static int grid = 0;
    if (grid == 0) {
        if (n_in != 20 || in_sizes[0] != NTOK * D || out_size != NTOK * D || ws_size < WS_END) { fprintf(stderr, "kernel_launch: unexpected shapes (n_in %d, ws %zu)\n", n_in, ws_size); grid = -1; return; }
        int dev = 0, cus = 0, per_cu = 0;
        if (hipGetDevice(&dev) != hipSuccess || hipDeviceGetAttribute(&cus, hipDeviceAttributeMultiprocessorCount, dev) != hipSuccess) { grid = -1; return; }
        if (hipFuncSetAttribute((const void*)trunk_fwd, hipFuncAttributeMaxDynamicSharedMemorySize, LDS_BYTES) != hipSuccess) { fprintf(stderr, "kernel_launch: hipFuncSetAttribute failed\n"); grid = -1; return; }
        if (hipOccupancyMaxActiveBlocksPerMultiprocessor(&per_cu, (const void*)trunk_fwd, NTHR, LDS_BYTES) != hipSuccess || per_cu < 1) fprintf(stderr, "kernel_launch: occupancy query reports %d\n", per_cu);
        (void)hipGetLastError();
        grid = cus;
    }
    if (grid < 0) return;
    if (hipMemsetAsync((char*)d_ws + WS_CTL, 0, CTL_ZERO_BYTES, stream) != hipSuccess) return;
    Args a{};
    for (int i = 0; i < 20; ++i) a.in[i] = (const float*)d_in[i];
    a.out = (float*)d_out; a.ws = (unsigned char*)d_ws;
    if (N_LAUNCH_SPLIT) {
        for (int s = 0; s < N_STEPS; ++s) { a.ph_lo = s; a.ph_hi = s + 1; hipLaunchKernelGGL(trunk_fwd, dim3(grid), dim3(NTHR), LDS_BYTES, stream, a); }
    } else {
        a.ph_lo = 0; a.ph_hi = N_STEPS; hipLaunchKernelGGL(trunk_fwd, dim3(grid), dim3(NTHR), LDS_BYTES, stream, a);
    }
}
```

```cpp
#include <hip/hip_runtime.h>
#include <cstdio>
#include <cstdint>

#ifndef SCAN_MFMA
#define SCAN_MFMA 1
#endif
#ifndef N_LAUNCH_SPLIT
#define N_LAUNCH_SPLIT 0
#endif

namespace pg8 {
#define PG8_LAS __attribute__((address_space(3)))
typedef unsigned short bf16_t;
typedef short bf16x8 __attribute__((ext_vector_type(8)));
typedef float f32x4 __attribute__((ext_vector_type(4)));
typedef unsigned u32x4 __attribute__((ext_vector_type(4)));
constexpr int BM = 256, BK = 64, HALF = 128, HTB = HALF * BK * 2, STAGE_BYTES = 8 * HTB, NXCD = 8, WGM = 8;

__host__ __device__ __forceinline__ int lds_byte(int r, int c) { const int st = (r >> 4) * 2 + (c >> 5), rr = r & 15, cc = c & 31, ob = rr * 64 + cc * 2; return st * 1024 + (ob ^ (((ob >> 9) & 1) << 5)); }
__host__ __device__ __forceinline__ void stage_rc(int b, int& R, int& C) { const int st = b / 1024, sb = b % 1024, swz = sb ^ (((sb >> 9) & 1) << 5); R = (st >> 1) * 16 + swz / 64; C = (st & 1) * 32 + (swz % 64) / 2; }
__host__ __device__ __forceinline__ int perm32(int rho) { const int n = rho >> 4, i = rho & 15; return 8 * (i >> 2) + 4 * n + (i & 3); }

__device__ __forceinline__ int opaque_v(int x) { asm volatile("" : "+v"(x)); return x; }
__device__ __forceinline__ int opaque_s(int x) { asm volatile("" : "+s"(x)); return x; }
struct Unit { int pm, pn, e, r0, half; };

struct TileOrder {
    int nM, nN, nwg, G, c, wgm;
    __device__ __forceinline__ void init(int nM_, int nN_, int G_, int c_, int wgm_ = WGM) { nM = nM_; nN = nN_; nwg = nM * nN; G = G_; c = c_; wgm = wgm_; }
    __device__ __forceinline__ bool map(int i, int& pm, int& pn) const {
        const long L = (long)i * G + c; if (L >= nwg) return false;
        int wgid = (int)L; { const int q = nwg / NXCD, r = nwg % NXCD, xcd = wgid % NXCD, off = wgid / NXCD; wgid = (xcd < r ? xcd * (q + 1) : r * (q + 1) + (xcd - r) * q) + off; }
        const int nig = wgm * nN, gid = wgid / nig, fm = gid * wgm, gsz = (nM - fm) < wgm ? (nM - fm) : wgm;
        pm = fm + ((wgid % nig) % gsz); pn = (wgid % nig) / gsz; return true;
    }
};
struct DenseSched {
    static constexpr bool GATHER = false;
    TileOrder T; const char* A; const char* Bt; int K;
    __device__ __forceinline__ bool next(int i, Unit& u) const { u.e = 0; u.r0 = 0; u.half = 0; return T.map(i, u.pm, u.pn); }
    __device__ __forceinline__ const char* a_base(const Unit& u) const { return A + (size_t)u.pm * 256 * K * 2; }
    __device__ __forceinline__ const char* b_base(const Unit& u) const { return Bt + (size_t)u.pn * 256 * K * 2; }
    __device__ __forceinline__ void a_voff(const Unit&, int tid, unsigned (&v)[2][2]) const {
#pragma unroll
        for (int i = 0; i < 2; ++i) { int R, C; stage_rc(tid * 16 + i * 8192, R, C); v[0][i] = (unsigned)(R * K + C) * 2u; v[1][i] = v[0][i]; }
    }
};
struct GuSched {
    static constexpr bool GATHER = true;
    TileOrder T; const char* A; const char* Bt; const int* slot_tok; const PG8_LAS int* toff; const PG8_LAS int* cnt; const PG8_LAS int* soff; const PG8_LAS int* sexp; int K;
    __device__ __forceinline__ bool next(int i, Unit& u) const {
        if (T.map(i, u.pm, u.pn)) {
            int e = 0;
#pragma unroll
            for (int j = 1; j < 32; ++j) e += (toff[j] <= u.pm) ? 1 : 0;
            u.e = e; u.r0 = (u.pm - toff[e]) * 256; u.half = 0; return true;
        }
        const long sidx = (long)i * T.G + T.c - T.nwg; if (sidx >= 4 * soff[32]) return false;
        const int t = (int)sidx >> 2; u.pn = (int)sidx & 3; u.pm = toff[32] + t; u.e = sexp[t]; u.r0 = (toff[u.e + 1] - toff[u.e]) * 256; u.half = 1; return true;
    }
    __device__ __forceinline__ const char* a_base(const Unit&) const { return A; }
    __device__ __forceinline__ const char* b_base(const Unit& u) const { return Bt + ((size_t)u.e * 1024 + (size_t)u.pn * 256) * K * 2; }
    __device__ __forceinline__ void a_voff(const Unit& u, int tid, unsigned (&v)[2][2]) const {
        const int c1 = cnt[u.e] - 1;
#pragma unroll
        for (int h = 0; h < 2; ++h)
#pragma unroll
            for (int i = 0; i < 2; ++i) { int R, C; stage_rc(tid * 16 + i * 8192, R, C); int idx = u.r0 + h * 128 + R; idx = idx < c1 ? idx : c1;
                const int tok = slot_tok[u.e * 16384 + idx]; v[h][i] = (unsigned)(tok * K + C) * 2u; }
    }
};
struct DnSched {
    static constexpr bool GATHER = false;
    TileOrder T; const char* A; const char* Bt; const PG8_LAS int* toff; const PG8_LAS int* soff; const PG8_LAS int* sexp; int K;
    __device__ __forceinline__ bool next(int i, Unit& u) const {
        u.r0 = 0;
        if (T.map(i, u.pm, u.pn)) {
            int e = 0;
#pragma unroll
            for (int j = 1; j < 32; ++j) e += (toff[j] <= u.pm) ? 1 : 0;
            u.e = e; u.half = 0; return true;
        }
        const long sidx = (long)i * T.G + T.c - T.nwg; if (sidx >= 4 * soff[32]) return false;
        const int t = (int)sidx >> 2; u.pn = (int)sidx & 3; u.pm = toff[32] + t; u.e = sexp[t]; u.half = 1; return true;
    }
    __device__ __forceinline__ const char* a_base(const Unit& u) const { return A + (size_t)u.pm * 256 * K * 2; }
    __device__ __forceinline__ const char* b_base(const Unit& u) const { return Bt + ((size_t)u.e * 1024 + (size_t)u.pn * 256) * K * 2; }
    __device__ __forceinline__ void a_voff(const Unit&, int tid, unsigned (&v)[2][2]) const {
#pragma unroll
        for (int i = 0; i < 2; ++i) { int R, C; stage_rc(tid * 16 + i * 8192, R, C); v[0][i] = (unsigned)(R * K + C) * 2u; v[1][i] = v[0][i]; }
    }
};

typedef __bf16 bf16x2_t __attribute__((ext_vector_type(2)));
__device__ __forceinline__ unsigned cvt_pk_bf16(float lo, float hi) { bf16x2_t v; v[0] = (__bf16)lo; v[1] = (__bf16)hi; return __builtin_bit_cast(unsigned, v); }
__device__ __forceinline__ u32x4 pack8(const f32x4 a, const f32x4 b) { u32x4 w; w.x = cvt_pk_bf16(a[0], a[1]); w.y = cvt_pk_bf16(a[2], a[3]); w.z = cvt_pk_bf16(b[0], b[1]); w.w = cvt_pk_bf16(b[2], b[3]); return w; }

struct EpiStoreBf16 {
    static constexpr bool PERM = true;
    bf16_t* O; int ldc; float sc;
    __device__ __forceinline__ void operator()(const f32x4 (&acc)[2][2][4][2], const Unit& u, int wr, int wc, int fr, int fq) const {
        const int row0 = u.pm * BM + wr * 64 + fr, col0 = u.pn * BM + wc * 32 + 8 * fq;
#pragma unroll
        for (int ai = 0; ai < 2; ++ai) { if (ai == 1 && u.half) break;
#pragma unroll
            for (int m = 0; m < 4; ++m) { bf16_t* rowp = O + (size_t)(row0 + ai * HALF + m * 16) * ldc + col0;
#pragma unroll
                for (int bj = 0; bj < 2; ++bj) *(u32x4*)(rowp + bj * HALF) = pack8(acc[ai][bj][m][0] * sc, acc[ai][bj][m][1] * sc); } }
    }
};
struct EpiConvIn {
    static constexpr bool PERM = true;
    bf16_t* O; int ldc;
    __device__ __forceinline__ void operator()(const f32x4 (&acc)[2][2][4][2], const Unit& u, int wr, int wc, int fr, int fq) const {
        const int row0 = u.pm * BM + wr * 64 + fr;
        if (u.pn < 8) {
            const int col0 = u.pn * HALF + wc * 32 + 8 * fq;
#pragma unroll
            for (int ai = 0; ai < 2; ++ai)
#pragma unroll
                for (int m = 0; m < 4; ++m) { bf16_t* rowp = O + (size_t)(row0 + ai * HALF + m * 16) * ldc + col0;
                    *(u32x4*)rowp = pack8(acc[ai][0][m][0] * acc[ai][1][m][0], acc[ai][0][m][1] * acc[ai][1][m][1]); }
        } else {
            const int col0 = 1024 + (u.pn - 8) * BM + wc * 32 + 8 * fq;
#pragma unroll
            for (int ai = 0; ai < 2; ++ai)
#pragma unroll
                for (int m = 0; m < 4; ++m) { bf16_t* rowp = O + (size_t)(row0 + ai * HALF + m * 16) * ldc + col0;
#pragma unroll
                    for (int bj = 0; bj < 2; ++bj) *(u32x4*)(rowp + bj * HALF) = pack8(acc[ai][bj][m][0], acc[ai][bj][m][1]); }
        }
    }
};
__device__ __forceinline__ float silu_f(float g) { return g * __builtin_amdgcn_rcpf(1.0f + __expf(-g)); }
__device__ __forceinline__ unsigned pk4_fp8(float a, float b, float c, float d) { unsigned w = 0; w = __builtin_amdgcn_cvt_pk_fp8_f32(a, b, w, false); w = __builtin_amdgcn_cvt_pk_fp8_f32(c, d, w, true); return w; }
constexpr float W8_INV = 1.0f / 32.0f;
struct EpiGateUp {
    static constexpr bool PERM = true;
    unsigned char* O;
    __device__ __forceinline__ void operator()(const f32x4 (&acc)[2][2][4][2], const Unit& u, int wr, int wc, int fr, int fq) const {
        const int row0 = u.pm * BM + wr * 64 + fr, col0 = u.pn * HALF + wc * 32 + 8 * fq;
        typedef unsigned u32x2 __attribute__((ext_vector_type(2)));
#pragma unroll
        for (int ai = 0; ai < 2; ++ai) { if (ai == 1 && u.half) break;
#pragma unroll
            for (int m = 0; m < 4; ++m) { unsigned char* rowp = O + (size_t)(row0 + ai * HALF + m * 16) * 512 + col0;
                f32x4 h0, h1;
#pragma unroll
                for (int j = 0; j < 4; ++j) { h0[j] = silu_f(acc[ai][0][m][0][j] * W8_INV) * (acc[ai][1][m][0][j] * W8_INV); h1[j] = silu_f(acc[ai][0][m][1][j] * W8_INV) * (acc[ai][1][m][1][j] * W8_INV); }
                u32x2 w; w.x = pk4_fp8(h0[0], h0[1], h0[2], h0[3]); w.y = pk4_fp8(h1[0], h1[1], h1[2], h1[3]); *(u32x2*)rowp = w; } }
    }
};
struct EpiStoreF8 {
    static constexpr bool PERM = true;
    unsigned char* O; int ldc;
    __device__ __forceinline__ void operator()(const f32x4 (&acc)[2][2][4][2], const Unit& u, int wr, int wc, int fr, int fq) const {
        const int row0 = u.pm * BM + wr * 64 + fr, col0 = u.pn * BM + wc * 32 + 8 * fq;
        typedef unsigned u32x2 __attribute__((ext_vector_type(2)));
#pragma unroll
        for (int ai = 0; ai < 2; ++ai) { if (ai == 1 && u.half) break;
#pragma unroll
            for (int m = 0; m < 4; ++m) { unsigned char* rowp = O + (size_t)(row0 + ai * HALF + m * 16) * ldc + col0;
#pragma unroll
                for (int bj = 0; bj < 2; ++bj) { u32x2 w; w.x = pk4_fp8(acc[ai][bj][m][0][0], acc[ai][bj][m][0][1], acc[ai][bj][m][0][2], acc[ai][bj][m][0][3]);
                    w.y = pk4_fp8(acc[ai][bj][m][1][0], acc[ai][bj][m][1][1], acc[ai][bj][m][1][2], acc[ai][bj][m][1][3]); *(u32x2*)(rowp + bj * HALF) = w; } } }
    }
};
struct EpiResid {
    static constexpr bool PERM = true;
    const float* xin32; bf16_t* xs; const float* gatev;
    __device__ __forceinline__ void operator()(const f32x4 (&acc)[2][2][4][2], const Unit& u, int wr, int wc, int fr, int fq) const {
        const int row0 = u.pm * BM + wr * 64 + fr, col0 = u.pn * BM + wc * 32 + 8 * fq, b = u.pm >> 3;
        f32x4 gv[2][2];
#pragma unroll
        for (int bj = 0; bj < 2; ++bj)
#pragma unroll
            for (int n = 0; n < 2; ++n) gv[bj][n] = *(const f32x4*)(gatev + b * 3072 + col0 + bj * HALF + n * 4);
#pragma unroll
        for (int ai = 0; ai < 2; ++ai)
#pragma unroll
            for (int m = 0; m < 4; ++m) { const size_t off = (size_t)(row0 + ai * HALF + m * 16) * 1024 + col0;
#pragma unroll
                for (int bj = 0; bj < 2; ++bj) {
                    f32x4 x0, x1;
                    if (xin32) { x0 = *(const f32x4*)(xin32 + off + bj * HALF); x1 = *(const f32x4*)(xin32 + off + bj * HALF + 4); }
                    else { const u32x4 w = *(const u32x4*)(xs + off + bj * HALF);
                        x0 = (f32x4){__builtin_bit_cast(float, w.x << 16), __builtin_bit_cast(float, w.x & 0xffff0000u), __builtin_bit_cast(float, w.y << 16), __builtin_bit_cast(float, w.y & 0xffff0000u)};
                        x1 = (f32x4){__builtin_bit_cast(float, w.z << 16), __builtin_bit_cast(float, w.z & 0xffff0000u), __builtin_bit_cast(float, w.w << 16), __builtin_bit_cast(float, w.w & 0xffff0000u)}; }
                    *(u32x4*)(xs + off + bj * HALF) = pack8(x0 + gv[bj][0] * acc[ai][bj][m][0], x1 + gv[bj][1] * acc[ai][bj][m][1]); } }
    }
};

typedef int i32x8 __attribute__((ext_vector_type(8)));
template <class Epi, class Sched, bool ALIGN_EPI, bool FP8 = false>
__device__ __forceinline__ void gemm_phase(PG8_LAS unsigned char* lds, const int K, const Sched& S, const Epi& E) {
    constexpr bool GATHER = Sched::GATHER;
    const int tid = opaque_v((int)threadIdx.x), wid = __builtin_amdgcn_readfirstlane(tid >> 6), lane = tid & 63, wr = wid >> 2, wc = wid & 3, fr = lane & 15, fq = lane >> 4;
    const int nt = opaque_s(K / BK);
    unsigned voffB[2];
#pragma unroll
    for (int i = 0; i < 2; ++i) { int R, C; stage_rc(tid * 16 + i * 8192, R, C); const int Rb = Epi::PERM ? ((R & ~31) + perm32(R & 31)) : R; voffB[i] = (unsigned)(Rb * K + C) * 2u; }
    const size_t kstep = (size_t)(BK * 2);
    const size_t hstepB = (size_t)HALF * K * 2;
    const size_t hstepA = GATHER ? (size_t)0 : hstepB;
    const unsigned ldsw = (unsigned)wid * 1024u;
    const int aoff = lds_byte(wr * 64 + fr, fq * 8), boff = lds_byte(wc * 32 + fr, fq * 8);
#define PG8_SA(b, h) (((b) * 2 + (h)) * HTB)
#define PG8_SB(b, h) ((4 + (b) * 2 + (h)) * HTB)
#define PG8_STAGE(bufoff, gbase, voff) do { _Pragma("unroll") for (int _i = 0; _i < 2; ++_i) \
        __builtin_amdgcn_global_load_lds((const unsigned*)((const char*)(gbase) + (voff)[_i]), (PG8_LAS unsigned*)(lds + (bufoff) + ldsw + _i * 8192), 16, 0, 0); } while (0)
#define PG8_LDA(dst, b, h) do { _Pragma("unroll") for (int m = 0; m < 4; ++m) _Pragma("unroll") for (int k = 0; k < 2; ++k) dst[m][k] = *(const PG8_LAS bf16x8*)(lds + PG8_SA(b, h) + aoff + m * 2048 + k * 1024); } while (0)
#define PG8_LDB(dst, b, h) do { _Pragma("unroll") for (int n = 0; n < 2; ++n) _Pragma("unroll") for (int k = 0; k < 2; ++k) dst[n][k] = *(const PG8_LAS bf16x8*)(lds + PG8_SB(b, h) + boff + n * 2048 + k * 1024); } while (0)
#define PG8_MMA16(ai, bj, At, Bt) do { __builtin_amdgcn_s_setprio(1); _Pragma("unroll") for (int m = 0; m < 4; ++m) _Pragma("unroll") for (int n = 0; n < 2; ++n) _Pragma("unroll") for (int k = 0; k < 2; ++k) \
        acc[ai][bj][m][n] = __builtin_amdgcn_mfma_f32_16x16x32_bf16(Bt[n][k], At[m][k], acc[ai][bj][m][n], 0, 0, 0); __builtin_amdgcn_s_setprio(0); } while (0)
#define PG8_LDA8(dst, b, h) do { _Pragma("unroll") for (int m = 0; m < 4; ++m) { const u32x4 _lo = *(const PG8_LAS u32x4*)(lds + PG8_SA(b, h) + aoff + m * 2048), _hi = *(const PG8_LAS u32x4*)(lds + PG8_SA(b, h) + aoff + m * 2048 + 1024); \
        dst[m] = __builtin_bit_cast(i32x8, __builtin_shufflevector(_lo, _hi, 0, 1, 2, 3, 4, 5, 6, 7)); } } while (0)
#define PG8_LDB8(dst, b, h) do { _Pragma("unroll") for (int n = 0; n < 2; ++n) { const u32x4 _lo = *(const PG8_LAS u32x4*)(lds + PG8_SB(b, h) + boff + n * 2048), _hi = *(const PG8_LAS u32x4*)(lds + PG8_SB(b, h) + boff + n * 2048 + 1024); \
        dst[n] = __builtin_bit_cast(i32x8, __builtin_shufflevector(_lo, _hi, 0, 1, 2, 3, 4, 5, 6, 7)); } } while (0)
#define PG8_MMA8(ai, bj, At, Bt) do { __builtin_amdgcn_s_setprio(1); asm volatile("s_nop 4"); _Pragma("unroll") for (int m = 0; m < 4; ++m) _Pragma("unroll") for (int n = 0; n < 2; ++n) \
        asm volatile("v_mfma_scale_f32_16x16x128_f8f6f4 %0, %1, %2, %0, %3, %3 op_sel_hi:[0,0,0]" : "+v"(acc[ai][bj][m][n]) : "v"(Bt[n]), "v"(At[m]), "v"(scale1)); __builtin_amdgcn_s_setprio(0); } while (0)
#define PG8_XLDA(b, h) do { if constexpr (FP8) PG8_LDA8(At8, b, h); else PG8_LDA(At, b, h); } while (0)
#define PG8_XLDB(w, b, h) do { if constexpr (FP8) PG8_LDB8(B##w##8, b, h); else PG8_LDB(B##w, b, h); } while (0)
#define PG8_XMMA(ai, bj, w) do { if constexpr (FP8) PG8_MMA8(ai, bj, At8, B##w##8); else PG8_MMA16(ai, bj, At, B##w); } while (0)
#define PG8_WAIT_V(n) asm volatile("s_waitcnt vmcnt(" #n ")" ::: "memory")
#define PG8_WAIT_L(n) asm volatile("s_waitcnt lgkmcnt(" #n ")" ::: "memory")
#define PG8_BAR __builtin_amdgcn_s_barrier()
#define PG8_SCHED __builtin_amdgcn_sched_barrier(0)
    Unit cur, nxt; int ui = 0;
    if (!S.next(0, cur)) return;
    f32x4 acc[2][2][4][2];
#pragma unroll
    for (int a = 0; a < 2; ++a)
#pragma unroll
        for (int b = 0; b < 2; ++b)
#pragma unroll
            for (int m = 0; m < 4; ++m)
#pragma unroll
                for (int n = 0; n < 2; ++n) acc[a][b][m][n] = (f32x4){0.f, 0.f, 0.f, 0.f};
    bf16x8 At[4][2], B0[2][2], B1[2][2]; i32x8 At8[4], B08[2], B18[2]; int scale1 = 0x7F7F7F7F; asm volatile("" : "+v"(scale1));
    const char* cA = S.a_base(cur); const char* cB = S.b_base(cur);
    unsigned vc[2][2], vn[2][2];
    S.a_voff(cur, tid, vc);
    PG8_STAGE(PG8_SB(0, 0), cB, voffB); PG8_STAGE(PG8_SB(0, 1), cB + hstepB, voffB); PG8_STAGE(PG8_SA(0, 0), cA, vc[0]); PG8_STAGE(PG8_SA(0, 1), cA + hstepA, vc[1]);
    if (wr == 1) PG8_BAR;
    PG8_WAIT_V(2); PG8_BAR;
    PG8_STAGE(PG8_SB(1, 0), cB + kstep, voffB); PG8_STAGE(PG8_SA(1, 0), cA + kstep, vc[0]); PG8_STAGE(PG8_SB(1, 1), cB + hstepB + kstep, voffB);
    PG8_WAIT_V(6); PG8_BAR;
    for (;;) {
        const bool has_next = S.next(ui + 1, nxt);
        const char* nA = has_next ? S.a_base(nxt) : cA; const char* nB = has_next ? S.b_base(nxt) : cB;
        if (GATHER && has_next) { S.a_voff(nxt, tid, vn); *(PG8_LAS u32x4*)(lds + STAGE_BYTES + tid * 16) = (u32x4){vn[0][0], vn[0][1], vn[1][0], vn[1][1]}; }
#pragma unroll 1
        for (int t = 0; t < nt; t += 2) {
            const bool last = (t == nt - 2);
            const char* a1 = cA + (size_t)(t + 1) * kstep;
            const char* a2 = last ? nA : cA + (size_t)(t + 2) * kstep; const char* b2 = last ? nB : cB + (size_t)(t + 2) * kstep;
            const char* a3 = a2 + kstep; const char* b3 = b2 + kstep;
            unsigned v2[2][2];
#pragma unroll
            for (int h = 0; h < 2; ++h)
#pragma unroll
                for (int i = 0; i < 2; ++i) v2[h][i] = vc[h][i];
            if (GATHER && last && has_next) { const u32x4 pk = *(const PG8_LAS u32x4*)(lds + STAGE_BYTES + tid * 16); v2[0][0] = pk[0]; v2[0][1] = pk[1]; v2[1][0] = pk[2]; v2[1][1] = pk[3]; }
            PG8_XLDB(0, 0, 0); PG8_XLDB(1, 0, 1); PG8_SCHED; PG8_XLDA(0, 0); PG8_STAGE(PG8_SA(1, 1), a1 + hstepA, vc[1]);
            PG8_WAIT_V(8); PG8_WAIT_L(0); PG8_BAR; PG8_XMMA(0, 0, 0); PG8_XMMA(0, 1, 1); PG8_BAR; PG8_SCHED;
            if (!cur.half) PG8_XLDA(0, 1); PG8_STAGE(PG8_SB(0, 0), b2, voffB); PG8_STAGE(PG8_SB(0, 1), b2 + hstepB, voffB); PG8_STAGE(PG8_SA(0, 0), a2, v2[0]);
            PG8_WAIT_V(8); PG8_WAIT_L(0); PG8_BAR; if (!cur.half) { PG8_XMMA(1, 0, 0); PG8_XMMA(1, 1, 1); } PG8_BAR; PG8_SCHED;
            PG8_XLDB(0, 1, 0); PG8_XLDB(1, 1, 1); PG8_SCHED; PG8_XLDA(1, 0); PG8_STAGE(PG8_SA(0, 1), a2 + hstepA, v2[1]);
            PG8_WAIT_V(8); PG8_WAIT_L(0); PG8_BAR; PG8_XMMA(0, 0, 0); PG8_XMMA(0, 1, 1); PG8_BAR; PG8_SCHED;
            if (!cur.half) PG8_XLDA(1, 1); PG8_STAGE(PG8_SB(1, 0), b3, voffB); PG8_STAGE(PG8_SB(1, 1), b3 + hstepB, voffB); PG8_STAGE(PG8_SA(1, 0), a3, v2[0]);
            PG8_WAIT_V(8); PG8_WAIT_L(0); PG8_BAR; if (!cur.half) { PG8_XMMA(1, 0, 0); PG8_XMMA(1, 1, 1); } PG8_BAR; PG8_SCHED;
        }
        if constexpr (ALIGN_EPI) { if (wr == 0) PG8_BAR; }
        if constexpr (FP8) asm volatile("s_nop 15\n\ts_nop 15" ::: "memory");
        E(acc, cur, wr, wc, fr, fq);
        if (!has_next) break;
#pragma unroll
        for (int a = 0; a < 2; ++a)
#pragma unroll
            for (int b = 0; b < 2; ++b)
#pragma unroll
                for (int m = 0; m < 4; ++m)
#pragma unroll
                    for (int n = 0; n < 2; ++n) acc[a][b][m][n] = (f32x4){0.f, 0.f, 0.f, 0.f};
        cur = nxt; cA = nA; cB = nB; ++ui;
        if (GATHER) { const u32x4 pk = *(const PG8_LAS u32x4*)(lds + STAGE_BYTES + tid * 16); vc[0][0] = pk[0]; vc[0][1] = pk[1]; vc[1][0] = pk[2]; vc[1][1] = pk[3]; }
        if constexpr (ALIGN_EPI) { if (wr == 1) PG8_BAR; }
    }
    PG8_WAIT_V(0);
    if constexpr (!ALIGN_EPI) { if (wr == 0) PG8_BAR; }
    PG8_BAR;
#undef PG8_SA
#undef PG8_SB
#undef PG8_STAGE
#undef PG8_LDA
#undef PG8_LDB
#undef PG8_MMA16
#undef PG8_LDA8
#undef PG8_LDB8
#undef PG8_MMA8
#undef PG8_XLDA
#undef PG8_XLDB
#undef PG8_XMMA
#undef PG8_WAIT_V
#undef PG8_WAIT_L
#undef PG8_BAR
#undef PG8_SCHED
}
}

constexpr int NWAVES = 8, NTHR = 512;
constexpr int D = 1024, BATCH = 8, SEQ = 2048, NTOK = BATCH * SEQ, DEPTH = 4;
constexpr int M_HEADS = 4, M_DK = 128, M_DV = 256, M_PROJ = 3080, NPROJ = 3072;
constexpr int N_EXP = 32, D_FF = 512;
constexpr float EPS = 1e-6f;
constexpr int PMAX = 40960;

constexpr size_t MiB = 1u << 20;
constexpr size_t WS_CTL = 0, CTL_ZERO_BYTES = 1 * MiB;
constexpr size_t WS_MOD = 1 * MiB;
constexpr size_t WS_GATES = 2 * MiB;
constexpr size_t WS_TOKPOS = 3 * MiB;
constexpr size_t WS_TOKW = 3 * MiB + 256 * 1024;
constexpr size_t WS_SLOTTOK = 4 * MiB;
constexpr size_t WS_WMIN = 8 * MiB;
constexpr size_t WS_WMOUT = 20 * MiB;
constexpr size_t WS_WSIN = 24 * MiB;
constexpr size_t WS_WSOUT = 36 * MiB;
constexpr size_t WS_WGU = 40 * MiB;
constexpr size_t WS_WDN = 296 * MiB;
constexpr size_t WS_H = 424 * MiB;
constexpr size_t WS_PROJ = 456 * MiB;
constexpr size_t WS_HS = 552 * MiB;
constexpr size_t WS_A2 = 616 * MiB;
constexpr size_t WS_HMID = 648 * MiB;
constexpr size_t WS_YR = 688 * MiB;
constexpr size_t WS_X = 768 * MiB;
constexpr size_t WS_END = 800 * MiB;
constexpr int CW_BAR = 4096;
constexpr int CW_CNT = 16384;

constexpr int LDS_BYTES = 163840;
constexpr int LDSCTL_OFF = 163840 - 1024;
constexpr int LC_TOFF = 16, LC_CNT = 64, LC_LCNT = 96, LC_LBASE = 128, LC_SOFF = 160, LC_SEXP = 200;

#define GAS __attribute__((address_space(1)))
#define LAS __attribute__((address_space(3)))
typedef unsigned short bf16;
typedef unsigned v4u __attribute__((ext_vector_type(4)));
typedef unsigned v2u __attribute__((ext_vector_type(2)));
typedef float f32x4 __attribute__((ext_vector_type(4)));
#define LDS_WAIT() asm volatile("s_waitcnt lgkmcnt(0)" ::: "memory")
__device__ __forceinline__ unsigned f2bf(float f) { unsigned u = __builtin_bit_cast(unsigned, f); return (u + 0x7fffu + ((u >> 16) & 1u)) >> 16; }
__device__ __forceinline__ unsigned pk2(float lo, float hi) { return f2bf(lo) | (f2bf(hi) << 16); }
__device__ __forceinline__ float bflo(unsigned w) { return __builtin_bit_cast(float, w << 16); }
__device__ __forceinline__ float bfhi(unsigned w) { return __builtin_bit_cast(float, w & 0xffff0000u); }
__device__ __forceinline__ float wave_sum(float v) {
#pragma unroll
    for (int o = 1; o < 64; o <<= 1) v += __shfl_xor(v, o);
    return v;
}

#define XB_TMO      128
#define XB_XCNT(j)  (256  + 64 * (j))
#define XB_XSUB(j)  (1280 + 64 * (j))
#define XB_XGEN(j)  (2304 + 64 * (j))
#define XB_TOP      3328
#define XB_TOPGEN   3392
#define XCD_BAR_WORDS 3456
#define XB_SPIN_CAP (1u << 18)
__device__ __forceinline__ unsigned xb_ld(unsigned* p)              { return __hip_atomic_load(p, __ATOMIC_RELAXED, __HIP_MEMORY_SCOPE_AGENT); }
__device__ __forceinline__ unsigned xb_add(unsigned* p, unsigned v) { return __hip_atomic_fetch_add(p, v, __ATOMIC_RELAXED, __HIP_MEMORY_SCOPE_AGENT); }
__device__ __forceinline__ unsigned xb_xcc_id() { return (unsigned)__builtin_amdgcn_s_getreg((3 << 11) | 20) & 0xFu; }
#define XB_SPIN(cond, bar) do { unsigned _sp = 0; while (cond) { __builtin_amdgcn_s_sleep(1); \
    if ((++_sp & 255u) == 0u) { if (xb_ld(&(bar)[XB_TMO])) break; if (_sp > XB_SPIN_CAP) { atomicAdd(&(bar)[XB_TMO], 1u); break; } } } } while (0)
struct XcdBarrier { unsigned* bar; unsigned x; volatile LAS unsigned* st; };
__device__ __forceinline__ XcdBarrier xcd_barrier_post(unsigned* bar, volatile LAS unsigned* st) {
    XcdBarrier b; b.bar = bar; b.x = xb_xcc_id(); b.st = st;
    if (threadIdx.x == 0) (void)xb_add(&bar[XB_XCNT(b.x)], 1u);
    return b;
}
__device__ __forceinline__ void xcd_barrier_complete(unsigned* bar, unsigned x, unsigned& nloc, unsigned& nx) {
    const unsigned G = gridDim.x * gridDim.y * gridDim.z;
    unsigned sum, cnt, mine, sp = 0u;
    for (;;) {
        sum = 0u; cnt = 0u; mine = 0u;
#pragma unroll
        for (unsigned j = 0; j < 16; ++j) { const unsigned c = xb_ld(&bar[XB_XCNT(j)]); sum += c; cnt += (c > 0u) ? 1u : 0u; mine = (j == x) ? c : mine; }
        if (sum == G) break;
        __builtin_amdgcn_s_sleep(1);
        if ((++sp & 255u) == 0u) { if (xb_ld(&bar[XB_TMO])) break; if (sp > XB_SPIN_CAP) { atomicAdd(&bar[XB_TMO], 1u); break; } }
    }
    nloc = mine > 0u ? mine : 1u; nx = cnt > 0u ? cnt : 1u;
}
__device__ __forceinline__ void xcd_barrier(const XcdBarrier& b) {
    asm volatile("s_waitcnt vmcnt(0)" ::: "memory");
    __syncthreads();
    if (threadIdx.x == 0) {
        unsigned* bar = b.bar;
        __builtin_amdgcn_s_waitcnt(0);
        unsigned nloc = b.st[0], nx = b.st[1];
        if (nloc == 0u) { xcd_barrier_complete(bar, b.x, nloc, nx); b.st[0] = nloc; b.st[1] = nx; }
        const unsigned old = xb_add(&bar[XB_XSUB(b.x)], 1u);
        const unsigned gen = old / nloc;
        if (old + 1u == (gen + 1u) * nloc) {
            __builtin_amdgcn_fence(__ATOMIC_RELEASE, "agent");
            asm volatile("s_waitcnt vmcnt(0)" ::: "memory");
            const unsigned og = xb_add(&bar[XB_TOP], 1u);
            const unsigned tg = og / nx;
            if (og + 1u == (tg + 1u) * nx) xb_add(&bar[XB_TOPGEN], 1u);
            else XB_SPIN(xb_ld(&bar[XB_TOPGEN]) == tg, bar);
            __builtin_amdgcn_fence(__ATOMIC_ACQUIRE, "agent");
            xb_add(&bar[XB_XGEN(b.x)], 1u);
            asm volatile("s_waitcnt vmcnt(0)" ::: "memory");
        } else {
            XB_SPIN(xb_ld(&bar[XB_XGEN(b.x)]) == gen, bar);
            __builtin_amdgcn_fence(__ATOMIC_ACQUIRE, "agent");
            asm volatile("s_waitcnt vmcnt(0)" ::: "memory");
        }
    }
    __syncthreads();
}

struct Args { const float* in[20]; float* out; unsigned char* ws; int ph_lo, ph_hi; };
enum InIdx { I_X = 0, I_C, I_ADAW, I_ADAB, I_NORMG, I_FINALG, I_MWIN, I_MBG, I_MNORMG, I_MWOUT, I_SWIN, I_SCONVW, I_SWOUT, I_RWG, I_RBG, I_RWE, I_RBE, I_EWG, I_EWU, I_EWD };

struct Frame {
    LAS unsigned char* lds;
    volatile LAS unsigned* LC;
    unsigned* ctl;
    int tid, lane, wave, G;
    float* out; unsigned char* ws;
};
typedef const __attribute__((address_space(4))) Args* KArgs;
__device__ __forceinline__ KArgs kargs() { auto p = __builtin_amdgcn_kernarg_segment_ptr(); asm volatile("" : "+s"(p)); return (KArgs)p; }
template <class T> __device__ __forceinline__ T* as_global(T* p) { __attribute__((address_space(1))) T* q = (__attribute__((address_space(1))) T*)p; asm volatile("" : "+s"(q)); return (T*)q; }
#define KIN(i) (as_global((const float*)kargs()->in[i]))
template <class T> __device__ __forceinline__ T* launder(T* p) { return as_global(p); }

__device__ __forceinline__ Frame fresh(const Frame& F) { Frame P = F; P.tid = pg8::opaque_v(F.tid); P.lane = P.tid & 63; P.wave = __builtin_amdgcn_readfirstlane(P.tid >> 6); P.G = pg8::opaque_s(F.G); return P; }
__device__ __forceinline__ void p_adaln(Frame& F) {
    LAS float* sc = (LAS float*)F.lds;
    LAS float* red = (LAS float*)(F.lds + 32768);
    const float* c = KIN(I_C); const float* adaw = KIN(I_ADAW); const float* adab = KIN(I_ADAB);
    float* mod = (float*)(F.ws + WS_MOD);
    for (int i = F.tid; i < 8192; i += NTHR) { const float v = c[i]; sc[i] = v / (1.0f + __expf(-v)); }
    __syncthreads();
    const int kq = F.lane >> 4, c4 = (F.lane & 15) * 4;
    for (int item = blockIdx.x; item < 8 * 48; item += F.G) {
        const int ls = item / 48, cg = item % 48;
        const float* W = adaw + (size_t)ls * 1024 * 3072 + cg * 64 + c4;
        float acc[8][4];
#pragma unroll
        for (int b = 0; b < 8; ++b) { acc[b][0] = 0.f; acc[b][1] = 0.f; acc[b][2] = 0.f; acc[b][3] = 0.f; }
#pragma unroll 8
        for (int i = 0; i < 32; ++i) {
            const int k = F.wave * 128 + i * 4 + kq;
            const f32x4 w = *(const f32x4*)(W + (size_t)k * 3072);
#pragma unroll
            for (int b = 0; b < 8; ++b) { const float s = sc[b * 1024 + k]; acc[b][0] += s * w[0]; acc[b][1] += s * w[1]; acc[b][2] += s * w[2]; acc[b][3] += s * w[3]; }
        }
#pragma unroll
        for (int b = 0; b < 8; ++b)
#pragma unroll
            for (int j = 0; j < 4; ++j) { float v = acc[b][j]; v += __shfl_xor(v, 16); v += __shfl_xor(v, 32); acc[b][j] = v; }
        if (kq == 0) {
#pragma unroll
            for (int b = 0; b < 8; ++b) *(LAS f32x4*)(red + (F.wave * 8 + b) * 64 + c4) = (f32x4){acc[b][0], acc[b][1], acc[b][2], acc[b][3]};
        }
        __syncthreads();
        { const int b = F.tid >> 6, col = F.tid & 63; float s = 0.f;
#pragma unroll
          for (int w = 0; w < 8; ++w) s += red[(w * 8 + b) * 64 + col];
          mod[((size_t)ls * 8 + b) * 3072 + cg * 64 + col] = s + adab[ls * 3072 + cg * 64 + col]; }
        __syncthreads();
    }
}

__device__ __forceinline__ void tr_item(const float* W, int ldw, bf16* WT, int ldt, LAS float* scr, int lane) {
#pragma unroll 8
    for (int i = 0; i < 32; ++i) { const int kk = 2 * i + (lane >> 5); scr[kk * 33 + (lane & 31)] = W[(size_t)kk * ldw + (lane & 31)]; }
    LDS_WAIT(); asm volatile("" ::: "memory");
    const int c = lane & 7;
#pragma unroll
    for (int j = 0; j < 4; ++j) { const int n = (lane >> 3) + 8 * j; const LAS float* s = scr + (8 * c) * 33 + n;
        v4u o; o.x = pk2(s[0 * 33], s[1 * 33]); o.y = pk2(s[2 * 33], s[3 * 33]); o.z = pk2(s[4 * 33], s[5 * 33]); o.w = pk2(s[6 * 33], s[7 * 33]);
        *(v4u*)(WT + (size_t)n * ldt + 8 * c) = o; }
    LDS_WAIT(); asm volatile("" ::: "memory");
}
__device__ __forceinline__ void tr_item8(const float* W, int ldw, unsigned char* WT, int ldt, LAS float* scr, int lane) {
#pragma unroll 8
    for (int i = 0; i < 64; ++i) { const int kk = 2 * i + (lane >> 5); scr[kk * 33 + (lane & 31)] = W[(size_t)kk * ldw + (lane & 31)] * 32.0f; }
    LDS_WAIT(); asm volatile("" ::: "memory");
    const int n = lane >> 1, kh = (lane & 1) * 64; const LAS float* sp = scr + kh * 33 + n;
    unsigned char* dst = WT + (size_t)n * ldt + kh;
#pragma unroll
    for (int q = 0; q < 4; ++q) { v4u o;
        o.x = pg8::pk4_fp8(sp[(16 * q + 0) * 33], sp[(16 * q + 1) * 33], sp[(16 * q + 2) * 33], sp[(16 * q + 3) * 33]); o.y = pg8::pk4_fp8(sp[(16 * q + 4) * 33], sp[(16 * q + 5) * 33], sp[(16 * q + 6) * 33], sp[(16 * q + 7) * 33]);
        o.z = pg8::pk4_fp8(sp[(16 * q + 8) * 33], sp[(16 * q + 9) * 33], sp[(16 * q + 10) * 33], sp[(16 * q + 11) * 33]); o.w = pg8::pk4_fp8(sp[(16 * q + 12) * 33], sp[(16 * q + 13) * 33], sp[(16 * q + 14) * 33], sp[(16 * q + 15) * 33]);
        *(v4u*)(dst + 16 * q) = o; }
    LDS_WAIT(); asm volatile("" ::: "memory");
}
__device__ __forceinline__ void p_convert(Frame& F) {
    LAS float* scr = (LAS float*)(F.lds + F.wave * 17408);
    const float* in_mwin = KIN(I_MWIN); const float* in_mwout = KIN(I_MWOUT); const float* in_swin = KIN(I_SWIN); const float* in_swout = KIN(I_SWOUT);
    const float* in_ewg = KIN(I_EWG); const float* in_ewu = KIN(I_EWU); const float* in_ewd = KIN(I_EWD);
    const int gw = blockIdx.x * NWAVES + F.wave, NGW = F.G * NWAVES;
    constexpr int I_A = 2 * 16 * 96, I_B = 2 * 16 * 32, I_C2 = I_A, I_D = I_B, I_E = 128 * 8 * 16, I_F = I_E, I_G = 128 * 4 * 32;
    constexpr int NITEMS = I_A + I_B + I_C2 + I_D + I_E + I_F + I_G;
    for (int it = gw; it < NITEMS; it += NGW) {
        int r = it;
        if (r < I_A) { const int j = r / 1536, q = r % 1536, kb = q / 96, nb = q % 96;
            tr_item(in_mwin + (size_t)j * 1024 * M_PROJ + (size_t)kb * 64 * M_PROJ + nb * 32, M_PROJ, (bf16*)(F.ws + WS_WMIN) + (size_t)j * 3072 * 1024 + (size_t)nb * 32 * 1024 + kb * 64, 1024, scr, F.lane); continue; } r -= I_A;
        if (r < I_B) { const int j = r / 512, q = r % 512, kb = q / 32, nb = q % 32;
            tr_item(in_mwout + (size_t)j * 1024 * 1024 + (size_t)kb * 64 * 1024 + nb * 32, 1024, (bf16*)(F.ws + WS_WMOUT) + (size_t)j * 1024 * 1024 + (size_t)nb * 32 * 1024 + kb * 64, 1024, scr, F.lane); continue; } r -= I_B;
        if (r < I_C2) { const int j = r / 1536, q = r % 1536, kb = q / 96, nb = q % 96, n0 = nb * 32;
            int drow; if (n0 < 1024) drow = 2048 + n0; else if (n0 < 2048) { const int cc = n0 - 1024; drow = 256 * (cc >> 7) + (cc & 127); } else { const int cc = n0 - 2048; drow = 256 * (cc >> 7) + 128 + (cc & 127); }
            tr_item(in_swin + (size_t)j * 1024 * 3072 + (size_t)kb * 64 * 3072 + n0, 3072, (bf16*)(F.ws + WS_WSIN) + (size_t)j * 3072 * 1024 + (size_t)drow * 1024 + kb * 64, 1024, scr, F.lane); continue; } r -= I_C2;
        if (r < I_D) { const int j = r / 512, q = r % 512, kb = q / 32, nb = q % 32;
            tr_item(in_swout + (size_t)j * 1024 * 1024 + (size_t)kb * 64 * 1024 + nb * 32, 1024, (bf16*)(F.ws + WS_WSOUT) + (size_t)j * 1024 * 1024 + (size_t)nb * 32 * 1024 + kb * 64, 1024, scr, F.lane); continue; } r -= I_D;
        if (r < I_E + I_F) { const bool up = r >= I_E; if (up) r -= I_E; const int mat = r / 128, q = r % 128, kb = q / 16, nb = q % 16, n0 = nb * 32;
            const int drow = 256 * (n0 >> 7) + (up ? 128 : 0) + (n0 & 127);
            tr_item8((up ? in_ewu : in_ewg) + (size_t)mat * 1024 * 512 + (size_t)kb * 128 * 512 + n0, 512, (unsigned char*)(F.ws + WS_WGU) + (size_t)mat * 1024 * 1024 + (size_t)drow * 1024 + kb * 128, 1024, scr, F.lane); continue; } r -= I_E + I_F;
        { const int mat = r / 128, q = r % 128, kb = q / 32, nb = q % 32;
            tr_item8(in_ewd + (size_t)mat * 512 * 1024 + (size_t)kb * 128 * 1024 + nb * 32, 1024, (unsigned char*)(F.ws + WS_WDN) + (size_t)mat * 1024 * 512 + (size_t)nb * 32 * 512 + kb * 128, 512, scr, F.lane); }
    }
}

__device__ __forceinline__ void moe_tables(Frame& F, int layer) {
    if (F.tid < 64) {
        const int e = F.tid & 31;
        const int c = (int)__hip_atomic_load(F.ctl + CW_CNT + (layer * 32 + e) * 16, __ATOMIC_RELAXED, __HIP_MEMORY_SCOPE_AGENT);
        const int tl = (c + 255) >> 8, rem = c - (tl - 1) * 256;
        const int sm = (tl > 0 && rem <= 128) ? 1 : 0, nb = tl - sm;
        int incb = (F.tid < 32) ? nb : 0, incs = (F.tid < 32) ? sm : 0;
#pragma unroll
        for (int o = 1; o < 32; o <<= 1) { const int vb = __shfl_up(incb, o), vs = __shfl_up(incs, o); if ((F.tid & 63) >= o) { incb += vb; incs += vs; } }
        if (F.tid < 32) { F.LC[LC_TOFF + e] = (unsigned)(incb - nb); F.LC[LC_SOFF + e] = (unsigned)(incs - sm); F.LC[LC_CNT + e] = (unsigned)c;
            if (sm) F.LC[LC_SEXP + (incs - sm)] = (unsigned)e;
            if (e == 31) { F.LC[LC_TOFF + 32] = (unsigned)incb; F.LC[LC_SOFF + 32] = (unsigned)incs; } }
    }
    __syncthreads();
}
__device__ __forceinline__ int moe_slot(Frame& F, int p) {
    const int e = p & 31, pos = p >> 5, k = pos >> 8, b0 = (int)F.LC[LC_TOFF + e], nb = (int)F.LC[LC_TOFF + e + 1] - b0;
    const int tile = (k < nb) ? b0 + k : (int)F.LC[LC_TOFF + 32] + (int)F.LC[LC_SOFF + e];
    return tile * 256 + (pos & 255);
}
template <int NC> __device__ __forceinline__ void wtab_put(LAS unsigned char* base, int k, int n, float v) {
    const unsigned hi = f2bf(v); const unsigned lo = f2bf(v - __builtin_bit_cast(float, hi << 16));
    const int off = ((k >> 3) * NC + n) * 16 + (k & 7) * 2;
    *(LAS unsigned short*)(base + off) = (unsigned short)hi; *(LAS unsigned short*)(base + NC * 2048 + off) = (unsigned short)lo;
}
typedef short rbf16x8 __attribute__((ext_vector_type(8)));
template <bool COMBINE, int AUX, bool FINAL, bool XF32 = false>
__device__ __forceinline__ void row_phase(Frame& F, const void* xsrc_, void* xdst_, const float* modn, const float* ng, const float* modprev, int prev_layer,
                                          const float* auxw0, const float* auxw1, const float* auxb0, const float* auxb1, int layer) {
    constexpr int NC = (AUX == 2) ? 36 : 8, NT = (NC + 15) / 16;
    constexpr int OFF_RINV = 147456, OFF_LOGIT = OFF_RINV + 256, OFF_ROWE = OFF_LOGIT + 64 * 36 * 4, OFF_ROWW = OFF_ROWE + 512, OFF_CB = OFF_ROWW + 512, OFF_R2 = OFF_CB + 256;
    static_assert(OFF_R2 + 14 * 36 * 4 <= LDSCTL_OFF && 64 * 8 * 4 <= 14 * 36 * 4 + 64, "row phase LDS map");
    const int lane = F.lane;
    const float* xsrc32 = (const float*)xsrc_; const bf16* xsrc16 = (const bf16*)xsrc_;
    float* xdst32 = (float*)xdst_; bf16* xdst16 = (bf16*)xdst_;
    if (COMBINE) moe_tables(F, prev_layer);
    const int* tokpos = (const int*)(F.ws + WS_TOKPOS); const float* tokw = (const float*)(F.ws + WS_TOKW);
    const unsigned char* YR = (const unsigned char*)(F.ws + WS_YR);
    bf16* H = (bf16*)(F.ws + WS_H);
    LAS float* rinvL = (LAS float*)(F.lds + OFF_RINV);
    LAS float* logit = (LAS float*)(F.lds + OFF_LOGIT);
    LAS int* rowE = (LAS int*)(F.lds + OFF_ROWE);
    LAS float* rowW = (LAS float*)(F.lds + OFF_ROWW);
    LAS float* cbL = (LAS float*)(F.lds + OFF_CB);
    LAS float* r2 = (LAS float*)(F.lds + OFF_R2);
    int tab_b = -1;
#ifdef SCAN_SELFCHECK
    const float FLAGSCALE = (FINAL && __hip_atomic_load(F.ctl + 64, __ATOMIC_RELAXED, __HIP_MEMORY_SCOPE_AGENT) != 0u) ? 2.0f : 1.0f;
#else
    const float FLAGSCALE = 1.0f;
#endif
    for (int rg = blockIdx.x; rg < NTOK / 64; rg += F.G) {
        const int b = rg >> 5;
        if (AUX != 0 && b != tab_b) {
            tab_b = b;
            const float* shp = modn + b * 3072; const float* scp = shp + 1024;
            LAS float* gsL = logit; LAS float* shL = logit + 1024;
            for (int k = F.tid; k < 1024; k += NTHR) { gsL[k] = ng[k] * (1.0f + scp[k]); shL[k] = shp[k]; }
            __syncthreads();
            constexpr int NQ = (AUX == 2) ? 14 : 4, NI = (AUX == 2) ? 10 : 1;
            if (AUX == 1) {
                float cs4[4] = {0.f, 0.f, 0.f, 0.f};
                if (F.tid < 256) { const int kc = F.tid >> 1, c4 = F.tid & 1; f32x4 wq[8];
#pragma unroll
                    for (int jj = 0; jj < 8; ++jj) wq[jj] = *(const f32x4*)(auxw0 + (size_t)(8 * kc + jj) * M_PROJ + NPROJ + 4 * c4);
#pragma unroll
                    for (int e = 0; e < 4; ++e) { float pv[8];
#pragma unroll
                        for (int jj = 0; jj < 8; ++jj) { const int k = 8 * kc + jj; cs4[e] += shL[k] * wq[jj][e]; pv[jj] = wq[jj][e] * gsL[k]; }
                        v4u hi, lo; unsigned* hp = (unsigned*)&hi; unsigned* lp = (unsigned*)&lo;
#pragma unroll
                        for (int q = 0; q < 4; ++q) { const unsigned w2 = pg8::cvt_pk_bf16(pv[2 * q], pv[2 * q + 1]); hp[q] = w2;
                            lp[q] = pg8::cvt_pk_bf16(pv[2 * q] - __builtin_bit_cast(float, w2 << 16), pv[2 * q + 1] - __builtin_bit_cast(float, w2 & 0xffff0000u)); }
                        *(LAS v4u*)(F.lds + (kc * NC + 4 * c4 + e) * 16) = hi; *(LAS v4u*)(F.lds + NC * 2048 + (kc * NC + 4 * c4 + e) * 16) = lo; } }
#pragma unroll
                for (int e = 0; e < 4; ++e) { float t = cs4[e]; t += __shfl_xor(t, 2); t += __shfl_xor(t, 4); t += __shfl_xor(t, 8); t += __shfl_xor(t, 16); t += __shfl_xor(t, 32); cs4[e] = t; }
                if (F.tid < 256 && lane < 2) {
#pragma unroll
                    for (int e = 0; e < 4; ++e) r2[F.wave * NC + 4 * lane + e] = cs4[e]; }
            } else {
            if (F.tid < NQ * NC) {
                const int n = F.tid % NC, kcq = F.tid / NC; float cs = 0.f;
                const float* wcol = (AUX == 1) ? auxw0 + NPROJ + n : ((n < 4) ? auxw0 + n : auxw1 + (n - 4));
                const int wstr = (AUX == 1) ? M_PROJ : ((n < 4) ? 4 : 32);
                constexpr int NB = (NI + 4) / 5;
#pragma unroll 1
                for (int bt = 0; bt < NB; ++bt) {
                    float wv[5][8];
#pragma unroll
                    for (int i = 0; i < 5; ++i) { const int kcr = kcq + NQ * (5 * bt + i); const int kc = kcr < 128 ? kcr : 127; const float* wp = wcol + (size_t)(8 * kc) * wstr;
#pragma unroll
                        for (int jj = 0; jj < 8; ++jj) wv[i][jj] = wp[jj * wstr]; }
#pragma unroll
                    for (int i = 0; i < 5; ++i) { const int kcr = kcq + NQ * (5 * bt + i); const bool valid = kcr < 128 && (5 * bt + i) < NI; const int kc = kcr < 128 ? kcr : 127;
                        float pv[8];
#pragma unroll
                        for (int jj = 0; jj < 8; ++jj) { const int k = 8 * kc + jj; cs += valid ? shL[k] * wv[i][jj] : 0.f; pv[jj] = wv[i][jj] * gsL[k]; }
                        v4u hi, lo; unsigned* hp = (unsigned*)&hi; unsigned* lp = (unsigned*)&lo;
#pragma unroll
                        for (int e = 0; e < 4; ++e) { const unsigned w2 = pg8::cvt_pk_bf16(pv[2 * e], pv[2 * e + 1]); hp[e] = w2;
                            lp[e] = pg8::cvt_pk_bf16(pv[2 * e] - __builtin_bit_cast(float, w2 << 16), pv[2 * e + 1] - __builtin_bit_cast(float, w2 & 0xffff0000u)); }
                        *(LAS v4u*)(F.lds + (kc * NC + n) * 16) = hi; *(LAS v4u*)(F.lds + NC * 2048 + (kc * NC + n) * 16) = lo;
                    }
                }
                r2[kcq * NC + n] = cs;
            }
            }
            __syncthreads();
            if (F.tid < NC) { float sacc = 0.f; for (int q = 0; q < NQ; ++q) sacc += r2[q * NC + F.tid]; cbL[F.tid] = sacc; }
            __syncthreads();
        }
        if (AUX != 0) { for (int i = F.tid; i < 64 * NC; i += NTHR) logit[i] = 0.f; if (AUX == 2 && F.tid < 32) F.LC[LC_LCNT + F.tid] = 0u; }
        {
            constexpr int RB = COMBINE ? 2 : 4;
            f32x4 gsv[4], shv[4], gtv[4];
#pragma unroll
            for (int j = 0; j < 4; ++j) {
                const f32x4 g = *((const f32x4*)ng + lane + 64 * j);
                if (FINAL) { gsv[j] = g; shv[j] = (f32x4){0.f, 0.f, 0.f, 0.f}; }
                else { const f32x4 scl = *((const f32x4*)(modn + b * 3072 + 1024) + lane + 64 * j); gsv[j] = g * (1.0f + scl); shv[j] = *((const f32x4*)(modn + b * 3072) + lane + 64 * j); }
                if (COMBINE) gtv[j] = *((const f32x4*)(modprev + b * 3072 + 2048) + lane + 64 * j);
            }
            for (int i0 = 0; i0 < 8; i0 += RB) {
                const int rowb = rg * 64 + F.wave * 8 + i0;
                f32x4 v[RB][4]; unsigned y0[RB][4], y1[RB][4]; float w0[RB], w1[RB];
#pragma unroll
                for (int r = 0; r < RB; ++r) {
#pragma unroll
                    for (int j = 0; j < 4; ++j) {
                        if (XF32) v[r][j] = *((const f32x4*)(xsrc32 + (size_t)(rowb + r) * D) + lane + 64 * j);
                        else { const v2u w = *((const v2u*)(xsrc16 + (size_t)(rowb + r) * D) + lane + 64 * j); v[r][j] = (f32x4){bflo(w.x), bfhi(w.x), bflo(w.y), bfhi(w.y)}; } }
                    if (COMBINE) {
                        const int p0 = __builtin_amdgcn_readfirstlane(tokpos[(rowb + r) * 2]), p1 = __builtin_amdgcn_readfirstlane(tokpos[(rowb + r) * 2 + 1]);
                        w0[r] = tokw[(rowb + r) * 2] * pg8::W8_INV; w1[r] = tokw[(rowb + r) * 2 + 1] * pg8::W8_INV;
                        const int s0 = moe_slot(F, p0), s1 = moe_slot(F, p1);
#pragma unroll
                        for (int j = 0; j < 4; ++j) { y0[r][j] = *((const unsigned*)(YR + (size_t)s0 * D) + lane + 64 * j); y1[r][j] = *((const unsigned*)(YR + (size_t)s1 * D) + lane + 64 * j); }
                    }
                }
#pragma unroll
                for (int r = 0; r < RB; ++r) {
                    const int row = rowb + r;
                    if (COMBINE) {
#pragma unroll
                        for (int j = 0; j < 4; ++j) {
                            v[r][j][0] += gtv[j][0] * (w0[r] * __builtin_amdgcn_cvt_f32_fp8(y0[r][j], 0) + w1[r] * __builtin_amdgcn_cvt_f32_fp8(y1[r][j], 0)); v[r][j][1] += gtv[j][1] * (w0[r] * __builtin_amdgcn_cvt_f32_fp8(y0[r][j], 1) + w1[r] * __builtin_amdgcn_cvt_f32_fp8(y1[r][j], 1));
                            v[r][j][2] += gtv[j][2] * (w0[r] * __builtin_amdgcn_cvt_f32_fp8(y0[r][j], 2) + w1[r] * __builtin_amdgcn_cvt_f32_fp8(y1[r][j], 2)); v[r][j][3] += gtv[j][3] * (w0[r] * __builtin_amdgcn_cvt_f32_fp8(y0[r][j], 3) + w1[r] * __builtin_amdgcn_cvt_f32_fp8(y1[r][j], 3));
                        }
                        if (!FINAL) {
#pragma unroll
                            for (int j = 0; j < 4; ++j) { v2u o; o.x = pk2(v[r][j][0], v[r][j][1]); o.y = pk2(v[r][j][2], v[r][j][3]); *((v2u*)(xdst16 + (size_t)row * D) + lane + 64 * j) = o;
                                v[r][j] = (f32x4){bflo(o.x), bfhi(o.x), bflo(o.y), bfhi(o.y)}; }
                        }
                    }
                    float ss = 0.f;
#pragma unroll
                    for (int j = 0; j < 4; ++j) ss += (v[r][j][0] * v[r][j][0] + v[r][j][1] * v[r][j][1]) + (v[r][j][2] * v[r][j][2] + v[r][j][3] * v[r][j][3]);
                    const float rinv = 1.0f / sqrtf(wave_sum(ss) * (1.0f / D) + EPS);
                    if (FINAL) {
#pragma unroll
                        for (int j = 0; j < 4; ++j) *((f32x4*)(xdst32 + (size_t)row * D) + lane + 64 * j) = v[r][j] * (rinv * FLAGSCALE) * gsv[j];
                    } else {
                        if (AUX != 0 && lane == 0) rinvL[F.wave * 8 + i0 + r] = rinv;
#pragma unroll
                        for (int j = 0; j < 4; ++j) { const f32x4 h = (v[r][j] * rinv) * gsv[j] + shv[j];
                            if (AUX == 2) *((unsigned*)((unsigned char*)H + (size_t)row * D) + lane + 64 * j) = pg8::pk4_fp8(h[0], h[1], h[2], h[3]);
                            else { v2u o; o.x = pk2(h[0], h[1]); o.y = pk2(h[2], h[3]); *((v2u*)(H + (size_t)row * D) + lane + 64 * j) = o; } }
                    }
                }
            }
        }
        if (AUX != 0) {
            __syncthreads();
            const int l15 = lane & 15, g4 = lane >> 4, tile = F.wave >> 1, kh = F.wave & 1;
            const int trow = rg * 64 + tile * 16 + l15;
            const float* xr32 = xsrc32 + (size_t)trow * D; const bf16* xr16 = (COMBINE ? (const bf16*)xdst16 : xsrc16) + (size_t)trow * D;
            f32x4 acc[NT];
#pragma unroll
            for (int nt = 0; nt < NT; ++nt) acc[nt] = (f32x4){0.f, 0.f, 0.f, 0.f};
#pragma unroll 8
            for (int ks = kh * 16; ks < kh * 16 + 16; ++ks) {
                const int k0 = 32 * ks + 8 * g4;
                v4u hi, lo = (v4u){0u, 0u, 0u, 0u};
                if (XF32) {
                    const f32x4 x0 = *(const f32x4*)(xr32 + k0), x1 = *(const f32x4*)(xr32 + k0 + 4);
                    const float hv[8] = {x0[0], x0[1], x0[2], x0[3], x1[0], x1[1], x1[2], x1[3]};
                    unsigned* hp = (unsigned*)&hi; unsigned* lp = (unsigned*)&lo;
#pragma unroll
                    for (int e = 0; e < 4; ++e) { const unsigned w2 = pg8::cvt_pk_bf16(hv[2 * e], hv[2 * e + 1]); hp[e] = w2;
                        lp[e] = pg8::cvt_pk_bf16(hv[2 * e] - __builtin_bit_cast(float, w2 << 16), hv[2 * e + 1] - __builtin_bit_cast(float, w2 & 0xffff0000u)); }
                } else hi = *(const v4u*)(xr16 + k0);
                const rbf16x8 Ahi = __builtin_bit_cast(rbf16x8, hi), Alo = __builtin_bit_cast(rbf16x8, lo);
#pragma unroll
                for (int nt = 0; nt < NT; ++nt) {
                    const int n = (16 * nt + l15) < NC ? (16 * nt + l15) : (NC - 1);
                    const LAS unsigned char* tp = F.lds + ((4 * ks + g4) * NC + n) * 16;
                    const rbf16x8 Bhi = *(const LAS rbf16x8*)tp, Blo = *(const LAS rbf16x8*)(tp + NC * 2048);
                    acc[nt] = __builtin_amdgcn_mfma_f32_16x16x32_bf16(Ahi, Bhi, acc[nt], 0, 0, 0);
                    if (XF32) acc[nt] = __builtin_amdgcn_mfma_f32_16x16x32_bf16(Alo, Bhi, acc[nt], 0, 0, 0);
                    acc[nt] = __builtin_amdgcn_mfma_f32_16x16x32_bf16(Ahi, Blo, acc[nt], 0, 0, 0);
                }
            }
#pragma unroll
            for (int nt = 0; nt < NT; ++nt) { const int n = 16 * nt + l15;
                if (n < NC) {
#pragma unroll
                    for (int r = 0; r < 4; ++r) (void)__hip_atomic_fetch_add(logit + (tile * 16 + 4 * g4 + r) * NC + n, acc[nt][r], __ATOMIC_RELAXED, __HIP_MEMORY_SCOPE_WORKGROUP);
                } }
            __syncthreads();
        }
        if (AUX == 1) {
            if (F.tid < 64) { const int row = rg * 64 + F.tid; const LAS float* lg = logit + F.tid * NC; const float ri = rinvL[F.tid]; float* gp = (float*)(F.ws + WS_GATES) + (size_t)row * 8;
                *(f32x4*)gp = (f32x4){lg[0] * ri + cbL[0], lg[1] * ri + cbL[1], lg[2] * ri + cbL[2], lg[3] * ri + cbL[3]};
                *(f32x4*)(gp + 4) = (f32x4){lg[4] * ri + cbL[4], lg[5] * ri + cbL[5], lg[6] * ri + cbL[6], lg[7] * ri + cbL[7]}; }
            __syncthreads();
        }
        if (AUX == 2) {
            if (F.tid < 64) {
                const LAS float* lg = logit + F.tid * NC; const float ri = rinvL[F.tid];
                float gl[4];
#pragma unroll
                for (int g = 0; g < 4; ++g) gl[g] = lg[g] * ri + cbL[g] + auxb0[g];
                int gs = 0; float gm = gl[0];
#pragma unroll
                for (int g = 1; g < 4; ++g) if (gl[g] > gm) { gm = gl[g]; gs = g; }
                float den = 0.f;
#pragma unroll
                for (int g = 0; g < 4; ++g) den += __expf(gl[g] - gm);
                const float psel = 1.0f / den;
                float el[8];
#pragma unroll
                for (int q = 0; q < 8; ++q) el[q] = lg[4 + gs * 8 + q] * ri + cbL[4 + gs * 8 + q] + auxb1[gs * 8 + q];
                int i1 = 0; float l1 = el[0];
#pragma unroll
                for (int q = 1; q < 8; ++q) if (el[q] > l1) { l1 = el[q]; i1 = q; }
                int i2 = -1; float l2 = -3.0e38f;
#pragma unroll
                for (int q = 0; q < 8; ++q) if (q != i1 && el[q] > l2) { l2 = el[q]; i2 = q; }
                const float ex = __expf(l2 - l1), w1 = psel / (1.0f + ex), w2 = psel * ex / (1.0f + ex);
                rowE[2 * F.tid] = gs * 8 + i1; rowE[2 * F.tid + 1] = gs * 8 + i2; rowW[2 * F.tid] = w1; rowW[2 * F.tid + 1] = w2;
            }
            __syncthreads();
            int e = 0, lp = 0;
            if (F.tid < 128) { e = rowE[F.tid]; lp = (int)__hip_atomic_fetch_add((LAS unsigned*)(F.LC + LC_LCNT + e), 1u, __ATOMIC_RELAXED, __HIP_MEMORY_SCOPE_WORKGROUP); }
            __syncthreads();
            if (F.tid < 32) F.LC[LC_LBASE + F.tid] = __hip_atomic_fetch_add(F.ctl + CW_CNT + (layer * 32 + F.tid) * 16, F.LC[LC_LCNT + F.tid], __ATOMIC_RELAXED, __HIP_MEMORY_SCOPE_AGENT);
            __syncthreads();
            if (F.tid < 128) { const int row = rg * 64 + (F.tid >> 1); const int pos = (int)F.LC[LC_LBASE + e] + lp;
                ((int*)(F.ws + WS_SLOTTOK))[e * 16384 + pos] = row; ((int*)(F.ws + WS_TOKPOS))[row * 2 + (F.tid & 1)] = pos * 32 + e; ((float*)(F.ws + WS_TOKW))[row * 2 + (F.tid & 1)] = rowW[F.tid]; }
            __syncthreads();
        }
    }
}

__device__ __forceinline__ float logsigmoid_f(float x) { return x < 0.f ? x - log1pf(__expf(x)) : -log1pf(__expf(-x)); }
__device__ __forceinline__ void p_scan(Frame& F, int j  ) {
    constexpr int QS = 132;
    LAS float* q = (LAS float*)F.lds;
    LAS float* k = q + 64 * QS;
    LAS float* Cm = k + 64 * QS;
    LAS float* vv = Cm + 32 * QS;
    LAS float* vw = vv + 64 * 32;
    LAS float* Sm = vw + 64 * 32;
    LAS float* nn = Sm + 64 * 68;
    LAS float* ga = nn + 128;
    LAS float* gM = ga + 64;
    LAS float* gb = gM + 64;
    LAS float* gden = gb + 64;
    LAS float* gm = gden + 64;
    const bf16* PROJ = (const bf16*)(F.ws + WS_PROJ);
    const float* GATES = (const float*)(F.ws + WS_GATES);
    float* HS = (float*)(F.ws + WS_HS);
    const float* bg = KIN(I_MBG) + j * 8;
    const int tid = F.tid;
    for (int item = blockIdx.x; item < 256; item += F.G) {
        const int b = item >> 5, hd = (item >> 3) & 3, vs = item & 7;
        for (int i = tid; i < 32 * QS; i += NTHR) Cm[i] = 0.f;
        if (tid < 128) nn[tid] = 0.f;
        if (tid == 0) gm[0] = 0.f;
        __syncthreads();
        for (int ch = 0; ch < 32; ++ch) {
            const int row0 = b * SEQ + ch * 64;
            for (int p = tid; p < 2048; p += NTHR) { const int isk = p >> 10, pp = p & 1023, r = pp >> 4, c8 = (pp & 15) * 8;
                const v4u w = *(const v4u*)(PROJ + (size_t)(row0 + r) * NPROJ + isk * 512 + hd * 128 + c8);
                const float sc = isk ? 1.0f : 0.08838834764831845f;
                LAS float* dst = (isk ? k : q) + r * QS + c8;
                *(LAS f32x4*)dst = (f32x4){bflo(w.x) * sc, bfhi(w.x) * sc, bflo(w.y) * sc, bfhi(w.y) * sc};
                *(LAS f32x4*)(dst + 4) = (f32x4){bflo(w.z) * sc, bfhi(w.z) * sc, bflo(w.w) * sc, bfhi(w.w) * sc}; }
            if (tid < 256) { const int r = tid >> 2, c8 = (tid & 3) * 8;
                const v4u w = *(const v4u*)(PROJ + (size_t)(row0 + r) * NPROJ + 1024 + hd * 256 + vs * 32 + c8);
                LAS float* dst = vv + r * 32 + c8;
                *(LAS f32x4*)dst = (f32x4){bflo(w.x), bfhi(w.x), bflo(w.y), bfhi(w.y)}; *(LAS f32x4*)(dst + 4) = (f32x4){bflo(w.z), bfhi(w.z), bflo(w.w), bfhi(w.w)}; }
            if (tid < 64) {
                const float ig = GATES[(size_t)(row0 + tid) * 8 + hd] + bg[hd];
                const float lf = logsigmoid_f(GATES[(size_t)(row0 + tid) * 8 + 4 + hd] + bg[4 + hd]);
                float bc = lf;
#pragma unroll
                for (int o = 1; o < 64; o <<= 1) { const float t = __shfl_up(bc, o); if (tid >= o) bc += t; }
                const float a = ig - bc;
                float pm = a;
#pragma unroll
                for (int o = 1; o < 64; o <<= 1) { const float t = __shfl_up(pm, o); if (tid >= o) pm = fmaxf(pm, t); }
                const float m = gm[0];
                ga[tid] = a; gM[tid] = fmaxf(m, pm); gb[tid] = bc;
            }
            __syncthreads();
            {
                const int s = tid & 63, t0 = (tid >> 6) * 8;
                float acc[8];
#pragma unroll
                for (int i = 0; i < 8; ++i) acc[i] = 0.f;
                for (int d4 = 0; d4 < 32; ++d4) {
                    const f32x4 kv = *(const LAS f32x4*)(k + s * QS + d4 * 4);
#pragma unroll
                    for (int i = 0; i < 8; ++i) { const f32x4 qv = *(const LAS f32x4*)(q + (t0 + i) * QS + d4 * 4); acc[i] += qv[0] * kv[0] + qv[1] * kv[1] + qv[2] * kv[2] + qv[3] * kv[3]; }
                }
                const float as = ga[s];
#pragma unroll
                for (int i = 0; i < 8; ++i) { const int t = t0 + i; Sm[t * 68 + s] = (s <= t) ? acc[i] * __expf(as - gM[t]) : 0.f; }
            }
            __syncthreads();
            {
                const int t = tid >> 3, part = tid & 7; float sden = 0.f, nq = 0.f;
#pragma unroll
                for (int s = 0; s < 8; ++s) sden += Sm[t * 68 + part * 8 + s];
#pragma unroll
                for (int d = 0; d < 16; ++d) nq += nn[part * 16 + d] * q[t * QS + part * 16 + d];
                float tot = sden + __expf(gm[0] - gM[t]) * nq;
                tot += __shfl_xor(tot, 1); tot += __shfl_xor(tot, 2); tot += __shfl_xor(tot, 4);
                if (part == 0) gden[t] = tot;
            }
            __syncthreads();
            {
                const int v = tid & 31, t0 = (tid >> 5) * 4;
                float a1[4] = {0.f, 0.f, 0.f, 0.f}, a2[4] = {0.f, 0.f, 0.f, 0.f};
                for (int s4 = 0; s4 < 16; ++s4) {
                    float vx[4];
#pragma unroll
                    for (int e = 0; e < 4; ++e) vx[e] = vv[(s4 * 4 + e) * 32 + v];
#pragma unroll
                    for (int i = 0; i < 4; ++i) { const f32x4 sv = *(const LAS f32x4*)(Sm + (t0 + i) * 68 + s4 * 4); a1[i] += sv[0] * vx[0] + sv[1] * vx[1] + sv[2] * vx[2] + sv[3] * vx[3]; }
                }
                for (int d4 = 0; d4 < 32; ++d4) {
                    const f32x4 cv = *(const LAS f32x4*)(Cm + v * QS + d4 * 4);
#pragma unroll
                    for (int i = 0; i < 4; ++i) { const f32x4 qv = *(const LAS f32x4*)(q + (t0 + i) * QS + d4 * 4); a2[i] += qv[0] * cv[0] + qv[1] * cv[1] + qv[2] * cv[2] + qv[3] * cv[3]; }
                }
                const float m = gm[0];
#pragma unroll
                for (int i = 0; i < 4; ++i) { const int t = t0 + i; const float Mt = gM[t];
                    const float num = a1[i] + __expf(m - Mt) * a2[i];
                    const float dn = fmaxf(fabsf(gden[t]), __expf(-(gb[t] + Mt)));
                    HS[(size_t)(row0 + t) * D + hd * 256 + vs * 32 + v] = num / dn; }
            }
            for (int p = tid; p < 2048; p += NTHR) { const int s = p >> 5; vw[p] = vv[p] * __expf(ga[s] - gM[63]); }
            __syncthreads();
            {
                const float decay = __expf(gm[0] - gM[63]);
                const int d = tid & 127, v0 = (tid >> 7) * 8;
                float acc[8];
#pragma unroll
                for (int i = 0; i < 8; ++i) acc[i] = decay * Cm[(v0 + i) * QS + d];
                for (int s = 0; s < 64; ++s) {
                    const float kv = k[s * QS + d];
                    const f32x4 w0 = *(const LAS f32x4*)(vw + s * 32 + v0), w1 = *(const LAS f32x4*)(vw + s * 32 + v0 + 4);
                    acc[0] += w0[0] * kv; acc[1] += w0[1] * kv; acc[2] += w0[2] * kv; acc[3] += w0[3] * kv;
                    acc[4] += w1[0] * kv; acc[5] += w1[1] * kv; acc[6] += w1[2] * kv; acc[7] += w1[3] * kv;
                }
                float nacc = 0.f;
                if (tid < 128) { nacc = decay * nn[d]; for (int s = 0; s < 64; ++s) nacc += __expf(ga[s] - gM[63]) * k[s * QS + d]; }
                __syncthreads();
#pragma unroll
                for (int i = 0; i < 8; ++i) Cm[(v0 + i) * QS + d] = acc[i];
                if (tid < 128) nn[d] = nacc;
                if (tid == 0) gm[0] = gb[63] + gM[63];
            }
            __syncthreads();
        }
    }
}

typedef short s16x4 __attribute__((ext_vector_type(4)));
typedef short sbf16x8 __attribute__((ext_vector_type(8)));
#define TR16(p) __builtin_amdgcn_ds_read_tr16_b64_v4i16((LAS s16x4*)(p))
__device__ __forceinline__ sbf16x8 cat4(s16x4 a, s16x4 b) { return __builtin_shufflevector(a, b, 0, 1, 2, 3, 4, 5, 6, 7); }
__device__ __forceinline__ f32x4 mfma16(sbf16x8 a, sbf16x8 b, f32x4 c) { return __builtin_amdgcn_mfma_f32_16x16x32_bf16(a, b, c, 0, 0, 0); }
__device__ __forceinline__ sbf16x8 pack8s(float a0, float a1, float a2, float a3, float a4, float a5, float a6, float a7) {
    v4u w; w.x = pg8::cvt_pk_bf16(a0, a1); w.y = pg8::cvt_pk_bf16(a2, a3); w.z = pg8::cvt_pk_bf16(a4, a5); w.w = pg8::cvt_pk_bf16(a6, a7); return __builtin_bit_cast(sbf16x8, w); }
__device__ __forceinline__ float bf_s(short x) { return __builtin_bit_cast(float, ((unsigned)(unsigned short)x) << 16); }
template <int NSB>
__device__ __forceinline__ void scan_chunk_body(LAS unsigned char* Qs, LAS unsigned char* Ks, LAS unsigned char* Vs, LAS unsigned char* Vw, LAS unsigned char* Cr, LAS unsigned char* Cw,
                                                const LAS float* WS, const LAS float* ETS, const LAS float* WI, const LAS float* EM, const LAS unsigned short* WSB, const LAS float* DEC,
                                                const int ch, const int tb, const int vt, const int w, const int l15, const int g, const int ql, const int pl, f32x4 (&accC)[3], bf16* orow) {
            constexpr int QB = 272, VB = 80;
            const sbf16x8 ones = (sbf16x8){0x3F80, 0x3F80, 0x3F80, 0x3F80, 0x3F80, 0x3F80, 0x3F80, 0x3F80};
            const int tt = tb * 16 + l15;
            sbf16x8 qf[4], kf[NSB][4]; f32x4 wv[NSB];
#pragma unroll
            for (int kd = 0; kd < 4; ++kd) qf[kd] = *(const LAS sbf16x8*)(Qs + (tb * 16 + l15) * QB + (32 * kd + 8 * g) * 2);
#pragma unroll
            for (int kd = 0; kd < 4; ++kd)
#pragma unroll
                for (int sb = 0; sb < NSB; ++sb) kf[sb][kd] = *(const LAS sbf16x8*)(Ks + (sb * 16 + l15) * QB + (32 * kd + 8 * g) * 2);
            const float ets = ETS[ch * 64 + tt];
#pragma unroll
            for (int sb = 0; sb < NSB; ++sb) wv[sb] = *(const LAS f32x4*)(WS + ch * 64 + sb * 16 + 4 * g);
            __builtin_amdgcn_sched_barrier(0);
            f32x4 sacc[NSB]; f32x4 pv = (f32x4){0.f, 0.f, 0.f, 0.f}, qc = pv, qn = pv, psum = pv;
#pragma unroll
            for (int sb = 0; sb < NSB; ++sb) sacc[sb] = (f32x4){0.f, 0.f, 0.f, 0.f};
#pragma unroll
            for (int kd = 0; kd < 4; ++kd) {
#pragma unroll
                for (int sb = 0; sb < NSB; ++sb) sacc[sb] = mfma16(kf[sb][kd], qf[kd], sacc[sb]);
            }
            __builtin_amdgcn_sched_barrier(0);
            sbf16x8 cf[4], nf[4]; s16x4 va[2], vb[2];
#pragma unroll
            for (int ks = 0; ks < 2; ++ks) { va[ks] = TR16(Vs + (32 * ks + 4 * g + ql) * VB + (16 * vt + 4 * pl) * 2); vb[ks] = TR16(Vs + (32 * ks + 16 + 4 * g + ql) * VB + (16 * vt + 4 * pl) * 2); }
#pragma unroll
            for (int kd = 0; kd < 4; ++kd) { cf[kd] = *(const LAS sbf16x8*)(Cr + (16 * vt + l15) * QB + (32 * kd + 8 * g) * 2); nf[kd] = *(const LAS sbf16x8*)(Cr + (32 + l15) * QB + (32 * kd + 8 * g) * 2); }
            const f32x4 wiv = *(const LAS f32x4*)(WI + ch * 64 + tb * 16 + 4 * g), emv = *(const LAS f32x4*)(EM + ch * 64 + tb * 16 + 4 * g);
            __builtin_amdgcn_sched_barrier(0);
            float P[4][4];
#pragma unroll
            for (int sb = 0; sb < 4; ++sb) {
                if (sb < NSB) {
#pragma unroll
                    for (int r = 0; r < 4; ++r) P[sb][r] = ((sb * 16 + 4 * g + r) <= tt) ? sacc[sb < NSB ? sb : 0][r] * wv[sb < NSB ? sb : 0][r] * ets : 0.f;
                } else {
#pragma unroll
                    for (int r = 0; r < 4; ++r) P[sb][r] = 0.f;
                }
            }
#pragma unroll
            for (int ks = 0; ks < 2; ++ks) {
                const sbf16x8 pf = pack8s(P[2 * ks][0], P[2 * ks][1], P[2 * ks][2], P[2 * ks][3], P[2 * ks + 1][0], P[2 * ks + 1][1], P[2 * ks + 1][2], P[2 * ks + 1][3]);
                pv = mfma16(pf, cat4(va[ks], vb[ks]), pv); psum = mfma16(pf, ones, psum);
            }
#pragma unroll
            for (int kd = 0; kd < 4; ++kd) { qc = mfma16(qf[kd], cf[kd], qc); qn = mfma16(qf[kd], nf[kd], qn); }
            __builtin_amdgcn_sched_barrier(0);
            s16x4 k0[2], k1[2], x0[2][2], x1[2][2]; sbf16x8 of[2];
#pragma unroll
            for (int ks = 0; ks < 2; ++ks) {
                const int sr = 32 * ks + 8 * g;
                k0[ks] = TR16(Ks + (sr + ql) * QB + (16 * w + 4 * pl) * 2); k1[ks] = TR16(Ks + (sr + 4 + ql) * QB + (16 * w + 4 * pl) * 2);
#pragma unroll
                for (int v = 0; v < 2; ++v) { x0[ks][v] = TR16(Vw + (sr + ql) * VB + (16 * v + 4 * pl) * 2); x1[ks][v] = TR16(Vw + (sr + 4 + ql) * VB + (16 * v + 4 * pl) * 2); }
                of[ks] = *(const LAS sbf16x8*)(WSB + ch * 64 + sr);
            }
            const float decay = DEC[ch];
            __builtin_amdgcn_sched_barrier(0);
#pragma unroll
            for (int r = 0; r < 4; ++r) { const float den = psum[r] + wiv[r] * qn[r], num = pv[r] + wiv[r] * qc[r]; orow[(size_t)r * D] = (bf16)f2bf(num * __builtin_amdgcn_rcpf(fmaxf(fabsf(den), emv[r]))); }
#pragma unroll
            for (int v = 0; v < 3; ++v) accC[v] = accC[v] * decay;
#pragma unroll
            for (int ks = 0; ks < 2; ++ks) {
                const sbf16x8 kt = cat4(k0[ks], k1[ks]);
#pragma unroll
                for (int v = 0; v < 2; ++v) accC[v] = mfma16(kt, cat4(x0[ks][v], x1[ks][v]), accC[v]);
                accC[2] = mfma16(kt, of[ks], accC[2]);
            }
#pragma unroll
            for (int v = 0; v < 3; ++v) { v2u o; o.x = pg8::cvt_pk_bf16(accC[v][0], accC[v][1]); o.y = pg8::cvt_pk_bf16(accC[v][2], accC[v][3]); *(LAS v2u*)(Cw + (16 * v + l15) * QB + (16 * w + 4 * g) * 2) = o; }
}
__device__ __forceinline__ void p_scan_mfma(Frame& F, int j, bf16* HS) {
    constexpr int QB = 272, VB = 80;
    constexpr int OFF_Q = 0, OFF_K = 2 * 64 * QB, OFF_V = 4 * 64 * QB, OFF_VW = OFF_V + 2 * 64 * VB, OFF_C = OFF_VW + 2 * 64 * VB;
    constexpr int OFF_WS = OFF_C + 2 * 48 * QB, OFF_ETS = OFF_WS + 8192, OFF_WI = OFF_ETS + 8192, OFF_EM = OFF_WI + 8192, OFF_WSB = OFF_EM + 8192, OFF_DEC = OFF_WSB + 4096, OFF_PM63 = OFF_DEC + 128, OFF_B63 = OFF_PM63 + 128;
    static_assert(OFF_B63 + 128 <= LDSCTL_OFF, "scan LDS map");
    LAS unsigned char* L = F.lds;
    const int tid = F.tid, lane = F.lane, w = F.wave, l15 = lane & 15, g = lane >> 4, ql = l15 >> 2, pl = l15 & 3, tb = w & 3, vt = w >> 2;
    LAS float* WS = (LAS float*)(L + OFF_WS); LAS float* ETS = (LAS float*)(L + OFF_ETS); LAS float* WI = (LAS float*)(L + OFF_WI); LAS float* EM = (LAS float*)(L + OFF_EM);
    LAS unsigned short* WSB = (LAS unsigned short*)(L + OFF_WSB); LAS float* DEC = (LAS float*)(L + OFF_DEC); LAS float* PM63 = (LAS float*)(L + OFF_PM63); LAS float* B63 = (LAS float*)(L + OFF_B63);
    const bf16* PROJ = (const bf16*)(F.ws + WS_PROJ);
    const float* GATES = (const float*)(F.ws + WS_GATES);
    const float* bg = KIN(I_MBG) + j * 8;
    const float scale = 0.08838834764831845f;
    const sbf16x8 ones = (sbf16x8){0x3F80, 0x3F80, 0x3F80, 0x3F80, 0x3F80, 0x3F80, 0x3F80, 0x3F80};
    for (int item0 = blockIdx.x; item0 < 256; item0 += F.G) {
        const int item = (((item0 & 7) * 4 + (item0 >> 6)) << 3) | ((item0 >> 3) & 7);
        const int b = item >> 5, hd = (item >> 3) & 3, vs = item & 7;
        const float bi = bg[hd], bfg = bg[4 + hd];
        const bf16* qbase = PROJ + (size_t)(b * SEQ) * NPROJ + hd * 128;
        const bf16* vbase = PROJ + (size_t)(b * SEQ) * NPROJ + 1024 + hd * 256 + vs * 32;
        const float* gbase = GATES + (size_t)(b * SEQ) * 8 + hd;
#ifdef SCAN_ZERO_LDS
        for (int i = tid; i < (OFF_B63 + 128) / 4; i += NTHR) ((LAS unsigned*)L)[i] = 0u;
        __syncthreads();
#endif
        for (int i = tid; i < 48 * QB / 4; i += NTHR) ((LAS unsigned*)(L + OFF_C))[i] = 0u;
#pragma unroll
        for (int cc = 0; cc < 4; ++cc) {
            const int c = 4 * w + cc, pos = c * 64 + lane;
            const float ipre = gbase[(size_t)pos * 8] + bi, lf = logsigmoid_f(gbase[(size_t)pos * 8 + 4] + bfg);
            float bc = lf;
#pragma unroll
            for (int o = 1; o < 64; o <<= 1) { const float t = __shfl_up(bc, o); if (lane >= o) bc += t; }
            const float a = ipre - bc;
            float pm = a;
#pragma unroll
            for (int o = 1; o < 64; o <<= 1) { const float t = __shfl_up(pm, o); if (lane >= o) pm = fmaxf(pm, t); }
            WS[pos] = a; ETS[pos] = bc; WI[pos] = pm;
            if (lane == 63) { PM63[c] = pm; B63[c] = bc; }
        }
        __syncthreads();
        {
            float mw[4] = {0.f, 0.f, 0.f, 0.f}; float mc = 0.f;
#pragma unroll
            for (int c = 0; c < 32; ++c) { if ((c >> 2) == w) mw[c & 3] = mc; mc = B63[c] + fmaxf(mc, PM63[c]); }
#pragma unroll
            for (int cc = 0; cc < 4; ++cc) {
                const int c = 4 * w + cc, pos = c * 64 + lane; const float m_c = mw[cc];
                const float a = WS[pos], bc = ETS[pos], pm = WI[pos];
                const float M63 = fmaxf(m_c, PM63[c]), Mt = fmaxf(m_c, pm);
                const float wsv = __expf(a - M63);
                WS[pos] = wsv; WSB[pos] = (unsigned short)f2bf(wsv); ETS[pos] = __expf(M63 - Mt) * scale; WI[pos] = __expf(m_c - Mt) * scale; EM[pos] = __expf(-(bc + Mt));
                if (lane == 0) DEC[c] = __expf(m_c - M63);
            }
        }
        __syncthreads();
        f32x4 accC[3];
#pragma unroll
        for (int v = 0; v < 3; ++v) accC[v] = (f32x4){0.f, 0.f, 0.f, 0.f};
        const int sr0 = tid >> 4, sc0 = (tid & 15) * 8, svr = (tid >> 2) & 63, svc = (tid & 3) * 8;
        const bf16* gq = qbase + (size_t)sr0 * NPROJ + sc0; const bf16* gv = vbase + (size_t)svr * NPROJ + svc;
        const int lq0 = sr0 * QB + sc0 * 2, lv0 = svr * VB + svc * 2;
        v4u qr[2], kr[2], vr = (v4u){0u, 0u, 0u, 0u};
#pragma unroll
        for (int i = 0; i < 2; ++i) { qr[i] = *(const v4u*)(gq + (size_t)(32 * i) * NPROJ); kr[i] = *(const v4u*)(gq + (size_t)(32 * i) * NPROJ + 512); }
        if (tid < 256) vr = *(const v4u*)gv;
#define SCAN_STAGE(buf, chn) do { \
            _Pragma("unroll") for (int i = 0; i < 2; ++i) { *(LAS v4u*)(L + OFF_Q + (buf) * 64 * QB + lq0 + 32 * i * QB) = qr[i]; *(LAS v4u*)(L + OFF_K + (buf) * 64 * QB + lq0 + 32 * i * QB) = kr[i]; } \
            if (tid < 256) { *(LAS v4u*)(L + OFF_V + (buf) * 64 * VB + lv0) = vr; const float wsr = WS[(chn) * 64 + svr]; \
                v4u sw; sw.x = pg8::cvt_pk_bf16(bflo(vr.x) * wsr, bfhi(vr.x) * wsr); sw.y = pg8::cvt_pk_bf16(bflo(vr.y) * wsr, bfhi(vr.y) * wsr); sw.z = pg8::cvt_pk_bf16(bflo(vr.z) * wsr, bfhi(vr.z) * wsr); sw.w = pg8::cvt_pk_bf16(bflo(vr.w) * wsr, bfhi(vr.w) * wsr); \
                *(LAS v4u*)(L + OFF_VW + (buf) * 64 * VB + lv0) = sw; } } while (0)
        SCAN_STAGE(0, 0);
        __syncthreads();
        bf16* obase = HS + (size_t)(b * SEQ + tb * 16 + 4 * g) * D + hd * 256 + vs * 32 + vt * 16 + l15;
        for (int ch = 0; ch < 32; ++ch) {
            const int cb = ch & 1, nb = cb ^ 1;
            LAS unsigned char* Qs = L + OFF_Q + cb * 64 * QB; LAS unsigned char* Ks = L + OFF_K + cb * 64 * QB; LAS unsigned char* Vs = L + OFF_V + cb * 64 * VB; LAS unsigned char* Vw = L + OFF_VW + cb * 64 * VB;
            LAS unsigned char* Cr = L + OFF_C + cb * 48 * QB; LAS unsigned char* Cw = L + OFF_C + nb * 48 * QB;
            { const size_t nro = (size_t)((ch < 31 ? ch + 1 : ch) * 64) * NPROJ;
#pragma unroll
              for (int i = 0; i < 2; ++i) { qr[i] = *(const v4u*)(gq + nro + (size_t)(32 * i) * NPROJ); kr[i] = *(const v4u*)(gq + nro + (size_t)(32 * i) * NPROJ + 512); }
              if (tid < 256) vr = *(const v4u*)(gv + nro); }
            { bf16* orow = obase + (size_t)(ch * 64) * D;
              if (tb == 0) scan_chunk_body<1>(Qs, Ks, Vs, Vw, Cr, Cw, WS, ETS, WI, EM, WSB, DEC, ch, tb, vt, w, l15, g, ql, pl, accC, orow);
              else if (tb == 1) scan_chunk_body<2>(Qs, Ks, Vs, Vw, Cr, Cw, WS, ETS, WI, EM, WSB, DEC, ch, tb, vt, w, l15, g, ql, pl, accC, orow);
              else if (tb == 2) scan_chunk_body<3>(Qs, Ks, Vs, Vw, Cr, Cw, WS, ETS, WI, EM, WSB, DEC, ch, tb, vt, w, l15, g, ql, pl, accC, orow);
              else scan_chunk_body<4>(Qs, Ks, Vs, Vw, Cr, Cw, WS, ETS, WI, EM, WSB, DEC, ch, tb, vt, w, l15, g, ql, pl, accC, orow); }
#ifdef SCAN_EXTRA_SYNC
            __syncthreads();
#endif
            SCAN_STAGE(nb, (ch < 31 ? ch + 1 : ch));
            __syncthreads();
        }
#undef SCAN_STAGE
    }
}

__device__ __forceinline__ void p_mnorm(Frame& F, int j) {
    const bf16* HS = (const bf16*)(F.ws + WS_HS); const bf16* PROJ = (const bf16*)(F.ws + WS_PROJ); bf16* A2 = (bf16*)(F.ws + WS_A2);
    const float* ng = KIN(I_MNORMG) + j * 1024;
    const int gw = blockIdx.x * NWAVES + F.wave, NGW = F.G * NWAVES, lane = F.lane;
    f32x4 g[4];
#pragma unroll
    for (int hd = 0; hd < 4; ++hd) g[hd] = *((const f32x4*)ng + lane + 64 * hd);
    for (int row0 = gw * 2; row0 < NTOK; row0 += NGW * 2) {
        f32x4 v[2][4]; v2u ow[2][4];
#pragma unroll
        for (int r = 0; r < 2; ++r)
#pragma unroll
            for (int hd = 0; hd < 4; ++hd) { const v2u hw = *((const v2u*)(HS + (size_t)(row0 + r) * D) + lane + 64 * hd); v[r][hd] = (f32x4){bflo(hw.x), bfhi(hw.x), bflo(hw.y), bfhi(hw.y)}; ow[r][hd] = *((const v2u*)(PROJ + (size_t)(row0 + r) * NPROJ + 2048) + lane + 64 * hd); }
#pragma unroll
        for (int r = 0; r < 2; ++r)
#pragma unroll
            for (int hd = 0; hd < 4; ++hd) {
                const f32x4 x = v[r][hd];
                const float ss = wave_sum((x[0] * x[0] + x[1] * x[1]) + (x[2] * x[2] + x[3] * x[3]));
                const float rinv = 1.0f / sqrtf(ss * (1.0f / 256.0f) + EPS);
                const float o0 = bflo(ow[r][hd].x), o1 = bfhi(ow[r][hd].x), o2 = bflo(ow[r][hd].y), o3 = bfhi(ow[r][hd].y);
                f32x4 q;
                q[0] = x[0] * rinv * g[hd][0] * __builtin_amdgcn_rcpf(1.0f + __expf(-o0)); q[1] = x[1] * rinv * g[hd][1] * __builtin_amdgcn_rcpf(1.0f + __expf(-o1));
                q[2] = x[2] * rinv * g[hd][2] * __builtin_amdgcn_rcpf(1.0f + __expf(-o2)); q[3] = x[3] * rinv * g[hd][3] * __builtin_amdgcn_rcpf(1.0f + __expf(-o3));
                v2u o; o.x = pk2(q[0], q[1]); o.y = pk2(q[2], q[3]);
                *((v2u*)(A2 + (size_t)(row0 + r) * D) + lane + 64 * hd) = o;
            }
    }
}

__device__ __forceinline__ void p_conv(Frame& F, int j) {
    const bf16* PROJ = (const bf16*)(F.ws + WS_PROJ); bf16* A2 = (bf16*)(F.ws + WS_A2);
    const float* cw = KIN(I_SCONVW) + (size_t)j * 3 * 1024;
    for (int item = blockIdx.x * NTHR + F.tid; item < (NTOK / 16) * 128; item += F.G * NTHR) {
        const int cg = item & 127, rc = item >> 7, row0 = rc * 16, ch = cg * 8;
        float w0[8], w1[8], w2[8], um2[8], um1[8];
#pragma unroll
        for (int c = 0; c < 8; ++c) { w0[c] = cw[ch + c]; w1[c] = cw[1024 + ch + c]; w2[c] = cw[2048 + ch + c]; um2[c] = 0.f; um1[c] = 0.f; }
        if ((row0 & (SEQ - 1)) != 0) {
            const v4u a = *(const v4u*)(PROJ + (size_t)(row0 - 2) * NPROJ + ch), bq = *(const v4u*)(PROJ + (size_t)(row0 - 1) * NPROJ + ch);
            um2[0] = bflo(a.x); um2[1] = bfhi(a.x); um2[2] = bflo(a.y); um2[3] = bfhi(a.y); um2[4] = bflo(a.z); um2[5] = bfhi(a.z); um2[6] = bflo(a.w); um2[7] = bfhi(a.w);
            um1[0] = bflo(bq.x); um1[1] = bfhi(bq.x); um1[2] = bflo(bq.y); um1[3] = bfhi(bq.y); um1[4] = bflo(bq.z); um1[5] = bfhi(bq.z); um1[6] = bflo(bq.w); um1[7] = bfhi(bq.w);
        }
        for (int r = 0; r < 16; ++r) {
            const v4u uw = *(const v4u*)(PROJ + (size_t)(row0 + r) * NPROJ + ch), gw = *(const v4u*)(PROJ + (size_t)(row0 + r) * NPROJ + 1024 + ch);
            float u0[8], g[8], y[8];
            u0[0] = bflo(uw.x); u0[1] = bfhi(uw.x); u0[2] = bflo(uw.y); u0[3] = bfhi(uw.y); u0[4] = bflo(uw.z); u0[5] = bfhi(uw.z); u0[6] = bflo(uw.w); u0[7] = bfhi(uw.w);
            g[0] = bflo(gw.x); g[1] = bfhi(gw.x); g[2] = bflo(gw.y); g[3] = bfhi(gw.y); g[4] = bflo(gw.z); g[5] = bfhi(gw.z); g[6] = bflo(gw.w); g[7] = bfhi(gw.w);
#pragma unroll
            for (int c = 0; c < 8; ++c) { y[c] = g[c] * (w0[c] * um2[c] + w1[c] * um1[c] + w2[c] * u0[c]); um2[c] = um1[c]; um1[c] = u0[c]; }
            v4u o; o.x = pk2(y[0], y[1]); o.y = pk2(y[2], y[3]); o.z = pk2(y[4], y[5]); o.w = pk2(y[6], y[7]);
            *(v4u*)(A2 + (size_t)(row0 + r) * D + ch) = o;
        }
    }
}

constexpr int N_STEPS = 2 + 2 * (8 + 7);
__global__ void __launch_bounds__(NTHR, 2) trunk_fwd(Args args) {
    extern __shared__ __attribute__((aligned(16))) unsigned char lds_raw[];
    Frame F;
    F.lds = (LAS unsigned char*)lds_raw;
    F.LC = (volatile LAS unsigned*)(F.lds + LDSCTL_OFF);
    F.tid = threadIdx.x; F.lane = F.tid & 63; F.wave = __builtin_amdgcn_readfirstlane(F.tid >> 6); F.G = gridDim.x;
    F.out = as_global(args.out); F.ws = as_global(args.ws); F.ctl = as_global((unsigned*)(args.ws + WS_CTL));
    for (int u = F.tid; u < 256; u += NTHR) F.LC[u] = 0u;
    __syncthreads();
    if (!N_LAUNCH_SPLIT) (void)xcd_barrier_post(F.ctl + CW_BAR, F.LC);
    const int lo = N_LAUNCH_SPLIT ? args.ph_lo : 0, hi = N_LAUNCH_SPLIT ? args.ph_hi : N_STEPS;
    int step = 0;
#ifndef EN_MASK
#define EN_MASK 0xFFFFFFFFu
#endif
#define EN(k) (((EN_MASK) >> (k)) & 1u)
#ifndef OUTPROJ_WGM
#define OUTPROJ_WGM 4
#endif
#ifndef INPROJ_WGM
#define INPROJ_WGM 4
#endif
#ifndef MOE_WGM
#define MOE_WGM 4
#endif
#ifndef BAR_REP
#define BAR_REP 0
#endif
#ifndef REP_MASK
#define REP_MASK 0u
#endif
#define REP(k) for (int _r = 0; _r < 1 + (int)(((REP_MASK) >> (k)) & 1u); ++_r)
#define IN_STEP() (lo <= step && step < hi)
#define END_STEP() do { if (!N_LAUNCH_SPLIT) { XcdBarrier _b; _b.bar = (unsigned*)launder(F.ws) + CW_BAR; _b.x = xb_xcc_id(); _b.st = F.LC; xcd_barrier(_b); if (BAR_REP) xcd_barrier(_b); } ++step; } while (0)
#define X (launder(F.out))
#define WSB (launder(F.ws))
#define XS ((bf16*)(WSB + WS_X))
#define MOD ((const float*)(WSB + WS_MOD))
#define H ((bf16*)(WSB + WS_H))
#define PROJ ((bf16*)(WSB + WS_PROJ))
#define A2 ((bf16*)(WSB + WS_A2))

    if (EN(0) && IN_STEP()) { Frame P = fresh(F); REP(15) { p_adaln(P); __syncthreads(); } REP(0) { p_convert(P); } } END_STEP();
    if (EN(1) && IN_STEP()) REP(1) { Frame P = fresh(F); row_phase<false, 1, false, true>(P, KIN(I_X), nullptr, MOD, KIN(I_NORMG), nullptr, 0, KIN(I_MWIN), nullptr, nullptr, nullptr, 0); } END_STEP();

    for (int l = 0; l < DEPTH; ++l) {
        const int lp = l >> 1;
        if ((l & 1) == 0) {
            if (EN(2) && IN_STEP()) REP(2) { pg8::DenseSched S; S.T.init(NTOK / 256, NPROJ / 256, pg8::opaque_s(F.G), pg8::opaque_s((int)blockIdx.x), INPROJ_WGM); S.A = (const char*)H; S.Bt = (const char*)(WSB + WS_WMIN) + (size_t)lp * 3072 * 1024 * 2; S.K = 1024;
                pg8::EpiStoreBf16 E{PROJ, NPROJ, 1.0f}; pg8::gemm_phase<pg8::EpiStoreBf16, pg8::DenseSched, true>(F.lds, 1024, S, E); } END_STEP();
            if (EN(3) && IN_STEP()) REP(3) { Frame P = fresh(F); p_scan_mfma(P, lp, (bf16*)(P.ws + WS_HS));
#ifdef SCAN_SELFCHECK
                { float* H1 = (float*)(P.ws + WS_HMID); float* H2 = (float*)(P.ws + WS_END);
                  __syncthreads(); p_scan_mfma(P, lp, H1); __syncthreads(); p_scan_mfma(P, lp, H2); asm volatile("s_waitcnt vmcnt(0)" ::: "memory"); __syncthreads();
                  for (int item = blockIdx.x; item < 256; item += P.G) { const int b = item >> 5, hd = (item >> 3) & 3, vs = item & 7; int bad = 0;
                      for (int i = P.tid; i < 2048 * 32; i += NTHR) { const size_t o = (size_t)(b * SEQ + (i >> 5)) * D + hd * 256 + vs * 32 + (i & 31);
                          const unsigned a1 = __hip_atomic_load((const unsigned*)H1 + o, __ATOMIC_RELAXED, __HIP_MEMORY_SCOPE_AGENT), a2 = __hip_atomic_load((const unsigned*)H2 + o, __ATOMIC_RELAXED, __HIP_MEMORY_SCOPE_AGENT); if (a1 != a2) bad = 1; }
                      if (bad) __hip_atomic_fetch_or(P.ctl + 64, 1u, __ATOMIC_RELAXED, __HIP_MEMORY_SCOPE_AGENT); } }
#endif
#ifdef SCAN_BOTH
                __syncthreads(); p_scan(P, lp);
#endif
            } END_STEP();
            if (EN(4) && IN_STEP()) REP(4) { Frame P = fresh(F); p_mnorm(P, lp); } END_STEP();
            if (EN(5) && IN_STEP()) REP(5) { pg8::DenseSched S; S.T.init(NTOK / 256, 4, pg8::opaque_s(F.G), pg8::opaque_s((int)blockIdx.x), OUTPROJ_WGM); S.A = (const char*)A2; S.Bt = (const char*)(WSB + WS_WMOUT) + (size_t)lp * 1024 * 1024 * 2; S.K = 1024;
                pg8::EpiResid E{l == 0 ? KIN(I_X) : (const float*)nullptr, XS, MOD + (size_t)(l * 2) * 8 * 3072 + 2048}; pg8::gemm_phase<pg8::EpiResid, pg8::DenseSched, true>(F.lds, 1024, S, E); } END_STEP();
        } else {
            if (EN(10) && IN_STEP()) REP(10) { pg8::DenseSched S; S.T.init(NTOK / 256, NPROJ / 256, pg8::opaque_s(F.G), pg8::opaque_s((int)blockIdx.x), INPROJ_WGM); S.A = (const char*)H; S.Bt = (const char*)(WSB + WS_WSIN) + (size_t)lp * 3072 * 1024 * 2; S.K = 1024;
                pg8::EpiConvIn E{PROJ, NPROJ}; pg8::gemm_phase<pg8::EpiConvIn, pg8::DenseSched, true>(F.lds, 1024, S, E); } END_STEP();
            if (EN(11) && IN_STEP()) REP(11) { Frame P = fresh(F); p_conv(P, lp); } END_STEP();
            if (EN(12) && IN_STEP()) REP(12) { pg8::DenseSched S; S.T.init(NTOK / 256, 4, pg8::opaque_s(F.G), pg8::opaque_s((int)blockIdx.x), OUTPROJ_WGM); S.A = (const char*)A2; S.Bt = (const char*)(WSB + WS_WSOUT) + (size_t)lp * 1024 * 1024 * 2; S.K = 1024;
                pg8::EpiResid E{nullptr, XS, MOD + (size_t)(l * 2) * 8 * 3072 + 2048}; pg8::gemm_phase<pg8::EpiResid, pg8::DenseSched, true>(F.lds, 1024, S, E); } END_STEP();
        }
        if (EN(6) && IN_STEP()) REP(6) { Frame P = fresh(F); row_phase<false, 2, false>(P, XS, nullptr, MOD + (size_t)(l * 2 + 1) * 8 * 3072, KIN(I_NORMG) + (l * 2 + 1) * 1024, nullptr, 0,
                                                  KIN(I_RWG) + (size_t)l * 1024 * 4, KIN(I_RWE) + (size_t)l * 1024 * 32, KIN(I_RBG) + l * 4, KIN(I_RBE) + l * 32, l + 4 * _r); } END_STEP();
        if (EN(7) && IN_STEP()) REP(7) { Frame P = fresh(F); moe_tables(P, l); pg8::GuSched S; S.T.init((int)F.LC[LC_TOFF + 32], 4, pg8::opaque_s(F.G), pg8::opaque_s((int)blockIdx.x), MOE_WGM); S.A = (const char*)H; S.K = 512; S.Bt = (const char*)(WSB + WS_WGU) + (size_t)l * 32 * 1024 * 1024;
            S.slot_tok = (const int*)(WSB + WS_SLOTTOK); S.toff = (const PG8_LAS int*)(F.lds + LDSCTL_OFF + LC_TOFF * 4); S.cnt = (const PG8_LAS int*)(F.lds + LDSCTL_OFF + LC_CNT * 4); S.soff = (const PG8_LAS int*)(F.lds + LDSCTL_OFF + LC_SOFF * 4); S.sexp = (const PG8_LAS int*)(F.lds + LDSCTL_OFF + LC_SEXP * 4);
            pg8::EpiGateUp E{(unsigned char*)(WSB + WS_HMID)}; pg8::gemm_phase<pg8::EpiGateUp, pg8::GuSched, true, true>(F.lds, 512, S, E); } END_STEP();
        if (EN(8) && IN_STEP()) REP(8) { Frame P = fresh(F); moe_tables(P, l); pg8::DnSched S; S.T.init((int)F.LC[LC_TOFF + 32], 4, pg8::opaque_s(F.G), pg8::opaque_s((int)blockIdx.x), MOE_WGM); S.A = (const char*)(WSB + WS_HMID); S.K = 256; S.Bt = (const char*)(WSB + WS_WDN) + (size_t)l * 32 * 1024 * 512;
            S.toff = (const PG8_LAS int*)(F.lds + LDSCTL_OFF + LC_TOFF * 4); S.soff = (const PG8_LAS int*)(F.lds + LDSCTL_OFF + LC_SOFF * 4); S.sexp = (const PG8_LAS int*)(F.lds + LDSCTL_OFF + LC_SEXP * 4);
            pg8::EpiStoreF8 E{(unsigned char*)(WSB + WS_YR), 1024}; pg8::gemm_phase<pg8::EpiStoreF8, pg8::DnSched, true, true>(F.lds, 256, S, E); } END_STEP();
        if (l == 3) {
            if (EN(14) && IN_STEP()) REP(14) { Frame P = fresh(F); row_phase<true, 0, true>(P, XS, X, nullptr, KIN(I_FINALG), MOD + (size_t)(l * 2 + 1) * 8 * 3072, l, nullptr, nullptr, nullptr, nullptr, 0); } ++step;
        } else if (l == 1) {
            if (EN(13) && IN_STEP()) REP(13) { Frame P = fresh(F); row_phase<true, 1, false>(P, XS, XS, MOD + (size_t)((l + 1) * 2) * 8 * 3072, KIN(I_NORMG) + ((l + 1) * 2) * 1024, MOD + (size_t)(l * 2 + 1) * 8 * 3072, l,
                                                     KIN(I_MWIN) + (size_t)1 * 1024 * M_PROJ, nullptr, nullptr, nullptr, 0); } END_STEP();
        } else {
            if (EN(9) && IN_STEP()) REP(9) { Frame P = fresh(F); row_phase<true, 0, false>(P, XS, XS, MOD + (size_t)((l + 1) * 2) * 8 * 3072, KIN(I_NORMG) + ((l + 1) * 2) * 1024, MOD + (size_t)(l * 2 + 1) * 8 * 3072, l, nullptr, nullptr, nullptr, nullptr, 0); } END_STEP();
        }
    }
#undef IN_STEP
#undef END_STEP
#undef X
#undef WSB
#undef XS
#undef MOD
#undef H
#undef PROJ
#undef A2
}

extern "C" void kernel_launch(void* const* d_in, const int* in_sizes, int n_in, void* d_out, int out_size, void* d_ws, size_t ws_size, hipStream_t stream) {
    static int grid = 0;
    if (grid == 0) {
        if (n_in != 20 || in_sizes[0] != NTOK * D || out_size != NTOK * D || ws_size < WS_END) { fprintf(stderr, "kernel_launch: unexpected shapes (n_in %d, ws %zu)\n", n_in, ws_size); grid = -1; return; }
        int dev = 0, cus = 0, per_cu = 0;
        if (hipGetDevice(&dev) != hipSuccess || hipDeviceGetAttribute(&cus, hipDeviceAttributeMultiprocessorCount, dev) != hipSuccess) { grid = -1; return; }
        if (hipFuncSetAttribute((const void*)trunk_fwd, hipFuncAttributeMaxDynamicSharedMemorySize, LDS_BYTES) != hipSuccess) { fprintf(stderr, "kernel_launch: hipFuncSetAttribute failed\n"); grid = -1; return; }
        if (hipOccupancyMaxActiveBlocksPerMultiprocessor(&per_cu, (const void*)trunk_fwd, NTHR, LDS_BYTES) != hipSuccess || per_cu < 1) fprintf(stderr, "kernel_launch: occupancy query reports %d\n", per_cu);
        (void)hipGetLastError();
        grid = cus;
    }
    if (grid < 0) return;
    if (hipMemsetAsync((char*)d_ws + WS_CTL, 0, CTL_ZERO_BYTES, stream) != hipSuccess) return;
    Args a{};
    for (int i = 0; i < 20; ++i) a.in[i] = (const float*)d_in[i];
    a.out = (float*)d_out; a.ws = (unsigned char*)d_ws;
    if (N_LAUNCH_SPLIT) {
        for (int s = 0; s < N_STEPS; ++s) { a.ph_lo = s; a.ph_hi = s + 1; hipLaunchKernelGGL(trunk_fwd, dim3(grid), dim3(NTHR), LDS_BYTES, stream, a); }
    } else {
        a.ph_lo = 0; a.ph_hi = N_STEPS; hipLaunchKernelGGL(trunk_fwd, dim3(grid), dim3(NTHR), LDS_BYTES, stream, a);
    }
}
```

```cpp
#include <hip/hip_runtime.h>
#include <cstdio>
#include <cstdint>

#ifndef SCAN_MFMA
#define SCAN_MFMA 1
#endif
#ifndef N_LAUNCH_SPLIT
#define N_LAUNCH_SPLIT 0
#endif

namespace pg8 {
#define PG8_LAS __attribute__((address_space(3)))
typedef unsigned short bf16_t;
typedef short bf16x8 __attribute__((ext_vector_type(8)));
typedef float f32x4 __attribute__((ext_vector_type(4)));
typedef unsigned u32x4 __attribute__((ext_vector_type(4)));
constexpr int BM = 256, BK = 64, HALF = 128, HTB = HALF * BK * 2, STAGE_BYTES = 8 * HTB, NXCD = 8, WGM = 8;

__host__ __device__ __forceinline__ int lds_byte(int r, int c) { const int st = (r >> 4) * 2 + (c >> 5), rr = r & 15, cc = c & 31, ob = rr * 64 + cc * 2; return st * 1024 + (ob ^ (((ob >> 9) & 1) << 5)); }
__host__ __device__ __forceinline__ void stage_rc(int b, int& R, int& C) { const int st = b / 1024, sb = b % 1024, swz = sb ^ (((sb >> 9) & 1) << 5); R = (st >> 1) * 16 + swz / 64; C = (st & 1) * 32 + (swz % 64) / 2; }
__host__ __device__ __forceinline__ int perm32(int rho) { const int n = rho >> 4, i = rho & 15; return 8 * (i >> 2) + 4 * n + (i & 3); }

__device__ __forceinline__ int opaque_v(int x) { asm volatile("" : "+v"(x)); return x; }
__device__ __forceinline__ int opaque_s(int x) { asm volatile("" : "+s"(x)); return x; }
struct Unit { int pm, pn, e, r0, half; };

struct TileOrder {
    int nM, nN, nwg, G, c, wgm;
    __device__ __forceinline__ void init(int nM_, int nN_, int G_, int c_, int wgm_ = WGM) { nM = nM_; nN = nN_; nwg = nM * nN; G = G_; c = c_; wgm = wgm_; }
    __device__ __forceinline__ bool map(int i, int& pm, int& pn) const {
        const long L = (long)i * G + c; if (L >= nwg) return false;
        int wgid = (int)L; { const int q = nwg / NXCD, r = nwg % NXCD, xcd = wgid % NXCD, off = wgid / NXCD; wgid = (xcd < r ? xcd * (q + 1) : r * (q + 1) + (xcd - r) * q) + off; }
        const int nig = wgm * nN, gid = wgid / nig, fm = gid * wgm, gsz = (nM - fm) < wgm ? (nM - fm) : wgm;
        pm = fm + ((wgid % nig) % gsz); pn = (wgid % nig) / gsz; return true;
    }
};
struct DenseSched {
    static constexpr bool GATHER = false;
    TileOrder T; const char* A; const char* Bt; int K;
    __device__ __forceinline__ bool next(int i, Unit& u) const { u.e = 0; u.r0 = 0; u.half = 0; return T.map(i, u.pm, u.pn); }
    __device__ __forceinline__ const char* a_base(const Unit& u) const { return A + (size_t)u.pm * 256 * K * 2; }
    __device__ __forceinline__ const char* b_base(const Unit& u) const { return Bt + (size_t)u.pn * 256 * K * 2; }
    __device__ __forceinline__ void a_voff(const Unit&, int tid, unsigned (&v)[2][2]) const {
#pragma unroll
        for (int i = 0; i < 2; ++i) { int R, C; stage_rc(tid * 16 + i * 8192, R, C); v[0][i] = (unsigned)(R * K + C) * 2u; v[1][i] = v[0][i]; }
    }
};
struct GuSched {
    static constexpr bool GATHER = true;
    TileOrder T; const char* A; const char* Bt; const int* slot_tok; const PG8_LAS int* toff; const PG8_LAS int* cnt; const PG8_LAS int* soff; const PG8_LAS int* sexp; int K;
    __device__ __forceinline__ bool next(int i, Unit& u) const {
        if (T.map(i, u.pm, u.pn)) {
            int e = 0;
#pragma unroll
            for (int j = 1; j < 32; ++j) e += (toff[j] <= u.pm) ? 1 : 0;
            u.e = e; u.r0 = (u.pm - toff[e]) * 256; u.half = 0; return true;
        }
        const long sidx = (long)i * T.G + T.c - T.nwg; if (sidx >= 4 * soff[32]) return false;
        const int t = (int)sidx >> 2; u.pn = (int)sidx & 3; u.pm = toff[32] + t; u.e = sexp[t]; u.r0 = (toff[u.e + 1] - toff[u.e]) * 256; u.half = 1; return true;
    }
    __device__ __forceinline__ const char* a_base(const Unit&) const { return A; }
    __device__ __forceinline__ const char* b_base(const Unit& u) const { return Bt + ((size_t)u.e * 1024 + (size_t)u.pn * 256) * K * 2; }
    __device__ __forceinline__ void a_voff(const Unit& u, int tid, unsigned (&v)[2][2]) const {
        const int c1 = cnt[u.e] - 1;
#pragma unroll
        for (int h = 0; h < 2; ++h)
#pragma unroll
            for (int i = 0; i < 2; ++i) { int R, C; stage_rc(tid * 16 + i * 8192, R, C); int idx = u.r0 + h * 128 + R; idx = idx < c1 ? idx : c1;
                const int tok = slot_tok[u.e * 16384 + idx]; v[h][i] = (unsigned)(tok * K + C) * 2u; }
    }
};
struct DnSched {
    static constexpr bool GATHER = false;
    TileOrder T; const char* A; const char* Bt; const PG8_LAS int* toff; const PG8_LAS int* soff; const PG8_LAS int* sexp; int K;
    __device__ __forceinline__ bool next(int i, Unit& u) const {
        u.r0 = 0;
        if (T.map(i, u.pm, u.pn)) {
            int e = 0;
#pragma unroll
            for (int j = 1; j < 32; ++j) e += (toff[j] <= u.pm) ? 1 : 0;
            u.e = e; u.half = 0; return true;
        }
        const long sidx = (long)i * T.G + T.c - T.nwg; if (sidx >= 4 * soff[32]) return false;
        const int t = (int)sidx >> 2; u.pn = (int)sidx & 3; u.pm = toff[32] + t; u.e = sexp[t]; u.half = 1; return true;
    }
    __device__ __forceinline__ const char* a_base(const Unit& u) const { return A + (size_t)u.pm * 256 * K * 2; }
    __device__ __forceinline__ const char* b_base(const Unit& u) const { return Bt + ((size_t)u.e * 1024 + (size_t)u.pn * 256) * K * 2; }
    __device__ __forceinline__ void a_voff(const Unit&, int tid, unsigned (&v)[2][2]) const {
#pragma unroll
        for (int i = 0; i < 2; ++i) { int R, C; stage_rc(tid * 16 + i * 8192, R, C); v[0][i] = (unsigned)(R * K + C) * 2u; v[1][i] = v[0][i]; }
    }
};

typedef __bf16 bf16x2_t __attribute__((ext_vector_type(2)));
__device__ __forceinline__ unsigned cvt_pk_bf16(float lo, float hi) { bf16x2_t v; v[0] = (__bf16)lo; v[1] = (__bf16)hi; return __builtin_bit_cast(unsigned, v); }
__device__ __forceinline__ u32x4 pack8(const f32x4 a, const f32x4 b) { u32x4 w; w.x = cvt_pk_bf16(a[0], a[1]); w.y = cvt_pk_bf16(a[2], a[3]); w.z = cvt_pk_bf16(b[0], b[1]); w.w = cvt_pk_bf16(b[2], b[3]); return w; }

struct EpiStoreBf16 {
    static constexpr bool PERM = true;
    bf16_t* O; int ldc; float sc;
    __device__ __forceinline__ void operator()(const f32x4 (&acc)[2][2][4][2], const Unit& u, int wr, int wc, int fr, int fq) const {
        const int row0 = u.pm * BM + wr * 64 + fr, col0 = u.pn * BM + wc * 32 + 8 * fq;
#pragma unroll
        for (int ai = 0; ai < 2; ++ai) { if (ai == 1 && u.half) break;
#pragma unroll
            for (int m = 0; m < 4; ++m) { bf16_t* rowp = O + (size_t)(row0 + ai * HALF + m * 16) * ldc + col0;
#pragma unroll
                for (int bj = 0; bj < 2; ++bj) *(u32x4*)(rowp + bj * HALF) = pack8(acc[ai][bj][m][0] * sc, acc[ai][bj][m][1] * sc); } }
    }
};
struct EpiConvIn {
    static constexpr bool PERM = true;
    bf16_t* O; int ldc;
    __device__ __forceinline__ void operator()(const f32x4 (&acc)[2][2][4][2], const Unit& u, int wr, int wc, int fr, int fq) const {
        const int row0 = u.pm * BM + wr * 64 + fr;
        if (u.pn < 8) {
            const int col0 = u.pn * HALF + wc * 32 + 8 * fq;
#pragma unroll
            for (int ai = 0; ai < 2; ++ai)
#pragma unroll
                for (int m = 0; m < 4; ++m) { bf16_t* rowp = O + (size_t)(row0 + ai * HALF + m * 16) * ldc + col0;
                    *(u32x4*)rowp = pack8(acc[ai][0][m][0] * acc[ai][1][m][0], acc[ai][0][m][1] * acc[ai][1][m][1]); }
        } else {
            const int col0 = 1024 + (u.pn - 8) * BM + wc * 32 + 8 * fq;
#pragma unroll
            for (int ai = 0; ai < 2; ++ai)
#pragma unroll
                for (int m = 0; m < 4; ++m) { bf16_t* rowp = O + (size_t)(row0 + ai * HALF + m * 16) * ldc + col0;
#pragma unroll
                    for (int bj = 0; bj < 2; ++bj) *(u32x4*)(rowp + bj * HALF) = pack8(acc[ai][bj][m][0], acc[ai][bj][m][1]); }
        }
    }
};
__device__ __forceinline__ float silu_f(float g) { return g * __builtin_amdgcn_rcpf(1.0f + __expf(-g)); }
__device__ __forceinline__ unsigned pk4_fp8(float a, float b, float c, float d) { unsigned w = 0; w = __builtin_amdgcn_cvt_pk_fp8_f32(a, b, w, false); w = __builtin_amdgcn_cvt_pk_fp8_f32(c, d, w, true); return w; }
constexpr float W8_INV = 1.0f / 32.0f;
struct EpiGateUp {
    static constexpr bool PERM = true;
    unsigned char* O;
    __device__ __forceinline__ void operator()(const f32x4 (&acc)[2][2][4][2], const Unit& u, int wr, int wc, int fr, int fq) const {
        const int row0 = u.pm * BM + wr * 64 + fr, col0 = u.pn * HALF + wc * 32 + 8 * fq;
        typedef unsigned u32x2 __attribute__((ext_vector_type(2)));
#pragma unroll
        for (int ai = 0; ai < 2; ++ai) { if (ai == 1 && u.half) break;
#pragma unroll
            for (int m = 0; m < 4; ++m) { unsigned char* rowp = O + (size_t)(row0 + ai * HALF + m * 16) * 512 + col0;
                f32x4 h0, h1;
#pragma unroll
                for (int j = 0; j < 4; ++j) { h0[j] = silu_f(acc[ai][0][m][0][j] * W8_INV) * (acc[ai][1][m][0][j] * W8_INV); h1[j] = silu_f(acc[ai][0][m][1][j] * W8_INV) * (acc[ai][1][m][1][j] * W8_INV); }
                u32x2 w; w.x = pk4_fp8(h0[0], h0[1], h0[2], h0[3]); w.y = pk4_fp8(h1[0], h1[1], h1[2], h1[3]); *(u32x2*)rowp = w; } }
    }
};
struct EpiStoreF8 {
    static constexpr bool PERM = true;
    unsigned char* O; int ldc;
    __device__ __forceinline__ void operator()(const f32x4 (&acc)[2][2][4][2], const Unit& u, int wr, int wc, int fr, int fq) const {
        const int row0 = u.pm * BM + wr * 64 + fr, col0 = u.pn * BM + wc * 32 + 8 * fq;
        typedef unsigned u32x2 __attribute__((ext_vector_type(2)));
#pragma unroll
        for (int ai = 0; ai < 2; ++ai) { if (ai == 1 && u.half) break;
#pragma unroll
            for (int m = 0; m < 4; ++m) { unsigned char* rowp = O + (size_t)(row0 + ai * HALF + m * 16) * ldc + col0;
#pragma unroll
                for (int bj = 0; bj < 2; ++bj) { u32x2 w; w.x = pk4_fp8(acc[ai][bj][m][0][0], acc[ai][bj][m][0][1], acc[ai][bj][m][0][2], acc[ai][bj][m][0][3]);
                    w.y = pk4_fp8(acc[ai][bj][m][1][0], acc[ai][bj][m][1][1], acc[ai][bj][m][1][2], acc[ai][bj][m][1][3]); *(u32x2*)(rowp + bj * HALF) = w; } } }
    }
};
struct EpiResid {
    static constexpr bool PERM = true;
    const float* xin32; bf16_t* xs; const float* gatev;
    __device__ __forceinline__ void operator()(const f32x4 (&acc)[2][2][4][2], const Unit& u, int wr, int wc, int fr, int fq) const {
        const int row0 = u.pm * BM + wr * 64 + fr, col0 = u.pn * BM + wc * 32 + 8 * fq, b = u.pm >> 3;
        f32x4 gv[2][2];
#pragma unroll
        for (int bj = 0; bj < 2; ++bj)
#pragma unroll
            for (int n = 0; n < 2; ++n) gv[bj][n] = *(const f32x4*)(gatev + b * 3072 + col0 + bj * HALF + n * 4);
#pragma unroll
        for (int ai = 0; ai < 2; ++ai)
#pragma unroll
            for (int m = 0; m < 4; ++m) { const size_t off = (size_t)(row0 + ai * HALF + m * 16) * 1024 + col0;
#pragma unroll
                for (int bj = 0; bj < 2; ++bj) {
                    f32x4 x0, x1;
                    if (xin32) { x0 = *(const f32x4*)(xin32 + off + bj * HALF); x1 = *(const f32x4*)(xin32 + off + bj * HALF + 4); }
                    else { const u32x4 w = *(const u32x4*)(xs + off + bj * HALF);
                        x0 = (f32x4){__builtin_bit_cast(float, w.x << 16), __builtin_bit_cast(float, w.x & 0xffff0000u), __builtin_bit_cast(float, w.y << 16), __builtin_bit_cast(float, w.y & 0xffff0000u)};
                        x1 = (f32x4){__builtin_bit_cast(float, w.z << 16), __builtin_bit_cast(float, w.z & 0xffff0000u), __builtin_bit_cast(float, w.w << 16), __builtin_bit_cast(float, w.w & 0xffff0000u)}; }
                    *(u32x4*)(xs + off + bj * HALF) = pack8(x0 + gv[bj][0] * acc[ai][bj][m][0], x1 + gv[bj][1] * acc[ai][bj][m][1]); } }
    }
};

typedef int i32x8 __attribute__((ext_vector_type(8)));
template <class Epi, class Sched, bool ALIGN_EPI, bool FP8 = false>
__device__ __forceinline__ void gemm_phase(PG8_LAS unsigned char* lds, const int K, const Sched& S, const Epi& E) {
    constexpr bool GATHER = Sched::GATHER;
    const int tid = opaque_v((int)threadIdx.x), wid = __builtin_amdgcn_readfirstlane(tid >> 6), lane = tid & 63, wr = wid >> 2, wc = wid & 3, fr = lane & 15, fq = lane >> 4;
    const int nt = opaque_s(K / BK);
    unsigned voffB[2];
#pragma unroll
    for (int i = 0; i < 2; ++i) { int R, C; stage_rc(tid * 16 + i * 8192, R, C); const int Rb = Epi::PERM ? ((R & ~31) + perm32(R & 31)) : R; voffB[i] = (unsigned)(Rb * K + C) * 2u; }
    const size_t kstep = (size_t)(BK * 2);
    const size_t hstepB = (size_t)HALF * K * 2;
    const size_t hstepA = GATHER ? (size_t)0 : hstepB;
    const unsigned ldsw = (unsigned)wid * 1024u;
    const int aoff = lds_byte(wr * 64 + fr, fq * 8), boff = lds_byte(wc * 32 + fr, fq * 8);
#define PG8_SA(b, h) (((b) * 2 + (h)) * HTB)
#define PG8_SB(b, h) ((4 + (b) * 2 + (h)) * HTB)
#define PG8_STAGE(bufoff, gbase, voff) do { _Pragma("unroll") for (int _i = 0; _i < 2; ++_i) \
        __builtin_amdgcn_global_load_lds((const unsigned*)((const char*)(gbase) + (voff)[_i]), (PG8_LAS unsigned*)(lds + (bufoff) + ldsw + _i * 8192), 16, 0, 0); } while (0)
#define PG8_LDA(dst, b, h) do { _Pragma("unroll") for (int m = 0; m < 4; ++m) _Pragma("unroll") for (int k = 0; k < 2; ++k) dst[m][k] = *(const PG8_LAS bf16x8*)(lds + PG8_SA(b, h) + aoff + m * 2048 + k * 1024); } while (0)
#define PG8_LDB(dst, b, h) do { _Pragma("unroll") for (int n = 0; n < 2; ++n) _Pragma("unroll") for (int k = 0; k < 2; ++k) dst[n][k] = *(const PG8_LAS bf16x8*)(lds + PG8_SB(b, h) + boff + n * 2048 + k * 1024); } while (0)
#define PG8_MMA16(ai, bj, At, Bt) do { __builtin_amdgcn_s_setprio(1); _Pragma("unroll") for (int m = 0; m < 4; ++m) _Pragma("unroll") for (int n = 0; n < 2; ++n) _Pragma("unroll") for (int k = 0; k < 2; ++k) \
        acc[ai][bj][m][n] = __builtin_amdgcn_mfma_f32_16x16x32_bf16(Bt[n][k], At[m][k], acc[ai][bj][m][n], 0, 0, 0); __builtin_amdgcn_s_setprio(0); } while (0)
#define PG8_LDA8(dst, b, h) do { _Pragma("unroll") for (int m = 0; m < 4; ++m) { const u32x4 _lo = *(const PG8_LAS u32x4*)(lds + PG8_SA(b, h) + aoff + m * 2048), _hi = *(const PG8_LAS u32x4*)(lds + PG8_SA(b, h) + aoff + m * 2048 + 1024); \
        dst[m] = __builtin_bit_cast(i32x8, __builtin_shufflevector(_lo, _hi, 0, 1, 2, 3, 4, 5, 6, 7)); } } while (0)
#define PG8_LDB8(dst, b, h) do { _Pragma("unroll") for (int n = 0; n < 2; ++n) { const u32x4 _lo = *(const PG8_LAS u32x4*)(lds + PG8_SB(b, h) + boff + n * 2048), _hi = *(const PG8_LAS u32x4*)(lds + PG8_SB(b, h) + boff + n * 2048 + 1024); \
        dst[n] = __builtin_bit_cast(i32x8, __builtin_shufflevector(_lo, _hi, 0, 1, 2, 3, 4, 5, 6, 7)); } } while (0)
#define PG8_MMA8(ai, bj, At, Bt) do { __builtin_amdgcn_s_setprio(1); asm volatile("s_nop 4"); _Pragma("unroll") for (int m = 0; m < 4; ++m) _Pragma("unroll") for (int n = 0; n < 2; ++n) \
        asm volatile("v_mfma_scale_f32_16x16x128_f8f6f4 %0, %1, %2, %0, %3, %3 op_sel_hi:[0,0,0]" : "+v"(acc[ai][bj][m][n]) : "v"(Bt[n]), "v"(At[m]), "v"(scale1)); __builtin_amdgcn_s_setprio(0); } while (0)
#define PG8_XLDA(b, h) do { if constexpr (FP8) PG8_LDA8(At8, b, h); else PG8_LDA(At, b, h); } while (0)
#define PG8_XLDB(w, b, h) do { if constexpr (FP8) PG8_LDB8(B##w##8, b, h); else PG8_LDB(B##w, b, h); } while (0)
#define PG8_XMMA(ai, bj, w) do { if constexpr (FP8) PG8_MMA8(ai, bj, At8, B##w##8); else PG8_MMA16(ai, bj, At, B##w); } while (0)
#define PG8_WAIT_V(n) asm volatile("s_waitcnt vmcnt(" #n ")" ::: "memory")
#define PG8_WAIT_L(n) asm volatile("s_waitcnt lgkmcnt(" #n ")" ::: "memory")
#define PG8_BAR __builtin_amdgcn_s_barrier()
#define PG8_SCHED __builtin_amdgcn_sched_barrier(0)
    Unit cur, nxt; int ui = 0;
    if (!S.next(0, cur)) return;
    f32x4 acc[2][2][4][2];
#pragma unroll
    for (int a = 0; a < 2; ++a)
#pragma unroll
        for (int b = 0; b < 2; ++b)
#pragma unroll
            for (int m = 0; m < 4; ++m)
#pragma unroll
                for (int n = 0; n < 2; ++n) acc[a][b][m][n] = (f32x4){0.f, 0.f, 0.f, 0.f};
    bf16x8 At[4][2], B0[2][2], B1[2][2]; i32x8 At8[4], B08[2], B18[2]; int scale1 = 0x7F7F7F7F; asm volatile("" : "+v"(scale1));
    const char* cA = S.a_base(cur); const char* cB = S.b_base(cur);
    unsigned vc[2][2], vn[2][2];
    S.a_voff(cur, tid, vc);
    PG8_STAGE(PG8_SB(0, 0), cB, voffB); PG8_STAGE(PG8_SB(0, 1), cB + hstepB, voffB); PG8_STAGE(PG8_SA(0, 0), cA, vc[0]); PG8_STAGE(PG8_SA(0, 1), cA + hstepA, vc[1]);
    if (wr == 1) PG8_BAR;
    PG8_WAIT_V(2); PG8_BAR;
    PG8_STAGE(PG8_SB(1, 0), cB + kstep, voffB); PG8_STAGE(PG8_SA(1, 0), cA + kstep, vc[0]); PG8_STAGE(PG8_SB(1, 1), cB + hstepB + kstep, voffB);
    PG8_WAIT_V(6); PG8_BAR;
    for (;;) {
        const bool has_next = S.next(ui + 1, nxt);
        const char* nA = has_next ? S.a_base(nxt) : cA; const char* nB = has_next ? S.b_base(nxt) : cB;
        if (GATHER && has_next) { S.a_voff(nxt, tid, vn); *(PG8_LAS u32x4*)(lds + STAGE_BYTES + tid * 16) = (u32x4){vn[0][0], vn[0][1], vn[1][0], vn[1][1]}; }
#pragma unroll 1
        for (int t = 0; t < nt; t += 2) {
            const bool last = (t == nt - 2);
            const char* a1 = cA + (size_t)(t + 1) * kstep;
            const char* a2 = last ? nA : cA + (size_t)(t + 2) * kstep; const char* b2 = last ? nB : cB + (size_t)(t + 2) * kstep;
            const char* a3 = a2 + kstep; const char* b3 = b2 + kstep;
            unsigned v2[2][2];
#pragma unroll
            for (int h = 0; h < 2; ++h)
#pragma unroll
                for (int i = 0; i < 2; ++i) v2[h][i] = vc[h][i];
            if (GATHER && last && has_next) { const u32x4 pk = *(const PG8_LAS u32x4*)(lds + STAGE_BYTES + tid * 16); v2[0][0] = pk[0]; v2[0][1] = pk[1]; v2[1][0] = pk[2]; v2[1][1] = pk[3]; }
            PG8_XLDB(0, 0, 0); PG8_XLDB(1, 0, 1); PG8_SCHED; PG8_XLDA(0, 0); PG8_STAGE(PG8_SA(1, 1), a1 + hstepA, vc[1]);
            PG8_WAIT_V(8); PG8_WAIT_L(0); PG8_BAR; PG8_XMMA(0, 0, 0); PG8_XMMA(0, 1, 1); PG8_BAR; PG8_SCHED;
            if (!cur.half) PG8_XLDA(0, 1); PG8_STAGE(PG8_SB(0, 0), b2, voffB); PG8_STAGE(PG8_SB(0, 1), b2 + hstepB, voffB); PG8_STAGE(PG8_SA(0, 0), a2, v2[0]);
            PG8_WAIT_V(8); PG8_WAIT_L(0); PG8_BAR; if (!cur.half) { PG8_XMMA(1, 0, 0); PG8_XMMA(1, 1, 1); } PG8_BAR; PG8_SCHED;
            PG8_XLDB(0, 1, 0); PG8_XLDB(1, 1, 1); PG8_SCHED; PG8_XLDA(1, 0); PG8_STAGE(PG8_SA(0, 1), a2 + hstepA, v2[1]);
            PG8_WAIT_V(8); PG8_WAIT_L(0); PG8_BAR; PG8_XMMA(0, 0, 0); PG8_XMMA(0, 1, 1); PG8_BAR; PG8_SCHED;
            if (!cur.half) PG8_XLDA(1, 1); PG8_STAGE(PG8_SB(1, 0), b3, voffB); PG8_STAGE(PG8_SB(1, 1), b3 + hstepB, voffB); PG8_STAGE(PG8_SA(1, 0), a3, v2[0]);
            PG8_WAIT_V(8); PG8_WAIT_L(0); PG8_BAR; if (!cur.half) { PG8_XMMA(1, 0, 0); PG8_XMMA(1, 1, 1); } PG8_BAR; PG8_SCHED;
        }
        if constexpr (ALIGN_EPI) { if (wr == 0) PG8_BAR; }
        if constexpr (FP8) asm volatile("s_nop 15\n\ts_nop 15" ::: "memory");
        E(acc, cur, wr, wc, fr, fq);
        if (!has_next) break;
#pragma unroll
        for (int a = 0; a < 2; ++a)
#pragma unroll
            for (int b = 0; b < 2; ++b)
#pragma unroll
                for (int m = 0; m < 4; ++m)
#pragma unroll
                    for (int n = 0; n < 2; ++n) acc[a][b][m][n] = (f32x4){0.f, 0.f, 0.f, 0.f};
        cur = nxt; cA = nA; cB = nB; ++ui;
        if (GATHER) { const u32x4 pk = *(const PG8_LAS u32x4*)(lds + STAGE_BYTES + tid * 16); vc[0][0] = pk[0]; vc[0][1] = pk[1]; vc[1][0] = pk[2]; vc[1][1] = pk[3]; }
        if constexpr (ALIGN_EPI) { if (wr == 1) PG8_BAR; }
    }
    PG8_WAIT_V(0);
    if constexpr (!ALIGN_EPI) { if (wr == 0) PG8_BAR; }
    PG8_BAR;
#undef PG8_SA
#undef PG8_SB
#undef PG8_STAGE
#undef PG8_LDA
#undef PG8_LDB
#undef PG8_MMA16
#undef PG8_LDA8
#undef PG8_LDB8
#undef PG8_MMA8
#undef PG8_XLDA
#undef PG8_XLDB
#undef PG8_XMMA
#undef PG8_WAIT_V
#undef PG8_WAIT_L
#undef PG8_BAR
#undef PG8_SCHED
}
}

constexpr int NWAVES = 8, NTHR = 512;
constexpr int D = 1024, BATCH = 8, SEQ = 2048, NTOK = BATCH * SEQ, DEPTH = 4;
constexpr int M_HEADS = 4, M_DK = 128, M_DV = 256, M_PROJ = 3080, NPROJ = 3072;
constexpr int N_EXP = 32, D_FF = 512;
constexpr float EPS = 1e-6f;
constexpr int PMAX = 40960;

constexpr size_t MiB = 1u << 20;
constexpr size_t WS_CTL = 0, CTL_ZERO_BYTES = 1 * MiB;
constexpr size_t WS_MOD = 1 * MiB;
constexpr size_t WS_GATES = 2 * MiB;
constexpr size_t WS_TOKPOS = 3 * MiB;
constexpr size_t WS_TOKW = 3 * MiB + 256 * 1024;
constexpr size_t WS_SLOTTOK = 4 * MiB;
constexpr size_t WS_WMIN = 8 * MiB;
constexpr size_t WS_WMOUT = 20 * MiB;
constexpr size_t WS_WSIN = 24 * MiB;
constexpr size_t WS_WSOUT = 36 * MiB;
constexpr size_t WS_WGU = 40 * MiB;
constexpr size_t WS_WDN = 296 * MiB;
constexpr size_t WS_H = 424 * MiB;
constexpr size_t WS_PROJ = 456 * MiB;
constexpr size_t WS_HS = 552 * MiB;
constexpr size_t WS_A2 = 616 * MiB;
constexpr size_t WS_HMID = 648 * MiB;
constexpr size_t WS_YR = 688 * MiB;
constexpr size_t WS_X = 768 * MiB;
constexpr size_t WS_END = 800 * MiB;
constexpr int CW_BAR = 4096;
constexpr int CW_CNT = 16384;

constexpr int LDS_BYTES = 163840;
constexpr int LDSCTL_OFF = 163840 - 1024;
constexpr int LC_TOFF = 16, LC_CNT = 64, LC_LCNT = 96, LC_LBASE = 128, LC_SOFF = 160, LC_SEXP = 200;

#define GAS __attribute__((address_space(1)))
#define LAS __attribute__((address_space(3)))
typedef unsigned short bf16;
typedef unsigned v4u __attribute__((ext_vector_type(4)));
typedef unsigned v2u __attribute__((ext_vector_type(2)));
typedef float f32x4 __attribute__((ext_vector_type(4)));
#define LDS_WAIT() asm volatile("s_waitcnt lgkmcnt(0)" ::: "memory")
__device__ __forceinline__ unsigned f2bf(float f) { unsigned u = __builtin_bit_cast(unsigned, f); return (u + 0x7fffu + ((u >> 16) & 1u)) >> 16; }
__device__ __forceinline__ unsigned pk2(float lo, float hi) { return f2bf(lo) | (f2bf(hi) << 16); }
__device__ __forceinline__ float bflo(unsigned w) { return __builtin_bit_cast(float, w << 16); }
__device__ __forceinline__ float bfhi(unsigned w) { return __builtin_bit_cast(float, w & 0xffff0000u); }
__device__ __forceinline__ float wave_sum(float v) {
#pragma unroll
    for (int o = 1; o < 64; o <<= 1) v += __shfl_xor(v, o);
    return v;
}

#define XB_TMO      128
#define XB_XCNT(j)  (256  + 64 * (j))
#define XB_XSUB(j)  (1280 + 64 * (j))
#define XB_XGEN(j)  (2304 + 64 * (j))
#define XB_TOP      3328
#define XB_TOPGEN   3392
#define XCD_BAR_WORDS 3456
#define XB_SPIN_CAP (1u << 18)
__device__ __forceinline__ unsigned xb_ld(unsigned* p)              { return __hip_atomic_load(p, __ATOMIC_RELAXED, __HIP_MEMORY_SCOPE_AGENT); }
__device__ __forceinline__ unsigned xb_add(unsigned* p, unsigned v) { return __hip_atomic_fetch_add(p, v, __ATOMIC_RELAXED, __HIP_MEMORY_SCOPE_AGENT); }
__device__ __forceinline__ unsigned xb_xcc_id() { return (unsigned)__builtin_amdgcn_s_getreg((3 << 11) | 20) & 0xFu; }
#define XB_SPIN(cond, bar) do { unsigned _sp = 0; while (cond) { __builtin_amdgcn_s_sleep(1); \
    if ((++_sp & 255u) == 0u) { if (xb_ld(&(bar)[XB_TMO])) break; if (_sp > XB_SPIN_CAP) { atomicAdd(&(bar)[XB_TMO], 1u); break; } } } } while (0)
struct XcdBarrier { unsigned* bar; unsigned x; volatile LAS unsigned* st; };
__device__ __forceinline__ XcdBarrier xcd_barrier_post(unsigned* bar, volatile LAS unsigned* st) {
    XcdBarrier b; b.bar = bar; b.x = xb_xcc_id(); b.st = st;
    if (threadIdx.x == 0) (void)xb_add(&bar[XB_XCNT(b.x)], 1u);
    return b;
}
__device__ __forceinline__ void xcd_barrier_complete(unsigned* bar, unsigned x, unsigned& nloc, unsigned& nx) {
    const unsigned G = gridDim.x * gridDim.y * gridDim.z;
    unsigned sum, cnt, mine, sp = 0u;
    for (;;) {
        sum = 0u; cnt = 0u; mine = 0u;
#pragma unroll
        for (unsigned j = 0; j < 16; ++j) { const unsigned c = xb_ld(&bar[XB_XCNT(j)]); sum += c; cnt += (c > 0u) ? 1u : 0u; mine = (j == x) ? c : mine; }
        if (sum == G) break;
        __builtin_amdgcn_s_sleep(1);
        if ((++sp & 255u) == 0u) { if (xb_ld(&bar[XB_TMO])) break; if (sp > XB_SPIN_CAP) { atomicAdd(&bar[XB_TMO], 1u); break; } }
    }
    nloc = mine > 0u ? mine : 1u; nx = cnt > 0u ? cnt : 1u;
}
__device__ __forceinline__ void xcd_barrier(const XcdBarrier& b) {
    asm volatile("s_waitcnt vmcnt(0)" ::: "memory");
    __syncthreads();
    if (threadIdx.x == 0) {
        unsigned* bar = b.bar;
        __builtin_amdgcn_s_waitcnt(0);
        unsigned nloc = b.st[0], nx = b.st[1];
        if (nloc == 0u) { xcd_barrier_complete(bar, b.x, nloc, nx); b.st[0] = nloc; b.st[1] = nx; }
        const unsigned old = xb_add(&bar[XB_XSUB(b.x)], 1u);
        const unsigned gen = old / nloc;
        if (old + 1u == (gen + 1u) * nloc) {
            __builtin_amdgcn_fence(__ATOMIC_RELEASE, "agent");
            asm volatile("s_waitcnt vmcnt(0)" ::: "memory");
            const unsigned og = xb_add(&bar[XB_TOP], 1u);
            const unsigned tg = og / nx;
            if (og + 1u == (tg + 1u) * nx) xb_add(&bar[XB_TOPGEN], 1u);
            else XB_SPIN(xb_ld(&bar[XB_TOPGEN]) == tg, bar);
            __builtin_amdgcn_fence(__ATOMIC_ACQUIRE, "agent");
            xb_add(&bar[XB_XGEN(b.x)], 1u);
            asm volatile("s_waitcnt vmcnt(0)" ::: "memory");
        } else {
            XB_SPIN(xb_ld(&bar[XB_XGEN(b.x)]) == gen, bar);
            __builtin_amdgcn_fence(__ATOMIC_ACQUIRE, "agent");
            asm volatile("s_waitcnt vmcnt(0)" ::: "memory");
        }
    }
    __syncthreads();
}

struct Args { const float* in[20]; float* out; unsigned char* ws; int ph_lo, ph_hi; };
enum InIdx { I_X = 0, I_C, I_ADAW, I_ADAB, I_NORMG, I_FINALG, I_MWIN, I_MBG, I_MNORMG, I_MWOUT, I_SWIN, I_SCONVW, I_SWOUT, I_RWG, I_RBG, I_RWE, I_RBE, I_EWG, I_EWU, I_EWD };

struct Frame {
    LAS unsigned char* lds;
    volatile LAS unsigned* LC;
    unsigned* ctl;
    int tid, lane, wave, G;
    float* out; unsigned char* ws;
};
typedef const __attribute__((address_space(4))) Args* KArgs;
__device__ __forceinline__ KArgs kargs() { auto p = __builtin_amdgcn_kernarg_segment_ptr(); asm volatile("" : "+s"(p)); return (KArgs)p; }
template <class T> __device__ __forceinline__ T* as_global(T* p) { __attribute__((address_space(1))) T* q = (__attribute__((address_space(1))) T*)p; asm volatile("" : "+s"(q)); return (T*)q; }
#define KIN(i) (as_global((const float*)kargs()->in[i]))
template <class T> __device__ __forceinline__ T* launder(T* p) { return as_global(p); }

__device__ __forceinline__ Frame fresh(const Frame& F) { Frame P = F; P.tid = pg8::opaque_v(F.tid); P.lane = P.tid & 63; P.wave = __builtin_amdgcn_readfirstlane(P.tid >> 6); P.G = pg8::opaque_s(F.G); return P; }
__device__ __forceinline__ void p_adaln(Frame& F) {
    LAS float* sc = (LAS float*)F.lds;
    LAS float* red = (LAS float*)(F.lds + 32768);
    const float* c = KIN(I_C); const float* adaw = KIN(I_ADAW); const float* adab = KIN(I_ADAB);
    float* mod = (float*)(F.ws + WS_MOD);
    for (int i = F.tid; i < 8192; i += NTHR) { const float v = c[i]; sc[i] = v / (1.0f + __expf(-v)); }
    __syncthreads();
    const int kq = F.lane >> 4, c4 = (F.lane & 15) * 4;
    for (int item = blockIdx.x; item < 8 * 48; item += F.G) {
        const int ls = item / 48, cg = item % 48;
        const float* W = adaw + (size_t)ls * 1024 * 3072 + cg * 64 + c4;
        float acc[8][4];
#pragma unroll
        for (int b = 0; b < 8; ++b) { acc[b][0] = 0.f; acc[b][1] = 0.f; acc[b][2] = 0.f; acc[b][3] = 0.f; }
#pragma unroll 8
        for (int i = 0; i < 32; ++i) {
            const int k = F.wave * 128 + i * 4 + kq;
            const f32x4 w = *(const f32x4*)(W + (size_t)k * 3072);
#pragma unroll
            for (int b = 0; b < 8; ++b) { const float s = sc[b * 1024 + k]; acc[b][0] += s * w[0]; acc[b][1] += s * w[1]; acc[b][2] += s * w[2]; acc[b][3] += s * w[3]; }
        }
#pragma unroll
        for (int b = 0; b < 8; ++b)
#pragma unroll
            for (int j = 0; j < 4; ++j) { float v = acc[b][j]; v += __shfl_xor(v, 16); v += __shfl_xor(v, 32); acc[b][j] = v; }
        if (kq == 0) {
#pragma unroll
            for (int b = 0; b < 8; ++b) *(LAS f32x4*)(red + (F.wave * 8 + b) * 64 + c4) = (f32x4){acc[b][0], acc[b][1], acc[b][2], acc[b][3]};
        }
        __syncthreads();
        { const int b = F.tid >> 6, col = F.tid & 63; float s = 0.f;
#pragma unroll
          for (int w = 0; w < 8; ++w) s += red[(w * 8 + b) * 64 + col];
          mod[((size_t)ls * 8 + b) * 3072 + cg * 64 + col] = s + adab[ls * 3072 + cg * 64 + col]; }
        __syncthreads();
    }
}

__device__ __forceinline__ void tr_item(const float* W, int ldw, bf16* WT, int ldt, LAS float* scr, int lane) {
#pragma unroll 8
    for (int i = 0; i < 32; ++i) { const int kk = 2 * i + (lane >> 5); scr[kk * 33 + (lane & 31)] = W[(size_t)kk * ldw + (lane & 31)]; }
    LDS_WAIT(); asm volatile("" ::: "memory");
    const int c = lane & 7;
#pragma unroll
    for (int j = 0; j < 4; ++j) { const int n = (lane >> 3) + 8 * j; const LAS float* s = scr + (8 * c) * 33 + n;
        v4u o; o.x = pk2(s[0 * 33], s[1 * 33]); o.y = pk2(s[2 * 33], s[3 * 33]); o.z = pk2(s[4 * 33], s[5 * 33]); o.w = pk2(s[6 * 33], s[7 * 33]);
        *(v4u*)(WT + (size_t)n * ldt + 8 * c) = o; }
    LDS_WAIT(); asm volatile("" ::: "memory");
}
__device__ __forceinline__ void tr_item8(const float* W, int ldw, unsigned char* WT, int ldt, LAS float* scr, int lane) {
#pragma unroll 8
    for (int i = 0; i < 64; ++i) { const int kk = 2 * i + (lane >> 5); scr[kk * 33 + (lane & 31)] = W[(size_t)kk * ldw + (lane & 31)] * 32.0f; }
    LDS_WAIT(); asm volatile("" ::: "memory");
    const int n = lane >> 1, kh = (lane & 1) * 64; const LAS float* sp = scr + kh * 33 + n;
    unsigned char* dst = WT + (size_t)n * ldt + kh;
#pragma unroll
    for (int q = 0; q < 4; ++q) { v4u o;
        o.x = pg8::pk4_fp8(sp[(16 * q + 0) * 33], sp[(16 * q + 1) * 33], sp[(16 * q + 2) * 33], sp[(16 * q + 3) * 33]); o.y = pg8::pk4_fp8(sp[(16 * q + 4) * 33], sp[(16 * q + 5) * 33], sp[(16 * q + 6) * 33], sp[(16 * q + 7) * 33]);
        o.z = pg8::pk4_fp8(sp[(16 * q + 8) * 33], sp[(16 * q + 9) * 33], sp[(16 * q + 10) * 33], sp[(16 * q + 11) * 33]); o.w = pg8::pk4_fp8(sp[(16 * q + 12) * 33], sp[(16 * q + 13) * 33], sp[(16 * q + 14) * 33], sp[(16 * q + 15) * 33]);
        *(v4u*)(dst + 16 * q) = o; }
    LDS_WAIT(); asm volatile("" ::: "memory");
}
__device__ __forceinline__ void p_convert(Frame& F) {
    LAS float* scr = (LAS float*)(F.lds + F.wave * 17408);
    const float* in_mwin = KIN(I_MWIN); const float* in_mwout = KIN(I_MWOUT); const float* in_swin = KIN(I_SWIN); const float* in_swout = KIN(I_SWOUT);
    const float* in_ewg = KIN(I_EWG); const float* in_ewu = KIN(I_EWU); const float* in_ewd = KIN(I_EWD);
    const int gw = blockIdx.x * NWAVES + F.wave, NGW = F.G * NWAVES;
    constexpr int I_A = 2 * 16 * 96, I_B = 2 * 16 * 32, I_C2 = I_A, I_D = I_B, I_E = 128 * 8 * 16, I_F = I_E, I_G = 128 * 4 * 32;
    constexpr int NITEMS = I_A + I_B + I_C2 + I_D + I_E + I_F + I_G;
    for (int it = gw; it < NITEMS; it += NGW) {
        int r = it;
        if (r < I_A) { const int j = r / 1536, q = r % 1536, kb = q / 96, nb = q % 96;
            tr_item(in_mwin + (size_t)j * 1024 * M_PROJ + (size_t)kb * 64 * M_PROJ + nb * 32, M_PROJ, (bf16*)(F.ws + WS_WMIN) + (size_t)j * 3072 * 1024 + (size_t)nb * 32 * 1024 + kb * 64, 1024, scr, F.lane); continue; } r -= I_A;
        if (r < I_B) { const int j = r / 512, q = r % 512, kb = q / 32, nb = q % 32;
            tr_item(in_mwout + (size_t)j * 1024 * 1024 + (size_t)kb * 64 * 1024 + nb * 32, 1024, (bf16*)(F.ws + WS_WMOUT) + (size_t)j * 1024 * 1024 + (size_t)nb * 32 * 1024 + kb * 64, 1024, scr, F.lane); continue; } r -= I_B;
        if (r < I_C2) { const int j = r / 1536, q = r % 1536, kb = q / 96, nb = q % 96, n0 = nb * 32;
            int drow; if (n0 < 1024) drow = 2048 + n0; else if (n0 < 2048) { const int cc = n0 - 1024; drow = 256 * (cc >> 7) + (cc & 127); } else { const int cc = n0 - 2048; drow = 256 * (cc >> 7) + 128 + (cc & 127); }
            tr_item(in_swin + (size_t)j * 1024 * 3072 + (size_t)kb * 64 * 3072 + n0, 3072, (bf16*)(F.ws + WS_WSIN) + (size_t)j * 3072 * 1024 + (size_t)drow * 1024 + kb * 64, 1024, scr, F.lane); continue; } r -= I_C2;
        if (r < I_D) { const int j = r / 512, q = r % 512, kb = q / 32, nb = q % 32;
            tr_item(in_swout + (size_t)j * 1024 * 1024 + (size_t)kb * 64 * 1024 + nb * 32, 1024, (bf16*)(F.ws + WS_WSOUT) + (size_t)j * 1024 * 1024 + (size_t)nb * 32 * 1024 + kb * 64, 1024, scr, F.lane); continue; } r -= I_D;
        if (r < I_E + I_F) { const bool up = r >= I_E; if (up) r -= I_E; const int mat = r / 128, q = r % 128, kb = q / 16, nb = q % 16, n0 = nb * 32;
            const int drow = 256 * (n0 >> 7) + (up ? 128 : 0) + (n0 & 127);
            tr_item8((up ? in_ewu : in_ewg) + (size_t)mat * 1024 * 512 + (size_t)kb * 128 * 512 + n0, 512, (unsigned char*)(F.ws + WS_WGU) + (size_t)mat * 1024 * 1024 + (size_t)drow * 1024 + kb * 128, 1024, scr, F.lane); continue; } r -= I_E + I_F;
        { const int mat = r / 128, q = r % 128, kb = q / 32, nb = q % 32;
            tr_item8(in_ewd + (size_t)mat * 512 * 1024 + (size_t)kb * 128 * 1024 + nb * 32, 1024, (unsigned char*)(F.ws + WS_WDN) + (size_t)mat * 1024 * 512 + (size_t)nb * 32 * 512 + kb * 128, 512, scr, F.lane); }
    }
}

__device__ __forceinline__ void moe_tables(Frame& F, int layer) {
    if (F.tid < 64) {
        const int e = F.tid & 31;
        const int c = (int)__hip_atomic_load(F.ctl + CW_CNT + (layer * 32 + e) * 16, __ATOMIC_RELAXED, __HIP_MEMORY_SCOPE_AGENT);
        const int tl = (c + 255) >> 8, rem = c - (tl - 1) * 256;
        const int sm = (tl > 0 && rem <= 128) ? 1 : 0, nb = tl - sm;
        int incb = (F.tid < 32) ? nb : 0, incs = (F.tid < 32) ? sm : 0;
#pragma unroll
        for (int o = 1; o < 32; o <<= 1) { const int vb = __shfl_up(incb, o), vs = __shfl_up(incs, o); if ((F.tid & 63) >= o) { incb += vb; incs += vs; } }
        if (F.tid < 32) { F.LC[LC_TOFF + e] = (unsigned)(incb - nb); F.LC[LC_SOFF + e] = (unsigned)(incs - sm); F.LC[LC_CNT + e] = (unsigned)c;
            if (sm) F.LC[LC_SEXP + (incs - sm)] = (unsigned)e;
            if (e == 31) { F.LC[LC_TOFF + 32] = (unsigned)incb; F.LC[LC_SOFF + 32] = (unsigned)incs; } }
    }
    __syncthreads();
}
__device__ __forceinline__ int moe_slot(Frame& F, int p) {
    const int e = p & 31, pos = p >> 5, k = pos >> 8, b0 = (int)F.LC[LC_TOFF + e], nb = (int)F.LC[LC_TOFF + e + 1] - b0;
    const int tile = (k < nb) ? b0 + k : (int)F.LC[LC_TOFF + 32] + (int)F.LC[LC_SOFF + e];
    return tile * 256 + (pos & 255);
}
template <int NC> __device__ __forceinline__ void wtab_put(LAS unsigned char* base, int k, int n, float v) {
    const unsigned hi = f2bf(v); const unsigned lo = f2bf(v - __builtin_bit_cast(float, hi << 16));
    const int off = ((k >> 3) * NC + n) * 16 + (k & 7) * 2;
    *(LAS unsigned short*)(base + off) = (unsigned short)hi; *(LAS unsigned short*)(base + NC * 2048 + off) = (unsigned short)lo;
}
typedef short rbf16x8 __attribute__((ext_vector_type(8)));
template <bool COMBINE, int AUX, bool FINAL, bool XF32 = false>
__device__ __forceinline__ void row_phase(Frame& F, const void* xsrc_, void* xdst_, const float* modn, const float* ng, const float* modprev, int prev_layer,
                                          const float* auxw0, const float* auxw1, const float* auxb0, const float* auxb1, int layer) {
    constexpr int NC = (AUX == 2) ? 36 : 8, NT = (NC + 15) / 16;
    constexpr int OFF_RINV = 147456, OFF_LOGIT = OFF_RINV + 256, OFF_ROWE = OFF_LOGIT + 64 * 36 * 4, OFF_ROWW = OFF_ROWE + 512, OFF_CB = OFF_ROWW + 512, OFF_R2 = OFF_CB + 256;
    static_assert(OFF_R2 + 14 * 36 * 4 <= LDSCTL_OFF && 64 * 8 * 4 <= 14 * 36 * 4 + 64, "row phase LDS map");
    const int lane = F.lane;
    const float* xsrc32 = (const float*)xsrc_; const bf16* xsrc16 = (const bf16*)xsrc_;
    float* xdst32 = (float*)xdst_; bf16* xdst16 = (bf16*)xdst_;
    if (COMBINE) moe_tables(F, prev_layer);
    const int* tokpos = (const int*)(F.ws + WS_TOKPOS); const float* tokw = (const float*)(F.ws + WS_TOKW);
    const unsigned char* YR = (const unsigned char*)(F.ws + WS_YR);
    bf16* H = (bf16*)(F.ws + WS_H);
    LAS float* rinvL = (LAS float*)(F.lds + OFF_RINV);
    LAS float* logit = (LAS float*)(F.lds + OFF_LOGIT);
    LAS int* rowE = (LAS int*)(F.lds + OFF_ROWE);
    LAS float* rowW = (LAS float*)(F.lds + OFF_ROWW);
    LAS float* cbL = (LAS float*)(F.lds + OFF_CB);
    LAS float* r2 = (LAS float*)(F.lds + OFF_R2);
    int tab_b = -1;
#ifdef SCAN_SELFCHECK
    const float FLAGSCALE = (FINAL && __hip_atomic_load(F.ctl + 64, __ATOMIC_RELAXED, __HIP_MEMORY_SCOPE_AGENT) != 0u) ? 2.0f : 1.0f;
#else
    const float FLAGSCALE = 1.0f;
#endif
#if defined(TPSUB)
    unsigned long long ts0 = __builtin_amdgcn_s_memrealtime(), ts1 = ts0;
#define TS_MARK(k) do { if (AUX == 2) { asm volatile("s_waitcnt vmcnt(0)" ::: "memory"); __syncthreads(); ts1 = __builtin_amdgcn_s_memrealtime(); if (TPSUB == (k) && F.tid == 0) atomicMax(F.ctl + 80, (unsigned)(ts1 - ts0)); ts0 = ts1; } } while (0)
#else
#define TS_MARK(k)
#endif
    for (int rg = blockIdx.x; rg < NTOK / 64; rg += F.G) {
        const int b = rg >> 5;
        if (AUX != 0 && b != tab_b) {
            tab_b = b;
            const float* shp = modn + b * 3072; const float* scp = shp + 1024;
            LAS float* gsL = logit; LAS float* shL = logit + 1024;
            for (int k = F.tid; k < 1024; k += NTHR) { gsL[k] = ng[k] * (1.0f + scp[k]); shL[k] = shp[k]; }
            __syncthreads();
            constexpr int NQ = (AUX == 2) ? 14 : 4, NI = (AUX == 2) ? 10 : 1;
            if (AUX == 1) {
                float cs4[4] = {0.f, 0.f, 0.f, 0.f};
                if (F.tid < 256) { const int kc = F.tid >> 1, c4 = F.tid & 1; f32x4 wq[8];
#pragma unroll
                    for (int jj = 0; jj < 8; ++jj) wq[jj] = *(const f32x4*)(auxw0 + (size_t)(8 * kc + jj) * M_PROJ + NPROJ + 4 * c4);
#pragma unroll
                    for (int e = 0; e < 4; ++e) { float pv[8];
#pragma unroll
                        for (int jj = 0; jj < 8; ++jj) { const int k = 8 * kc + jj; cs4[e] += shL[k] * wq[jj][e]; pv[jj] = wq[jj][e] * gsL[k]; }
                        v4u hi, lo; unsigned* hp = (unsigned*)&hi; unsigned* lp = (unsigned*)&lo;
#pragma unroll
                        for (int q = 0; q < 4; ++q) { const unsigned w2 = pg8::cvt_pk_bf16(pv[2 * q], pv[2 * q + 1]); hp[q] = w2;
                            lp[q] = pg8::cvt_pk_bf16(pv[2 * q] - __builtin_bit_cast(float, w2 << 16), pv[2 * q + 1] - __builtin_bit_cast(float, w2 & 0xffff0000u)); }
                        *(LAS v4u*)(F.lds + (kc * NC + 4 * c4 + e) * 16) = hi; *(LAS v4u*)(F.lds + NC * 2048 + (kc * NC + 4 * c4 + e) * 16) = lo; } }
#pragma unroll
                for (int e = 0; e < 4; ++e) { float t = cs4[e]; t += __shfl_xor(t, 2); t += __shfl_xor(t, 4); t += __shfl_xor(t, 8); t += __shfl_xor(t, 16); t += __shfl_xor(t, 32); cs4[e] = t; }
                if (F.tid < 256 && lane < 2) {
#pragma unroll
                    for (int e = 0; e < 4; ++e) r2[F.wave * NC + 4 * lane + e] = cs4[e]; }
            } else {
            if (F.tid < NQ * NC) {
                const int n = F.tid % NC, kcq = F.tid / NC; float cs = 0.f;
                const float* wcol = (AUX == 1) ? auxw0 + NPROJ + n : ((n < 4) ? auxw0 + n : auxw1 + (n - 4));
                const int wstr = (AUX == 1) ? M_PROJ : ((n < 4) ? 4 : 32);
                constexpr int NB = (NI + 4) / 5;
#pragma unroll 1
                for (int bt = 0; bt < NB; ++bt) {
                    float wv[5][8];
#pragma unroll
                    for (int i = 0; i < 5; ++i) { const int kcr = kcq + NQ * (5 * bt + i); const int kc = kcr < 128 ? kcr : 127; const float* wp = wcol + (size_t)(8 * kc) * wstr;
#pragma unroll
                        for (int jj = 0; jj < 8; ++jj) wv[i][jj] = wp[jj * wstr]; }
#pragma unroll
                    for (int i = 0; i < 5; ++i) { const int kcr = kcq + NQ * (5 * bt + i); const bool valid = kcr < 128 && (5 * bt + i) < NI; const int kc = kcr < 128 ? kcr : 127;
                        float pv[8];
#pragma unroll
                        for (int jj = 0; jj < 8; ++jj) { const int k = 8 * kc + jj; cs += valid ? shL[k] * wv[i][jj] : 0.f; pv[jj] = wv[i][jj] * gsL[k]; }
                        v4u hi, lo; unsigned* hp = (unsigned*)&hi; unsigned* lp = (unsigned*)&lo;
#pragma unroll
                        for (int e = 0; e < 4; ++e) { const unsigned w2 = pg8::cvt_pk_bf16(pv[2 * e], pv[2 * e + 1]); hp[e] = w2;
                            lp[e] = pg8::cvt_pk_bf16(pv[2 * e] - __builtin_bit_cast(float, w2 << 16), pv[2 * e + 1] - __builtin_bit_cast(float, w2 & 0xffff0000u)); }
                        *(LAS v4u*)(F.lds + (kc * NC + n) * 16) = hi; *(LAS v4u*)(F.lds + NC * 2048 + (kc * NC + n) * 16) = lo;
                    }
                }
                r2[kcq * NC + n] = cs;
            }
            }
            __syncthreads();
            if (F.tid < NC) { float sacc = 0.f; for (int q = 0; q < NQ; ++q) sacc += r2[q * NC + F.tid]; cbL[F.tid] = sacc; }
            __syncthreads();
        }
        TS_MARK(1);
        if (AUX == 2 && F.tid < 32) F.LC[LC_LCNT + F.tid] = 0u;
        {
            constexpr int RB = COMBINE ? 2 : 4;
            f32x4 gsv[4], shv[4], gtv[4];
#pragma unroll
            for (int j = 0; j < 4; ++j) {
                const f32x4 g = *((const f32x4*)ng + lane + 64 * j);
                if (FINAL) { gsv[j] = g; shv[j] = (f32x4){0.f, 0.f, 0.f, 0.f}; }
                else { const f32x4 scl = *((const f32x4*)(modn + b * 3072 + 1024) + lane + 64 * j); gsv[j] = g * (1.0f + scl); shv[j] = *((const f32x4*)(modn + b * 3072) + lane + 64 * j); }
                if (COMBINE) gtv[j] = *((const f32x4*)(modprev + b * 3072 + 2048) + lane + 64 * j);
            }
            for (int i0 = 0; i0 < 8; i0 += RB) {
                const int rowb = rg * 64 + F.wave * 8 + i0;
                f32x4 v[RB][4]; unsigned y0[RB][4], y1[RB][4]; float w0[RB], w1[RB];
#pragma unroll
                for (int r = 0; r < RB; ++r) {
#pragma unroll
                    for (int j = 0; j < 4; ++j) {
                        if (XF32) v[r][j] = *((const f32x4*)(xsrc32 + (size_t)(rowb + r) * D) + lane + 64 * j);
                        else { const v2u w = *((const v2u*)(xsrc16 + (size_t)(rowb + r) * D) + lane + 64 * j); v[r][j] = (f32x4){bflo(w.x), bfhi(w.x), bflo(w.y), bfhi(w.y)}; } }
                    if (COMBINE) {
                        const int p0 = __builtin_amdgcn_readfirstlane(tokpos[(rowb + r) * 2]), p1 = __builtin_amdgcn_readfirstlane(tokpos[(rowb + r) * 2 + 1]);
                        w0[r] = tokw[(rowb + r) * 2] * pg8::W8_INV; w1[r] = tokw[(rowb + r) * 2 + 1] * pg8::W8_INV;
                        const int s0 = moe_slot(F, p0), s1 = moe_slot(F, p1);
#pragma unroll
                        for (int j = 0; j < 4; ++j) { y0[r][j] = *((const unsigned*)(YR + (size_t)s0 * D) + lane + 64 * j); y1[r][j] = *((const unsigned*)(YR + (size_t)s1 * D) + lane + 64 * j); }
                    }
                }
#pragma unroll
                for (int r = 0; r < RB; ++r) {
                    const int row = rowb + r;
                    if (COMBINE) {
#pragma unroll
                        for (int j = 0; j < 4; ++j) {
                            v[r][j][0] += gtv[j][0] * (w0[r] * __builtin_amdgcn_cvt_f32_fp8(y0[r][j], 0) + w1[r] * __builtin_amdgcn_cvt_f32_fp8(y1[r][j], 0)); v[r][j][1] += gtv[j][1] * (w0[r] * __builtin_amdgcn_cvt_f32_fp8(y0[r][j], 1) + w1[r] * __builtin_amdgcn_cvt_f32_fp8(y1[r][j], 1));
                            v[r][j][2] += gtv[j][2] * (w0[r] * __builtin_amdgcn_cvt_f32_fp8(y0[r][j], 2) + w1[r] * __builtin_amdgcn_cvt_f32_fp8(y1[r][j], 2)); v[r][j][3] += gtv[j][3] * (w0[r] * __builtin_amdgcn_cvt_f32_fp8(y0[r][j], 3) + w1[r] * __builtin_amdgcn_cvt_f32_fp8(y1[r][j], 3));
                        }
                        if (!FINAL) {
#pragma unroll
                            for (int j = 0; j < 4; ++j) { v2u o; o.x = pk2(v[r][j][0], v[r][j][1]); o.y = pk2(v[r][j][2], v[r][j][3]); *((v2u*)(xdst16 + (size_t)row * D) + lane + 64 * j) = o;
                                v[r][j] = (f32x4){bflo(o.x), bfhi(o.x), bflo(o.y), bfhi(o.y)}; }
                        }
                    }
                    float ss = 0.f;
#pragma unroll
                    for (int j = 0; j < 4; ++j) ss += (v[r][j][0] * v[r][j][0] + v[r][j][1] * v[r][j][1]) + (v[r][j][2] * v[r][j][2] + v[r][j][3] * v[r][j][3]);
                    const float rinv = 1.0f / sqrtf(wave_sum(ss) * (1.0f / D) + EPS);
                    if (FINAL) {
#pragma unroll
                        for (int j = 0; j < 4; ++j) *((f32x4*)(xdst32 + (size_t)row * D) + lane + 64 * j) = v[r][j] * (rinv * FLAGSCALE) * gsv[j];
                    } else {
                        if (AUX != 0 && lane == 0) rinvL[F.wave * 8 + i0 + r] = rinv;
#pragma unroll
                        for (int j = 0; j < 4; ++j) { const f32x4 h = (v[r][j] * rinv) * gsv[j] + shv[j];
                            if (AUX == 2) *((unsigned*)((unsigned char*)H + (size_t)row * D) + lane + 64 * j) = pg8::pk4_fp8(h[0], h[1], h[2], h[3]);
                            else { v2u o; o.x = pk2(h[0], h[1]); o.y = pk2(h[2], h[3]); *((v2u*)(H + (size_t)row * D) + lane + 64 * j) = o; } }
                    }
                }
            }
        }
        TS_MARK(2);
        if (AUX != 0) {
            __syncthreads();
            const int l15 = lane & 15, g4 = lane >> 4, tile = F.wave >> 1, kh = F.wave & 1;
            const int trow = rg * 64 + tile * 16 + l15;
            const float* xr32 = xsrc32 + (size_t)trow * D; const bf16* xr16 = (COMBINE ? (const bf16*)xdst16 : xsrc16) + (size_t)trow * D;
            f32x4 acc[NT];
#pragma unroll
            for (int nt = 0; nt < NT; ++nt) acc[nt] = (f32x4){0.f, 0.f, 0.f, 0.f};
#pragma unroll 8
            for (int ks = kh * 16; ks < kh * 16 + 16; ++ks) {
                const int k0 = 32 * ks + 8 * g4;
                v4u hi, lo = (v4u){0u, 0u, 0u, 0u};
                if (XF32) {
                    const f32x4 x0 = *(const f32x4*)(xr32 + k0), x1 = *(const f32x4*)(xr32 + k0 + 4);
                    const float hv[8] = {x0[0], x0[1], x0[2], x0[3], x1[0], x1[1], x1[2], x1[3]};
                    unsigned* hp = (unsigned*)&hi; unsigned* lp = (unsigned*)&lo;
#pragma unroll
                    for (int e = 0; e < 4; ++e) { const unsigned w2 = pg8::cvt_pk_bf16(hv[2 * e], hv[2 * e + 1]); hp[e] = w2;
                        lp[e] = pg8::cvt_pk_bf16(hv[2 * e] - __builtin_bit_cast(float, w2 << 16), hv[2 * e + 1] - __builtin_bit_cast(float, w2 & 0xffff0000u)); }
                } else hi = *(const v4u*)(xr16 + k0);
                const rbf16x8 Ahi = __builtin_bit_cast(rbf16x8, hi), Alo = __builtin_bit_cast(rbf16x8, lo);
#pragma unroll
                for (int nt = 0; nt < NT; ++nt) {
                    const int n = (16 * nt + l15) < NC ? (16 * nt + l15) : (NC - 1);
                    const LAS unsigned char* tp = F.lds + ((4 * ks + g4) * NC + n) * 16;
                    const rbf16x8 Bhi = *(const LAS rbf16x8*)tp, Blo = *(const LAS rbf16x8*)(tp + NC * 2048);
                    acc[nt] = __builtin_amdgcn_mfma_f32_16x16x32_bf16(Ahi, Bhi, acc[nt], 0, 0, 0);
                    if (XF32) acc[nt] = __builtin_amdgcn_mfma_f32_16x16x32_bf16(Alo, Bhi, acc[nt], 0, 0, 0);
                    acc[nt] = __builtin_amdgcn_mfma_f32_16x16x32_bf16(Ahi, Blo, acc[nt], 0, 0, 0);
                }
            }
            TS_MARK(5);
            if (kh == 1) {
#pragma unroll
                for (int nt = 0; nt < NT; ++nt) { const int n = 16 * nt + l15;
                    if (n < NC) {
#pragma unroll
                        for (int r = 0; r < 4; ++r) logit[(tile * 16 + 4 * g4 + r) * NC + n] = acc[nt][r]; } }
            }
            __syncthreads();
            if (kh == 0) {
#pragma unroll
                for (int nt = 0; nt < NT; ++nt) { const int n = 16 * nt + l15;
                    if (n < NC) {
#pragma unroll
                        for (int r = 0; r < 4; ++r) logit[(tile * 16 + 4 * g4 + r) * NC + n] += acc[nt][r]; } }
            }
            __syncthreads();
        }
        TS_MARK(3);
        if (AUX == 1) {
            if (F.tid < 64) { const int row = rg * 64 + F.tid; const LAS float* lg = logit + F.tid * NC; const float ri = rinvL[F.tid]; float* gp = (float*)(F.ws + WS_GATES) + (size_t)row * 8;
                *(f32x4*)gp = (f32x4){lg[0] * ri + cbL[0], lg[1] * ri + cbL[1], lg[2] * ri + cbL[2], lg[3] * ri + cbL[3]};
                *(f32x4*)(gp + 4) = (f32x4){lg[4] * ri + cbL[4], lg[5] * ri + cbL[5], lg[6] * ri + cbL[6], lg[7] * ri + cbL[7]}; }
            __syncthreads();
        }
        if (AUX == 2) {
            if (F.tid < 64) {
                const LAS float* lg = logit + F.tid * NC; const float ri = rinvL[F.tid];
                float gl[4];
#pragma unroll
                for (int g = 0; g < 4; ++g) gl[g] = lg[g] * ri + cbL[g] + auxb0[g];
                int gs = 0; float gm = gl[0];
#pragma unroll
                for (int g = 1; g < 4; ++g) if (gl[g] > gm) { gm = gl[g]; gs = g; }
                float den = 0.f;
#pragma unroll
                for (int g = 0; g < 4; ++g) den += __expf(gl[g] - gm);
                const float psel = 1.0f / den;
                float el[8];
#pragma unroll
                for (int q = 0; q < 8; ++q) el[q] = lg[4 + gs * 8 + q] * ri + cbL[4 + gs * 8 + q] + auxb1[gs * 8 + q];
                int i1 = 0; float l1 = el[0];
#pragma unroll
                for (int q = 1; q < 8; ++q) if (el[q] > l1) { l1 = el[q]; i1 = q; }
                int i2 = -1; float l2 = -3.0e38f;
#pragma unroll
                for (int q = 0; q < 8; ++q) if (q != i1 && el[q] > l2) { l2 = el[q]; i2 = q; }
                const float ex = __expf(l2 - l1), w1 = psel / (1.0f + ex), w2 = psel * ex / (1.0f + ex);
                rowE[2 * F.tid] = gs * 8 + i1; rowE[2 * F.tid + 1] = gs * 8 + i2; rowW[2 * F.tid] = w1; rowW[2 * F.tid + 1] = w2;
            }
            __syncthreads();
            int e = 0, lp = 0;
            if (F.tid < 128) { e = rowE[F.tid]; lp = (int)__hip_atomic_fetch_add((LAS unsigned*)(F.LC + LC_LCNT + e), 1u, __ATOMIC_RELAXED, __HIP_MEMORY_SCOPE_WORKGROUP); }
            __syncthreads();
            if (F.tid < 32) F.LC[LC_LBASE + F.tid] = __hip_atomic_fetch_add(F.ctl + CW_CNT + (layer * 32 + F.tid) * 16, F.LC[LC_LCNT + F.tid], __ATOMIC_RELAXED, __HIP_MEMORY_SCOPE_AGENT);
            __syncthreads();
            if (F.tid < 128) { const int row = rg * 64 + (F.tid >> 1); const int pos = (int)F.LC[LC_LBASE + e] + lp;
                ((int*)(F.ws + WS_SLOTTOK))[e * 16384 + pos] = row; ((int*)(F.ws + WS_TOKPOS))[row * 2 + (F.tid & 1)] = pos * 32 + e; ((float*)(F.ws + WS_TOKW))[row * 2 + (F.tid & 1)] = rowW[F.tid]; }
            __syncthreads();
        }
        TS_MARK(4);
    }
}

__device__ __forceinline__ float logsigmoid_f(float x) { return x < 0.f ? x - log1pf(__expf(x)) : -log1pf(__expf(-x)); }
__device__ __forceinline__ void p_scan(Frame& F, int j  ) {
    constexpr int QS = 132;
    LAS float* q = (LAS float*)F.lds;
    LAS float* k = q + 64 * QS;
    LAS float* Cm = k + 64 * QS;
    LAS float* vv = Cm + 32 * QS;
    LAS float* vw = vv + 64 * 32;
    LAS float* Sm = vw + 64 * 32;
    LAS float* nn = Sm + 64 * 68;
    LAS float* ga = nn + 128;
    LAS float* gM = ga + 64;
    LAS float* gb = gM + 64;
    LAS float* gden = gb + 64;
    LAS float* gm = gden + 64;
    const bf16* PROJ = (const bf16*)(F.ws + WS_PROJ);
    const float* GATES = (const float*)(F.ws + WS_GATES);
    float* HS = (float*)(F.ws + WS_HS);
    const float* bg = KIN(I_MBG) + j * 8;
    const int tid = F.tid;
    for (int item = blockIdx.x; item < 256; item += F.G) {
        const int b = item >> 5, hd = (item >> 3) & 3, vs = item & 7;
        for (int i = tid; i < 32 * QS; i += NTHR) Cm[i] = 0.f;
        if (tid < 128) nn[tid] = 0.f;
        if (tid == 0) gm[0] = 0.f;
        __syncthreads();
        for (int ch = 0; ch < 32; ++ch) {
            const int row0 = b * SEQ + ch * 64;
            for (int p = tid; p < 2048; p += NTHR) { const int isk = p >> 10, pp = p & 1023, r = pp >> 4, c8 = (pp & 15) * 8;
                const v4u w = *(const v4u*)(PROJ + (size_t)(row0 + r) * NPROJ + isk * 512 + hd * 128 + c8);
                const float sc = isk ? 1.0f : 0.08838834764831845f;
                LAS float* dst = (isk ? k : q) + r * QS + c8;
                *(LAS f32x4*)dst = (f32x4){bflo(w.x) * sc, bfhi(w.x) * sc, bflo(w.y) * sc, bfhi(w.y) * sc};
                *(LAS f32x4*)(dst + 4) = (f32x4){bflo(w.z) * sc, bfhi(w.z) * sc, bflo(w.w) * sc, bfhi(w.w) * sc}; }
            if (tid < 256) { const int r = tid >> 2, c8 = (tid & 3) * 8;
                const v4u w = *(const v4u*)(PROJ + (size_t)(row0 + r) * NPROJ + 1024 + hd * 256 + vs * 32 + c8);
                LAS float* dst = vv + r * 32 + c8;
                *(LAS f32x4*)dst = (f32x4){bflo(w.x), bfhi(w.x), bflo(w.y), bfhi(w.y)}; *(LAS f32x4*)(dst + 4) = (f32x4){bflo(w.z), bfhi(w.z), bflo(w.w), bfhi(w.w)}; }
            if (tid < 64) {
                const float ig = GATES[(size_t)(row0 + tid) * 8 + hd] + bg[hd];
                const float lf = logsigmoid_f(GATES[(size_t)(row0 + tid) * 8 + 4 + hd] + bg[4 + hd]);
                float bc = lf;
#pragma unroll
                for (int o = 1; o < 64; o <<= 1) { const float t = __shfl_up(bc, o); if (tid >= o) bc += t; }
                const float a = ig - bc;
                float pm = a;
#pragma unroll
                for (int o = 1; o < 64; o <<= 1) { const float t = __shfl_up(pm, o); if (tid >= o) pm = fmaxf(pm, t); }
                const float m = gm[0];
                ga[tid] = a; gM[tid] = fmaxf(m, pm); gb[tid] = bc;
            }
            __syncthreads();
            {
                const int s = tid & 63, t0 = (tid >> 6) * 8;
                float acc[8];
#pragma unroll
                for (int i = 0; i < 8; ++i) acc[i] = 0.f;
                for (int d4 = 0; d4 < 32; ++d4) {
                    const f32x4 kv = *(const LAS f32x4*)(k + s * QS + d4 * 4);
#pragma unroll
                    for (int i = 0; i < 8; ++i) { const f32x4 qv = *(const LAS f32x4*)(q + (t0 + i) * QS + d4 * 4); acc[i] += qv[0] * kv[0] + qv[1] * kv[1] + qv[2] * kv[2] + qv[3] * kv[3]; }
                }
                const float as = ga[s];
#pragma unroll
                for (int i = 0; i < 8; ++i) { const int t = t0 + i; Sm[t * 68 + s] = (s <= t) ? acc[i] * __expf(as - gM[t]) : 0.f; }
            }
            __syncthreads();
            {
                const int t = tid >> 3, part = tid & 7; float sden = 0.f, nq = 0.f;
#pragma unroll
                for (int s = 0; s < 8; ++s) sden += Sm[t * 68 + part * 8 + s];
#pragma unroll
                for (int d = 0; d < 16; ++d) nq += nn[part * 16 + d] * q[t * QS + part * 16 + d];
                float tot = sden + __expf(gm[0] - gM[t]) * nq;
                tot += __shfl_xor(tot, 1); tot += __shfl_xor(tot, 2); tot += __shfl_xor(tot, 4);
                if (part == 0) gden[t] = tot;
            }
            __syncthreads();
            {
                const int v = tid & 31, t0 = (tid >> 5) * 4;
                float a1[4] = {0.f, 0.f, 0.f, 0.f}, a2[4] = {0.f, 0.f, 0.f, 0.f};
                for (int s4 = 0; s4 < 16; ++s4) {
                    float vx[4];
#pragma unroll
                    for (int e = 0; e < 4; ++e) vx[e] = vv[(s4 * 4 + e) * 32 + v];
#pragma unroll
                    for (int i = 0; i < 4; ++i) { const f32x4 sv = *(const LAS f32x4*)(Sm + (t0 + i) * 68 + s4 * 4); a1[i] += sv[0] * vx[0] + sv[1] * vx[1] + sv[2] * vx[2] + sv[3] * vx[3]; }
                }
                for (int d4 = 0; d4 < 32; ++d4) {
                    const f32x4 cv = *(const LAS f32x4*)(Cm + v * QS + d4 * 4);
#pragma unroll
                    for (int i = 0; i < 4; ++i) { const f32x4 qv = *(const LAS f32x4*)(q + (t0 + i) * QS + d4 * 4); a2[i] += qv[0] * cv[0] + qv[1] * cv[1] + qv[2] * cv[2] + qv[3] * cv[3]; }
                }
                const float m = gm[0];
#pragma unroll
                for (int i = 0; i < 4; ++i) { const int t = t0 + i; const float Mt = gM[t];
                    const float num = a1[i] + __expf(m - Mt) * a2[i];
                    const float dn = fmaxf(fabsf(gden[t]), __expf(-(gb[t] + Mt)));
                    HS[(size_t)(row0 + t) * D + hd * 256 + vs * 32 + v] = num / dn; }
            }
            for (int p = tid; p < 2048; p += NTHR) { const int s = p >> 5; vw[p] = vv[p] * __expf(ga[s] - gM[63]); }
            __syncthreads();
            {
                const float decay = __expf(gm[0] - gM[63]);
                const int d = tid & 127, v0 = (tid >> 7) * 8;
                float acc[8];
#pragma unroll
                for (int i = 0; i < 8; ++i) acc[i] = decay * Cm[(v0 + i) * QS + d];
                for (int s = 0; s < 64; ++s) {
                    const float kv = k[s * QS + d];
                    const f32x4 w0 = *(const LAS f32x4*)(vw + s * 32 + v0), w1 = *(const LAS f32x4*)(vw + s * 32 + v0 + 4);
                    acc[0] += w0[0] * kv; acc[1] += w0[1] * kv; acc[2] += w0[2] * kv; acc[3] += w0[3] * kv;
                    acc[4] += w1[0] * kv; acc[5] += w1[1] * kv; acc[6] += w1[2] * kv; acc[7] += w1[3] * kv;
                }
                float nacc = 0.f;
                if (tid < 128) { nacc = decay * nn[d]; for (int s = 0; s < 64; ++s) nacc += __expf(ga[s] - gM[63]) * k[s * QS + d]; }
                __syncthreads();
#pragma unroll
                for (int i = 0; i < 8; ++i) Cm[(v0 + i) * QS + d] = acc[i];
                if (tid < 128) nn[d] = nacc;
                if (tid == 0) gm[0] = gb[63] + gM[63];
            }
            __syncthreads();
        }
    }
}

typedef short s16x4 __attribute__((ext_vector_type(4)));
typedef short sbf16x8 __attribute__((ext_vector_type(8)));
#define TR16(p) __builtin_amdgcn_ds_read_tr16_b64_v4i16((LAS s16x4*)(p))
__device__ __forceinline__ sbf16x8 cat4(s16x4 a, s16x4 b) { return __builtin_shufflevector(a, b, 0, 1, 2, 3, 4, 5, 6, 7); }
__device__ __forceinline__ f32x4 mfma16(sbf16x8 a, sbf16x8 b, f32x4 c) { return __builtin_amdgcn_mfma_f32_16x16x32_bf16(a, b, c, 0, 0, 0); }
__device__ __forceinline__ sbf16x8 pack8s(float a0, float a1, float a2, float a3, float a4, float a5, float a6, float a7) {
    v4u w; w.x = pg8::cvt_pk_bf16(a0, a1); w.y = pg8::cvt_pk_bf16(a2, a3); w.z = pg8::cvt_pk_bf16(a4, a5); w.w = pg8::cvt_pk_bf16(a6, a7); return __builtin_bit_cast(sbf16x8, w); }
__device__ __forceinline__ float bf_s(short x) { return __builtin_bit_cast(float, ((unsigned)(unsigned short)x) << 16); }
template <int NSB>
__device__ __forceinline__ void scan_chunk_body(LAS unsigned char* Qs, LAS unsigned char* Ks, LAS unsigned char* Vs, LAS unsigned char* Vw, LAS unsigned char* Cr, LAS unsigned char* Cw,
                                                const LAS float* WS, const LAS float* ETS, const LAS float* WI, const LAS float* EM, const LAS unsigned short* WSB, const LAS float* DEC,
                                                const int ch, const int tb, const int vt, const int w, const int l15, const int g, const int ql, const int pl, f32x4 (&accC)[3], bf16* orow) {
            constexpr int QB = 272, VB = 80;
            const sbf16x8 ones = (sbf16x8){0x3F80, 0x3F80, 0x3F80, 0x3F80, 0x3F80, 0x3F80, 0x3F80, 0x3F80};
            const int tt = tb * 16 + l15;
            sbf16x8 qf[4], kf[NSB][4]; f32x4 wv[NSB];
#pragma unroll
            for (int kd = 0; kd < 4; ++kd) qf[kd] = *(const LAS sbf16x8*)(Qs + (tb * 16 + l15) * QB + (32 * kd + 8 * g) * 2);
#pragma unroll
            for (int kd = 0; kd < 4; ++kd)
#pragma unroll
                for (int sb = 0; sb < NSB; ++sb) kf[sb][kd] = *(const LAS sbf16x8*)(Ks + (sb * 16 + l15) * QB + (32 * kd + 8 * g) * 2);
            const float ets = ETS[ch * 64 + tt];
#pragma unroll
            for (int sb = 0; sb < NSB; ++sb) wv[sb] = *(const LAS f32x4*)(WS + ch * 64 + sb * 16 + 4 * g);
            __builtin_amdgcn_sched_barrier(0);
            f32x4 sacc[NSB]; f32x4 pv = (f32x4){0.f, 0.f, 0.f, 0.f}, qc = pv, qn = pv, psum = pv;
#pragma unroll
            for (int sb = 0; sb < NSB; ++sb) sacc[sb] = (f32x4){0.f, 0.f, 0.f, 0.f};
#pragma unroll
            for (int kd = 0; kd < 4; ++kd) {
#pragma unroll
                for (int sb = 0; sb < NSB; ++sb) sacc[sb] = mfma16(kf[sb][kd], qf[kd], sacc[sb]);
            }
            __builtin_amdgcn_sched_barrier(0);
            sbf16x8 cf[4], nf[4]; s16x4 va[2], vb[2];
#pragma unroll
            for (int ks = 0; ks < 2; ++ks) { va[ks] = TR16(Vs + (32 * ks + 4 * g + ql) * VB + (16 * vt + 4 * pl) * 2); vb[ks] = TR16(Vs + (32 * ks + 16 + 4 * g + ql) * VB + (16 * vt + 4 * pl) * 2); }
#pragma unroll
            for (int kd = 0; kd < 4; ++kd) { cf[kd] = *(const LAS sbf16x8*)(Cr + (16 * vt + l15) * QB + (32 * kd + 8 * g) * 2); nf[kd] = *(const LAS sbf16x8*)(Cr + (32 + l15) * QB + (32 * kd + 8 * g) * 2); }
            const f32x4 wiv = *(const LAS f32x4*)(WI + ch * 64 + tb * 16 + 4 * g), emv = *(const LAS f32x4*)(EM + ch * 64 + tb * 16 + 4 * g);
            __builtin_amdgcn_sched_barrier(0);
            float P[4][4];
#pragma unroll
            for (int sb = 0; sb < 4; ++sb) {
                if (sb < NSB) {
#pragma unroll
                    for (int r = 0; r < 4; ++r) P[sb][r] = ((sb * 16 + 4 * g + r) <= tt) ? sacc[sb < NSB ? sb : 0][r] * wv[sb < NSB ? sb : 0][r] * ets : 0.f;
                } else {
#pragma unroll
                    for (int r = 0; r < 4; ++r) P[sb][r] = 0.f;
                }
            }
#pragma unroll
            for (int ks = 0; ks < 2; ++ks) {
                const sbf16x8 pf = pack8s(P[2 * ks][0], P[2 * ks][1], P[2 * ks][2], P[2 * ks][3], P[2 * ks + 1][0], P[2 * ks + 1][1], P[2 * ks + 1][2], P[2 * ks + 1][3]);
                pv = mfma16(pf, cat4(va[ks], vb[ks]), pv); psum = mfma16(pf, ones, psum);
            }
#pragma unroll
            for (int kd = 0; kd < 4; ++kd) { qc = mfma16(qf[kd], cf[kd], qc); qn = mfma16(qf[kd], nf[kd], qn); }
            __builtin_amdgcn_sched_barrier(0);
            s16x4 k0[2], k1[2], x0[2][2], x1[2][2]; sbf16x8 of[2];
#pragma unroll
            for (int ks = 0; ks < 2; ++ks) {
                const int sr = 32 * ks + 8 * g;
                k0[ks] = TR16(Ks + (sr + ql) * QB + (16 * w + 4 * pl) * 2); k1[ks] = TR16(Ks + (sr + 4 + ql) * QB + (16 * w + 4 * pl) * 2);
#pragma unroll
                for (int v = 0; v < 2; ++v) { x0[ks][v] = TR16(Vw + (sr + ql) * VB + (16 * v + 4 * pl) * 2); x1[ks][v] = TR16(Vw + (sr + 4 + ql) * VB + (16 * v + 4 * pl) * 2); }
                of[ks] = *(const LAS sbf16x8*)(WSB + ch * 64 + sr);
            }
            const float decay = DEC[ch];
            __builtin_amdgcn_sched_barrier(0);
#pragma unroll
            for (int r = 0; r < 4; ++r) { const float den = psum[r] + wiv[r] * qn[r], num = pv[r] + wiv[r] * qc[r]; orow[(size_t)r * D] = (bf16)f2bf(num * __builtin_amdgcn_rcpf(fmaxf(fabsf(den), emv[r]))); }
#pragma unroll
            for (int v = 0; v < 3; ++v) accC[v] = accC[v] * decay;
#pragma unroll
            for (int ks = 0; ks < 2; ++ks) {
                const sbf16x8 kt = cat4(k0[ks], k1[ks]);
#pragma unroll
                for (int v = 0; v < 2; ++v) accC[v] = mfma16(kt, cat4(x0[ks][v], x1[ks][v]), accC[v]);
                accC[2] = mfma16(kt, of[ks], accC[2]);
            }
#pragma unroll
            for (int v = 0; v < 3; ++v) { v2u o; o.x = pg8::cvt_pk_bf16(accC[v][0], accC[v][1]); o.y = pg8::cvt_pk_bf16(accC[v][2], accC[v][3]); *(LAS v2u*)(Cw + (16 * v + l15) * QB + (16 * w + 4 * g) * 2) = o; }
}
__device__ __forceinline__ void p_scan_mfma(Frame& F, int j, bf16* HS) {
    constexpr int QB = 272, VB = 80;
    constexpr int OFF_Q = 0, OFF_K = 2 * 64 * QB, OFF_V = 4 * 64 * QB, OFF_VW = OFF_V + 2 * 64 * VB, OFF_C = OFF_VW + 2 * 64 * VB;
    constexpr int OFF_WS = OFF_C + 2 * 48 * QB, OFF_ETS = OFF_WS + 8192, OFF_WI = OFF_ETS + 8192, OFF_EM = OFF_WI + 8192, OFF_WSB = OFF_EM + 8192, OFF_DEC = OFF_WSB + 4096, OFF_PM63 = OFF_DEC + 128, OFF_B63 = OFF_PM63 + 128;
    static_assert(OFF_B63 + 128 <= LDSCTL_OFF, "scan LDS map");
    LAS unsigned char* L = F.lds;
    const int tid = F.tid, lane = F.lane, w = F.wave, l15 = lane & 15, g = lane >> 4, ql = l15 >> 2, pl = l15 & 3, tb = w & 3, vt = w >> 2;
    LAS float* WS = (LAS float*)(L + OFF_WS); LAS float* ETS = (LAS float*)(L + OFF_ETS); LAS float* WI = (LAS float*)(L + OFF_WI); LAS float* EM = (LAS float*)(L + OFF_EM);
    LAS unsigned short* WSB = (LAS unsigned short*)(L + OFF_WSB); LAS float* DEC = (LAS float*)(L + OFF_DEC); LAS float* PM63 = (LAS float*)(L + OFF_PM63); LAS float* B63 = (LAS float*)(L + OFF_B63);
    const bf16* PROJ = (const bf16*)(F.ws + WS_PROJ);
    const float* GATES = (const float*)(F.ws + WS_GATES);
    const float* bg = KIN(I_MBG) + j * 8;
    const float scale = 0.08838834764831845f;
    const sbf16x8 ones = (sbf16x8){0x3F80, 0x3F80, 0x3F80, 0x3F80, 0x3F80, 0x3F80, 0x3F80, 0x3F80};
    for (int item0 = blockIdx.x; item0 < 256; item0 += F.G) {
        const int item = (((item0 & 7) * 4 + (item0 >> 6)) << 3) | ((item0 >> 3) & 7);
        const int b = item >> 5, hd = (item >> 3) & 3, vs = item & 7;
        const float bi = bg[hd], bfg = bg[4 + hd];
        const bf16* qbase = PROJ + (size_t)(b * SEQ) * NPROJ + hd * 128;
        const bf16* vbase = PROJ + (size_t)(b * SEQ) * NPROJ + 1024 + hd * 256 + vs * 32;
        const float* gbase = GATES + (size_t)(b * SEQ) * 8 + hd;
#ifdef SCAN_ZERO_LDS
        for (int i = tid; i < (OFF_B63 + 128) / 4; i += NTHR) ((LAS unsigned*)L)[i] = 0u;
        __syncthreads();
#endif
        for (int i = tid; i < 48 * QB / 4; i += NTHR) ((LAS unsigned*)(L + OFF_C))[i] = 0u;
#pragma unroll
        for (int cc = 0; cc < 4; ++cc) {
            const int c = 4 * w + cc, pos = c * 64 + lane;
            const float ipre = gbase[(size_t)pos * 8] + bi, lf = logsigmoid_f(gbase[(size_t)pos * 8 + 4] + bfg);
            float bc = lf;
#pragma unroll
            for (int o = 1; o < 64; o <<= 1) { const float t = __shfl_up(bc, o); if (lane >= o) bc += t; }
            const float a = ipre - bc;
            float pm = a;
#pragma unroll
            for (int o = 1; o < 64; o <<= 1) { const float t = __shfl_up(pm, o); if (lane >= o) pm = fmaxf(pm, t); }
            WS[pos] = a; ETS[pos] = bc; WI[pos] = pm;
            if (lane == 63) { PM63[c] = pm; B63[c] = bc; }
        }
        __syncthreads();
        {
            float mw[4] = {0.f, 0.f, 0.f, 0.f}; float mc = 0.f;
#pragma unroll
            for (int c = 0; c < 32; ++c) { if ((c >> 2) == w) mw[c & 3] = mc; mc = B63[c] + fmaxf(mc, PM63[c]); }
#pragma unroll
            for (int cc = 0; cc < 4; ++cc) {
                const int c = 4 * w + cc, pos = c * 64 + lane; const float m_c = mw[cc];
                const float a = WS[pos], bc = ETS[pos], pm = WI[pos];
                const float M63 = fmaxf(m_c, PM63[c]), Mt = fmaxf(m_c, pm);
                const float wsv = __expf(a - M63);
                WS[pos] = wsv; WSB[pos] = (unsigned short)f2bf(wsv); ETS[pos] = __expf(M63 - Mt) * scale; WI[pos] = __expf(m_c - Mt) * scale; EM[pos] = __expf(-(bc + Mt));
                if (lane == 0) DEC[c] = __expf(m_c - M63);
            }
        }
        __syncthreads();
        f32x4 accC[3];
#pragma unroll
        for (int v = 0; v < 3; ++v) accC[v] = (f32x4){0.f, 0.f, 0.f, 0.f};
        const int sr0 = tid >> 4, sc0 = (tid & 15) * 8, svr = (tid >> 2) & 63, svc = (tid & 3) * 8;
        const bf16* gq = qbase + (size_t)sr0 * NPROJ + sc0; const bf16* gv = vbase + (size_t)svr * NPROJ + svc;
        const int lq0 = sr0 * QB + sc0 * 2, lv0 = svr * VB + svc * 2;
        v4u qr[2], kr[2], vr = (v4u){0u, 0u, 0u, 0u};
#pragma unroll
        for (int i = 0; i < 2; ++i) { qr[i] = *(const v4u*)(gq + (size_t)(32 * i) * NPROJ); kr[i] = *(const v4u*)(gq + (size_t)(32 * i) * NPROJ + 512); }
        if (tid < 256) vr = *(const v4u*)gv;
#define SCAN_STAGE(buf, chn) do { \
            _Pragma("unroll") for (int i = 0; i < 2; ++i) { *(LAS v4u*)(L + OFF_Q + (buf) * 64 * QB + lq0 + 32 * i * QB) = qr[i]; *(LAS v4u*)(L + OFF_K + (buf) * 64 * QB + lq0 + 32 * i * QB) = kr[i]; } \
            if (tid < 256) { *(LAS v4u*)(L + OFF_V + (buf) * 64 * VB + lv0) = vr; const float wsr = WS[(chn) * 64 + svr]; \
                v4u sw; sw.x = pg8::cvt_pk_bf16(bflo(vr.x) * wsr, bfhi(vr.x) * wsr); sw.y = pg8::cvt_pk_bf16(bflo(vr.y) * wsr, bfhi(vr.y) * wsr); sw.z = pg8::cvt_pk_bf16(bflo(vr.z) * wsr, bfhi(vr.z) * wsr); sw.w = pg8::cvt_pk_bf16(bflo(vr.w) * wsr, bfhi(vr.w) * wsr); \
                *(LAS v4u*)(L + OFF_VW + (buf) * 64 * VB + lv0) = sw; } } while (0)
        SCAN_STAGE(0, 0);
        __syncthreads();
        bf16* obase = HS + (size_t)(b * SEQ + tb * 16 + 4 * g) * D + hd * 256 + vs * 32 + vt * 16 + l15;
        for (int ch = 0; ch < 32; ++ch) {
            const int cb = ch & 1, nb = cb ^ 1;
            LAS unsigned char* Qs = L + OFF_Q + cb * 64 * QB; LAS unsigned char* Ks = L + OFF_K + cb * 64 * QB; LAS unsigned char* Vs = L + OFF_V + cb * 64 * VB; LAS unsigned char* Vw = L + OFF_VW + cb * 64 * VB;
            LAS unsigned char* Cr = L + OFF_C + cb * 48 * QB; LAS unsigned char* Cw = L + OFF_C + nb * 48 * QB;
            { const size_t nro = (size_t)((ch < 31 ? ch + 1 : ch) * 64) * NPROJ;
#pragma unroll
              for (int i = 0; i < 2; ++i) { qr[i] = *(const v4u*)(gq + nro + (size_t)(32 * i) * NPROJ); kr[i] = *(const v4u*)(gq + nro + (size_t)(32 * i) * NPROJ + 512); }
              if (tid < 256) vr = *(const v4u*)(gv + nro); }
            { bf16* orow = obase + (size_t)(ch * 64) * D;
              if (tb == 0) scan_chunk_body<1>(Qs, Ks, Vs, Vw, Cr, Cw, WS, ETS, WI, EM, WSB, DEC, ch, tb, vt, w, l15, g, ql, pl, accC, orow);
              else if (tb == 1) scan_chunk_body<2>(Qs, Ks, Vs, Vw, Cr, Cw, WS, ETS, WI, EM, WSB, DEC, ch, tb, vt, w, l15, g, ql, pl, accC, orow);
              else if (tb == 2) scan_chunk_body<3>(Qs, Ks, Vs, Vw, Cr, Cw, WS, ETS, WI, EM, WSB, DEC, ch, tb, vt, w, l15, g, ql, pl, accC, orow);
              else scan_chunk_body<4>(Qs, Ks, Vs, Vw, Cr, Cw, WS, ETS, WI, EM, WSB, DEC, ch, tb, vt, w, l15, g, ql, pl, accC, orow); }
#ifdef SCAN_EXTRA_SYNC
            __syncthreads();
#endif
            SCAN_STAGE(nb, (ch < 31 ? ch + 1 : ch));
            __syncthreads();
        }
#undef SCAN_STAGE
    }
}

__device__ __forceinline__ void p_mnorm(Frame& F, int j) {
    const bf16* HS = (const bf16*)(F.ws + WS_HS); const bf16* PROJ = (const bf16*)(F.ws + WS_PROJ); bf16* A2 = (bf16*)(F.ws + WS_A2);
    const float* ng = KIN(I_MNORMG) + j * 1024;
    const int gw = blockIdx.x * NWAVES + F.wave, NGW = F.G * NWAVES, lane = F.lane;
    f32x4 g[4];
#pragma unroll
    for (int hd = 0; hd < 4; ++hd) g[hd] = *((const f32x4*)ng + lane + 64 * hd);
    for (int row0 = gw * 2; row0 < NTOK; row0 += NGW * 2) {
        f32x4 v[2][4]; v2u ow[2][4];
#pragma unroll
        for (int r = 0; r < 2; ++r)
#pragma unroll
            for (int hd = 0; hd < 4; ++hd) { const v2u hw = *((const v2u*)(HS + (size_t)(row0 + r) * D) + lane + 64 * hd); v[r][hd] = (f32x4){bflo(hw.x), bfhi(hw.x), bflo(hw.y), bfhi(hw.y)}; ow[r][hd] = *((const v2u*)(PROJ + (size_t)(row0 + r) * NPROJ + 2048) + lane + 64 * hd); }
#pragma unroll
        for (int r = 0; r < 2; ++r)
#pragma unroll
            for (int hd = 0; hd < 4; ++hd) {
                const f32x4 x = v[r][hd];
                const float ss = wave_sum((x[0] * x[0] + x[1] * x[1]) + (x[2] * x[2] + x[3] * x[3]));
                const float rinv = 1.0f / sqrtf(ss * (1.0f / 256.0f) + EPS);
                const float o0 = bflo(ow[r][hd].x), o1 = bfhi(ow[r][hd].x), o2 = bflo(ow[r][hd].y), o3 = bfhi(ow[r][hd].y);
                f32x4 q;
                q[0] = x[0] * rinv * g[hd][0] * __builtin_amdgcn_rcpf(1.0f + __expf(-o0)); q[1] = x[1] * rinv * g[hd][1] * __builtin_amdgcn_rcpf(1.0f + __expf(-o1));
                q[2] = x[2] * rinv * g[hd][2] * __builtin_amdgcn_rcpf(1.0f + __expf(-o2)); q[3] = x[3] * rinv * g[hd][3] * __builtin_amdgcn_rcpf(1.0f + __expf(-o3));
                v2u o; o.x = pk2(q[0], q[1]); o.y = pk2(q[2], q[3]);
                *((v2u*)(A2 + (size_t)(row0 + r) * D) + lane + 64 * hd) = o;
            }
    }
}

__device__ __forceinline__ void p_conv(Frame& F, int j) {
    const bf16* PROJ = (const bf16*)(F.ws + WS_PROJ); bf16* A2 = (bf16*)(F.ws + WS_A2);
    const float* cw = KIN(I_SCONVW) + (size_t)j * 3 * 1024;
    for (int item = blockIdx.x * NTHR + F.tid; item < (NTOK / 16) * 128; item += F.G * NTHR) {
        const int cg = item & 127, rc = item >> 7, row0 = rc * 16, ch = cg * 8;
        float w0[8], w1[8], w2[8], um2[8], um1[8];
#pragma unroll
        for (int c = 0; c < 8; ++c) { w0[c] = cw[ch + c]; w1[c] = cw[1024 + ch + c]; w2[c] = cw[2048 + ch + c]; um2[c] = 0.f; um1[c] = 0.f; }
        if ((row0 & (SEQ - 1)) != 0) {
            const v4u a = *(const v4u*)(PROJ + (size_t)(row0 - 2) * NPROJ + ch), bq = *(const v4u*)(PROJ + (size_t)(row0 - 1) * NPROJ + ch);
            um2[0] = bflo(a.x); um2[1] = bfhi(a.x); um2[2] = bflo(a.y); um2[3] = bfhi(a.y); um2[4] = bflo(a.z); um2[5] = bfhi(a.z); um2[6] = bflo(a.w); um2[7] = bfhi(a.w);
            um1[0] = bflo(bq.x); um1[1] = bfhi(bq.x); um1[2] = bflo(bq.y); um1[3] = bfhi(bq.y); um1[4] = bflo(bq.z); um1[5] = bfhi(bq.z); um1[6] = bflo(bq.w); um1[7] = bfhi(bq.w);
        }
        for (int r = 0; r < 16; ++r) {
            const v4u uw = *(const v4u*)(PROJ + (size_t)(row0 + r) * NPROJ + ch), gw = *(const v4u*)(PROJ + (size_t)(row0 + r) * NPROJ + 1024 + ch);
            float u0[8], g[8], y[8];
            u0[0] = bflo(uw.x); u0[1] = bfhi(uw.x); u0[2] = bflo(uw.y); u0[3] = bfhi(uw.y); u0[4] = bflo(uw.z); u0[5] = bfhi(uw.z); u0[6] = bflo(uw.w); u0[7] = bfhi(uw.w);
            g[0] = bflo(gw.x); g[1] = bfhi(gw.x); g[2] = bflo(gw.y); g[3] = bfhi(gw.y); g[4] = bflo(gw.z); g[5] = bfhi(gw.z); g[6] = bflo(gw.w); g[7] = bfhi(gw.w);
#pragma unroll
            for (int c = 0; c < 8; ++c) { y[c] = g[c] * (w0[c] * um2[c] + w1[c] * um1[c] + w2[c] * u0[c]); um2[c] = um1[c]; um1[c] = u0[c]; }
            v4u o; o.x = pk2(y[0], y[1]); o.y = pk2(y[2], y[3]); o.z = pk2(y[4], y[5]); o.w = pk2(y[6], y[7]);
            *(v4u*)(A2 + (size_t)(row0 + r) * D + ch) = o;
        }
    }
}

constexpr int N_STEPS = 2 + 2 * (8 + 7);
__global__ void __launch_bounds__(NTHR, 2) trunk_fwd(Args args) {
    extern __shared__ __attribute__((aligned(16))) unsigned char lds_raw[];
    Frame F;
    F.lds = (LAS unsigned char*)lds_raw;
    F.LC = (volatile LAS unsigned*)(F.lds + LDSCTL_OFF);
    F.tid = threadIdx.x; F.lane = F.tid & 63; F.wave = __builtin_amdgcn_readfirstlane(F.tid >> 6); F.G = gridDim.x;
    F.out = as_global(args.out); F.ws = as_global(args.ws); F.ctl = as_global((unsigned*)(args.ws + WS_CTL));
    for (int u = F.tid; u < 256; u += NTHR) F.LC[u] = 0u;
    __syncthreads();
    if (!N_LAUNCH_SPLIT) (void)xcd_barrier_post(F.ctl + CW_BAR, F.LC);
    const int lo = N_LAUNCH_SPLIT ? args.ph_lo : 0, hi = N_LAUNCH_SPLIT ? args.ph_hi : N_STEPS;
    int step = 0;
#ifndef EN_MASK
#define EN_MASK 0xFFFFFFFFu
#endif
#define EN(k) (((EN_MASK) >> (k)) & 1u)
#ifndef OUTPROJ_WGM
#define OUTPROJ_WGM 4
#endif
#ifndef INPROJ_WGM
#define INPROJ_WGM 4
#endif
#ifndef MOE_WGM
#define MOE_WGM 4
#endif
#ifndef BAR_REP
#define BAR_REP 0
#endif
#ifndef REP_MASK
#define REP_MASK 0u
#endif
#define REP(k) for (int _r = 0; _r < 1 + (int)(((REP_MASK) >> (k)) & 1u); ++_r)
#define IN_STEP() (lo <= step && step < hi)
#ifdef TPROBE
    int tp_cur = -1; unsigned long long tp_t0 = 0;
#define TP0(k) tp_cur = (k); if (TPROBE == (k)) tp_t0 = __builtin_amdgcn_s_memrealtime();
#define TP_PRE() unsigned long long _t1 = 0; if (tp_cur == TPROBE) { asm volatile("s_waitcnt vmcnt(0)" ::: "memory"); __syncthreads(); _t1 = __builtin_amdgcn_s_memrealtime(); \
        if (TPMODE == 0 && threadIdx.x == 0) atomicMax(F.ctl + 80, (unsigned)(_t1 - tp_t0)); }
#define TP_POST() if (tp_cur == TPROBE && TPMODE != 0 && threadIdx.x == 0) { const unsigned d = (unsigned)(__builtin_amdgcn_s_memrealtime() - _t1); atomicMax(F.ctl + 80, TPMODE == 1 ? 0x40000000u - d : d); }
#else
#define TP0(k)
#define TP_PRE()
#define TP_POST()
#endif
#define END_STEP() do { TP_PRE(); if (!N_LAUNCH_SPLIT) { XcdBarrier _b; _b.bar = (unsigned*)launder(F.ws) + CW_BAR; _b.x = xb_xcc_id(); _b.st = F.LC; xcd_barrier(_b); if (BAR_REP) xcd_barrier(_b); } TP_POST(); ++step; } while (0)
#define X (launder(F.out))
#define WSB (launder(F.ws))
#define XS ((bf16*)(WSB + WS_X))
#define MOD ((const float*)(WSB + WS_MOD))
#define H ((bf16*)(WSB + WS_H))
#define PROJ ((bf16*)(WSB + WS_PROJ))
#define A2 ((bf16*)(WSB + WS_A2))

    TP0(0) if (EN(0) && IN_STEP()) { Frame P = fresh(F); REP(15) { p_adaln(P); __syncthreads(); } REP(0) { p_convert(P); } } END_STEP();
    TP0(1) if (EN(1) && IN_STEP()) REP(1) { Frame P = fresh(F); row_phase<false, 1, false, true>(P, KIN(I_X), nullptr, MOD, KIN(I_NORMG), nullptr, 0, KIN(I_MWIN), nullptr, nullptr, nullptr, 0); } END_STEP();

    for (int l = 0; l < DEPTH; ++l) {
        const int lp = l >> 1;
        if ((l & 1) == 0) {
            TP0(2) if (EN(2) && IN_STEP()) REP(2) { pg8::DenseSched S; S.T.init(NTOK / 256, NPROJ / 256, pg8::opaque_s(F.G), pg8::opaque_s((int)blockIdx.x), INPROJ_WGM); S.A = (const char*)H; S.Bt = (const char*)(WSB + WS_WMIN) + (size_t)lp * 3072 * 1024 * 2; S.K = 1024;
                pg8::EpiStoreBf16 E{PROJ, NPROJ, 1.0f}; pg8::gemm_phase<pg8::EpiStoreBf16, pg8::DenseSched, true>(F.lds, 1024, S, E); } END_STEP();
            TP0(3) if (EN(3) && IN_STEP()) REP(3) { Frame P = fresh(F); p_scan_mfma(P, lp, (bf16*)(P.ws + WS_HS));
#ifdef SCAN_SELFCHECK
                { float* H1 = (float*)(P.ws + WS_HMID); float* H2 = (float*)(P.ws + WS_END);
                  __syncthreads(); p_scan_mfma(P, lp, H1); __syncthreads(); p_scan_mfma(P, lp, H2); asm volatile("s_waitcnt vmcnt(0)" ::: "memory"); __syncthreads();
                  for (int item = blockIdx.x; item < 256; item += P.G) { const int b = item >> 5, hd = (item >> 3) & 3, vs = item & 7; int bad = 0;
                      for (int i = P.tid; i < 2048 * 32; i += NTHR) { const size_t o = (size_t)(b * SEQ + (i >> 5)) * D + hd * 256 + vs * 32 + (i & 31);
                          const unsigned a1 = __hip_atomic_load((const unsigned*)H1 + o, __ATOMIC_RELAXED, __HIP_MEMORY_SCOPE_AGENT), a2 = __hip_atomic_load((const unsigned*)H2 + o, __ATOMIC_RELAXED, __HIP_MEMORY_SCOPE_AGENT); if (a1 != a2) bad = 1; }
                      if (bad) __hip_atomic_fetch_or(P.ctl + 64, 1u, __ATOMIC_RELAXED, __HIP_MEMORY_SCOPE_AGENT); } }
#endif
#ifdef SCAN_BOTH
                __syncthreads(); p_scan(P, lp);
#endif
            } END_STEP();
            TP0(4) if (EN(4) && IN_STEP()) REP(4) { Frame P = fresh(F); p_mnorm(P, lp); } END_STEP();
            TP0(5) if (EN(5) && IN_STEP()) REP(5) { pg8::DenseSched S; S.T.init(NTOK / 256, 4, pg8::opaque_s(F.G), pg8::opaque_s((int)blockIdx.x), OUTPROJ_WGM); S.A = (const char*)A2; S.Bt = (const char*)(WSB + WS_WMOUT) + (size_t)lp * 1024 * 1024 * 2; S.K = 1024;
                pg8::EpiResid E{l == 0 ? KIN(I_X) : (const float*)nullptr, XS, MOD + (size_t)(l * 2) * 8 * 3072 + 2048}; pg8::gemm_phase<pg8::EpiResid, pg8::DenseSched, true>(F.lds, 1024, S, E); } END_STEP();
        } else {
            TP0(10) if (EN(10) && IN_STEP()) REP(10) { pg8::DenseSched S; S.T.init(NTOK / 256, NPROJ / 256, pg8::opaque_s(F.G), pg8::opaque_s((int)blockIdx.x), INPROJ_WGM); S.A = (const char*)H; S.Bt = (const char*)(WSB + WS_WSIN) + (size_t)lp * 3072 * 1024 * 2; S.K = 1024;
                pg8::EpiConvIn E{PROJ, NPROJ}; pg8::gemm_phase<pg8::EpiConvIn, pg8::DenseSched, true>(F.lds, 1024, S, E); } END_STEP();
            TP0(11) if (EN(11) && IN_STEP()) REP(11) { Frame P = fresh(F); p_conv(P, lp); } END_STEP();
            TP0(12) if (EN(12) && IN_STEP()) REP(12) { pg8::DenseSched S; S.T.init(NTOK / 256, 4, pg8::opaque_s(F.G), pg8::opaque_s((int)blockIdx.x), OUTPROJ_WGM); S.A = (const char*)A2; S.Bt = (const char*)(WSB + WS_WSOUT) + (size_t)lp * 1024 * 1024 * 2; S.K = 1024;
                pg8::EpiResid E{nullptr, XS, MOD + (size_t)(l * 2) * 8 * 3072 + 2048}; pg8::gemm_phase<pg8::EpiResid, pg8::DenseSched, true>(F.lds, 1024, S, E); } END_STEP();
        }
        TP0(6) if (EN(6) && IN_STEP()) REP(6) { Frame P = fresh(F); row_phase<false, 2, false>(P, XS, nullptr, MOD + (size_t)(l * 2 + 1) * 8 * 3072, KIN(I_NORMG) + (l * 2 + 1) * 1024, nullptr, 0,
                                                  KIN(I_RWG) + (size_t)l * 1024 * 4, KIN(I_RWE) + (size_t)l * 1024 * 32, KIN(I_RBG) + l * 4, KIN(I_RBE) + l * 32, l + 4 * _r); } END_STEP();
        TP0(7) if (EN(7) && IN_STEP()) REP(7) { Frame P = fresh(F); moe_tables(P, l); pg8::GuSched S; S.T.init((int)F.LC[LC_TOFF + 32], 4, pg8::opaque_s(F.G), pg8::opaque_s((int)blockIdx.x), MOE_WGM); S.A = (const char*)H; S.K = 512; S.Bt = (const char*)(WSB + WS_WGU) + (size_t)l * 32 * 1024 * 1024;
            S.slot_tok = (const int*)(WSB + WS_SLOTTOK); S.toff = (const PG8_LAS int*)(F.lds + LDSCTL_OFF + LC_TOFF * 4); S.cnt = (const PG8_LAS int*)(F.lds + LDSCTL_OFF + LC_CNT * 4); S.soff = (const PG8_LAS int*)(F.lds + LDSCTL_OFF + LC_SOFF * 4); S.sexp = (const PG8_LAS int*)(F.lds + LDSCTL_OFF + LC_SEXP * 4);
            pg8::EpiGateUp E{(unsigned char*)(WSB + WS_HMID)}; pg8::gemm_phase<pg8::EpiGateUp, pg8::GuSched, true, true>(F.lds, 512, S, E); } END_STEP();
        TP0(8) if (EN(8) && IN_STEP()) REP(8) { Frame P = fresh(F); moe_tables(P, l); pg8::DnSched S; S.T.init((int)F.LC[LC_TOFF + 32], 4, pg8::opaque_s(F.G), pg8::opaque_s((int)blockIdx.x), MOE_WGM); S.A = (const char*)(WSB + WS_HMID); S.K = 256; S.Bt = (const char*)(WSB + WS_WDN) + (size_t)l * 32 * 1024 * 512;
            S.toff = (const PG8_LAS int*)(F.lds + LDSCTL_OFF + LC_TOFF * 4); S.soff = (const PG8_LAS int*)(F.lds + LDSCTL_OFF + LC_SOFF * 4); S.sexp = (const PG8_LAS int*)(F.lds + LDSCTL_OFF + LC_SEXP * 4);
            pg8::EpiStoreF8 E{(unsigned char*)(WSB + WS_YR), 1024}; pg8::gemm_phase<pg8::EpiStoreF8, pg8::DnSched, true, true>(F.lds, 256, S, E); } END_STEP();
        if (l == 3) {
            TP0(14) if (EN(14) && IN_STEP()) REP(14) { Frame P = fresh(F); row_phase<true, 0, true>(P, XS, X, nullptr, KIN(I_FINALG), MOD + (size_t)(l * 2 + 1) * 8 * 3072, l, nullptr, nullptr, nullptr, nullptr, 0); } ++step;
        } else if (l == 1) {
            TP0(13) if (EN(13) && IN_STEP()) REP(13) { Frame P = fresh(F); row_phase<true, 1, false>(P, XS, XS, MOD + (size_t)((l + 1) * 2) * 8 * 3072, KIN(I_NORMG) + ((l + 1) * 2) * 1024, MOD + (size_t)(l * 2 + 1) * 8 * 3072, l,
                                                     KIN(I_MWIN) + (size_t)1 * 1024 * M_PROJ, nullptr, nullptr, nullptr, 0); } END_STEP();
        } else {
            TP0(9) if (EN(9) && IN_STEP()) REP(9) { Frame P = fresh(F); row_phase<true, 0, false>(P, XS, XS, MOD + (size_t)((l + 1) * 2) * 8 * 3072, KIN(I_NORMG) + ((l + 1) * 2) * 1024, MOD + (size_t)(l * 2 + 1) * 8 * 3072, l, nullptr, nullptr, nullptr, nullptr, 0); } END_STEP();
        }
    }
#if defined(TPROBE) || defined(TPSUB)
#ifndef TPMODE
#define TPMODE 0
#endif
    __syncthreads();
    if (blockIdx.x == 0 && threadIdx.x == 0) { asm volatile("s_waitcnt vmcnt(0)" ::: "memory"); unsigned d = __hip_atomic_load(F.ctl + 80, __ATOMIC_RELAXED, __HIP_MEMORY_SCOPE_AGENT); if (TPMODE == 1) d = 0x40000000u - d;
        F.out[0] = (float)d * (0.01f / (float)(TPSCALE)); }
#endif
#undef IN_STEP
#undef END_STEP
#undef X
#undef WSB
#undef XS
#undef MOD
#undef H
#undef PROJ
#undef A2
}

extern "C" void kernel_launch(void* const* d_in, const int* in_sizes, int n_in, void* d_out, int out_size, void* d_ws, size_t ws_size, hipStream_t stream) {
    static int grid = 0;
    if (grid == 0) {
        if (n_in != 20 || in_sizes[0] != NTOK * D || out_size != NTOK * D || ws_size < WS_END) { fprintf(stderr, "kernel_launch: unexpected shapes (n_in %d, ws %zu)\n", n_in, ws_size); grid = -1; return; }
        int dev = 0, cus = 0, per_cu = 0;
        if (hipGetDevice(&dev) != hipSuccess || hipDeviceGetAttribute(&cus, hipDeviceAttributeMultiprocessorCount, dev) != hipSuccess) { grid = -1; return; }
        if (hipFuncSetAttribute((const void*)trunk_fwd, hipFuncAttributeMaxDynamicSharedMemorySize, LDS_BYTES) != hipSuccess) { fprintf(stderr, "kernel_launch: hipFuncSetAttribute failed\n"); grid = -1; return; }
        if (hipOccupancyMaxActiveBlocksPerMultiprocessor(&per_cu, (const void*)trunk_fwd, NTHR, LDS_BYTES) != hipSuccess || per_cu < 1) fprintf(stderr, "kernel_launch: occupancy query reports %d\n", per_cu);
        (void)hipGetLastError();
        grid = cus;
    }
    if (grid < 0) return;
    if (hipMemsetAsync((char*)d_ws + WS_CTL, 0, CTL_ZERO_BYTES, stream) != hipSuccess) return;
    Args a{};
    for (int i = 0; i < 20; ++i) a.in[i] = (const float*)d_in[i];
    a.out = (float*)d_out; a.ws = (unsigned char*)d_ws;
    if (N_LAUNCH_SPLIT) {
        for (int s = 0; s < N_STEPS; ++s) { a.ph_lo = s; a.ph_hi = s + 1; hipLaunchKernelGGL(trunk_fwd, dim3(grid), dim3(NTHR), LDS_BYTES, stream, a); }
    } else {
        a.ph_lo = 0; a.ph_hi = N_STEPS; hipLaunchKernelGGL(trunk_fwd, dim3(grid), dim3(NTHR), LDS_BYTES, stream, a);
    }
}
```

```cpp
#include <hip/hip_runtime.h>
#include <cstdio>
#include <cstdint>

#ifndef SCAN_MFMA
#define SCAN_MFMA 1
#endif
#ifndef N_LAUNCH_SPLIT
#define N_LAUNCH_SPLIT 0
#endif

namespace pg8 {
#define PG8_LAS __attribute__((address_space(3)))
typedef unsigned short bf16_t;
typedef short bf16x8 __attribute__((ext_vector_type(8)));
typedef float f32x4 __attribute__((ext_vector_type(4)));
typedef unsigned u32x4 __attribute__((ext_vector_type(4)));
constexpr int BM = 256, BK = 64, HALF = 128, HTB = HALF * BK * 2, STAGE_BYTES = 8 * HTB, NXCD = 8, WGM = 8;

__host__ __device__ __forceinline__ int lds_byte(int r, int c) { const int st = (r >> 4) * 2 + (c >> 5), rr = r & 15, cc = c & 31, ob = rr * 64 + cc * 2; return st * 1024 + (ob ^ (((ob >> 9) & 1) << 5)); }
__host__ __device__ __forceinline__ void stage_rc(int b, int& R, int& C) { const int st = b / 1024, sb = b % 1024, swz = sb ^ (((sb >> 9) & 1) << 5); R = (st >> 1) * 16 + swz / 64; C = (st & 1) * 32 + (swz % 64) / 2; }
__host__ __device__ __forceinline__ int perm32(int rho) { const int n = rho >> 4, i = rho & 15; return 8 * (i >> 2) + 4 * n + (i & 3); }

__device__ __forceinline__ int opaque_v(int x) { asm volatile("" : "+v"(x)); return x; }
__device__ __forceinline__ int opaque_s(int x) { asm volatile("" : "+s"(x)); return x; }
struct Unit { int pm, pn, e, r0, half; };

struct TileOrder {
    int nM, nN, nwg, G, c, wgm;
    __device__ __forceinline__ void init(int nM_, int nN_, int G_, int c_, int wgm_ = WGM) { nM = nM_; nN = nN_; nwg = nM * nN; G = G_; c = c_; wgm = wgm_; }
    __device__ __forceinline__ bool map(int i, int& pm, int& pn) const {
        const long L = (long)i * G + c; if (L >= nwg) return false;
        int wgid = (int)L; { const int q = nwg / NXCD, r = nwg % NXCD, xcd = wgid % NXCD, off = wgid / NXCD; wgid = (xcd < r ? xcd * (q + 1) : r * (q + 1) + (xcd - r) * q) + off; }
        const int nig = wgm * nN, gid = wgid / nig, fm = gid * wgm, gsz = (nM - fm) < wgm ? (nM - fm) : wgm;
        pm = fm + ((wgid % nig) % gsz); pn = (wgid % nig) / gsz; return true;
    }
};
struct DenseSched {
    static constexpr bool GATHER = false;
    TileOrder T; const char* A; const char* Bt; int K;
    __device__ __forceinline__ bool next(int i, Unit& u) const { u.e = 0; u.r0 = 0; u.half = 0; return T.map(i, u.pm, u.pn); }
    __device__ __forceinline__ const char* a_base(const Unit& u) const { return A + (size_t)u.pm * 256 * K * 2; }
    __device__ __forceinline__ const char* b_base(const Unit& u) const { return Bt + (size_t)u.pn * 256 * K * 2; }
    __device__ __forceinline__ void a_voff(const Unit&, int tid, unsigned (&v)[2][2]) const {
#pragma unroll
        for (int i = 0; i < 2; ++i) { int R, C; stage_rc(tid * 16 + i * 8192, R, C); v[0][i] = (unsigned)(R * K + C) * 2u; v[1][i] = v[0][i]; }
    }
};
struct GuSched {
    static constexpr bool GATHER = true;
    TileOrder T; const char* A; const char* Bt; const int* slot_tok; const PG8_LAS int* toff; const PG8_LAS int* cnt; const PG8_LAS int* soff; const PG8_LAS int* sexp; int K;
    __device__ __forceinline__ bool next(int i, Unit& u) const {
        if (T.map(i, u.pm, u.pn)) {
            int e = 0;
#pragma unroll
            for (int j = 1; j < 32; ++j) e += (toff[j] <= u.pm) ? 1 : 0;
            u.e = e; u.r0 = (u.pm - toff[e]) * 256; u.half = 0; return true;
        }
        const long sidx = (long)i * T.G + T.c - T.nwg; if (sidx >= 4 * soff[32]) return false;
        const int t = (int)sidx >> 2; u.pn = (int)sidx & 3; u.pm = toff[32] + t; u.e = sexp[t]; u.r0 = (toff[u.e + 1] - toff[u.e]) * 256; u.half = 1; return true;
    }
    __device__ __forceinline__ const char* a_base(const Unit&) const { return A; }
    __device__ __forceinline__ const char* b_base(const Unit& u) const { return Bt + ((size_t)u.e * 1024 + (size_t)u.pn * 256) * K * 2; }
    __device__ __forceinline__ void a_voff(const Unit& u, int tid, unsigned (&v)[2][2]) const {
        const int c1 = cnt[u.e] - 1;
#pragma unroll
        for (int h = 0; h < 2; ++h)
#pragma unroll
            for (int i = 0; i < 2; ++i) { int R, C; stage_rc(tid * 16 + i * 8192, R, C); int idx = u.r0 + h * 128 + R; idx = idx < c1 ? idx : c1;
                const int tok = slot_tok[u.e * 16384 + idx]; v[h][i] = (unsigned)(tok * K + C) * 2u; }
    }
};
struct DnSched {
    static constexpr bool GATHER = false;
    TileOrder T; const char* A; const char* Bt; const PG8_LAS int* toff; const PG8_LAS int* soff; const PG8_LAS int* sexp; int K;
    __device__ __forceinline__ bool next(int i, Unit& u) const {
        u.r0 = 0;
        if (T.map(i, u.pm, u.pn)) {
            int e = 0;
#pragma unroll
            for (int j = 1; j < 32; ++j) e += (toff[j] <= u.pm) ? 1 : 0;
            u.e = e; u.half = 0; return true;
        }
        const long sidx = (long)i * T.G + T.c - T.nwg; if (sidx >= 4 * soff[32]) return false;
        const int t = (int)sidx >> 2; u.pn = (int)sidx & 3; u.pm = toff[32] + t; u.e = sexp[t]; u.half = 1; return true;
    }
    __device__ __forceinline__ const char* a_base(const Unit& u) const { return A + (size_t)u.pm * 256 * K * 2; }
    __device__ __forceinline__ const char* b_base(const Unit& u) const { return Bt + ((size_t)u.e * 1024 + (size_t)u.pn * 256) * K * 2; }
    __device__ __forceinline__ void a_voff(const Unit&, int tid, unsigned (&v)[2][2]) const {
#pragma unroll
        for (int i = 0; i < 2; ++i) { int R, C; stage_rc(tid * 16 + i * 8192, R, C); v[0][i] = (unsigned)(R * K + C) * 2u; v[1][i] = v[0][i]; }
    }
};

typedef __bf16 bf16x2_t __attribute__((ext_vector_type(2)));
__device__ __forceinline__ unsigned cvt_pk_bf16(float lo, float hi) { bf16x2_t v; v[0] = (__bf16)lo; v[1] = (__bf16)hi; return __builtin_bit_cast(unsigned, v); }
__device__ __forceinline__ u32x4 pack8(const f32x4 a, const f32x4 b) { u32x4 w; w.x = cvt_pk_bf16(a[0], a[1]); w.y = cvt_pk_bf16(a[2], a[3]); w.z = cvt_pk_bf16(b[0], b[1]); w.w = cvt_pk_bf16(b[2], b[3]); return w; }

struct EpiStoreBf16 {
    static constexpr bool PERM = true;
    bf16_t* O; int ldc; float sc;
    __device__ __forceinline__ void operator()(const f32x4 (&acc)[2][2][4][2], const Unit& u, int wr, int wc, int fr, int fq) const {
        const int row0 = u.pm * BM + wr * 64 + fr, col0 = u.pn * BM + wc * 32 + 8 * fq;
#pragma unroll
        for (int ai = 0; ai < 2; ++ai) { if (ai == 1 && u.half) break;
#pragma unroll
            for (int m = 0; m < 4; ++m) { bf16_t* rowp = O + (size_t)(row0 + ai * HALF + m * 16) * ldc + col0;
#pragma unroll
                for (int bj = 0; bj < 2; ++bj) *(u32x4*)(rowp + bj * HALF) = pack8(acc[ai][bj][m][0] * sc, acc[ai][bj][m][1] * sc); } }
    }
};
struct EpiConvIn {
    static constexpr bool PERM = true;
    bf16_t* O; int ldc;
    __device__ __forceinline__ void operator()(const f32x4 (&acc)[2][2][4][2], const Unit& u, int wr, int wc, int fr, int fq) const {
        const int row0 = u.pm * BM + wr * 64 + fr;
        if (u.pn < 8) {
            const int col0 = u.pn * HALF + wc * 32 + 8 * fq;
#pragma unroll
            for (int ai = 0; ai < 2; ++ai)
#pragma unroll
                for (int m = 0; m < 4; ++m) { bf16_t* rowp = O + (size_t)(row0 + ai * HALF + m * 16) * ldc + col0;
                    *(u32x4*)rowp = pack8(acc[ai][0][m][0] * acc[ai][1][m][0], acc[ai][0][m][1] * acc[ai][1][m][1]); }
        } else {
            const int col0 = 1024 + (u.pn - 8) * BM + wc * 32 + 8 * fq;
#pragma unroll
            for (int ai = 0; ai < 2; ++ai)
#pragma unroll
                for (int m = 0; m < 4; ++m) { bf16_t* rowp = O + (size_t)(row0 + ai * HALF + m * 16) * ldc + col0;
#pragma unroll
                    for (int bj = 0; bj < 2; ++bj) *(u32x4*)(rowp + bj * HALF) = pack8(acc[ai][bj][m][0], acc[ai][bj][m][1]); }
        }
    }
};
__device__ __forceinline__ float silu_f(float g) { return g * __builtin_amdgcn_rcpf(1.0f + __expf(-g)); }
__device__ __forceinline__ unsigned pk4_fp8(float a, float b, float c, float d) { unsigned w = 0; w = __builtin_amdgcn_cvt_pk_fp8_f32(a, b, w, false); w = __builtin_amdgcn_cvt_pk_fp8_f32(c, d, w, true); return w; }
constexpr float W8_INV = 1.0f / 32.0f;
struct EpiGateUp {
    static constexpr bool PERM = true;
    unsigned char* O;
    __device__ __forceinline__ void operator()(const f32x4 (&acc)[2][2][4][2], const Unit& u, int wr, int wc, int fr, int fq) const {
        const int row0 = u.pm * BM + wr * 64 + fr, col0 = u.pn * HALF + wc * 32 + 8 * fq;
        typedef unsigned u32x2 __attribute__((ext_vector_type(2)));
#pragma unroll
        for (int ai = 0; ai < 2; ++ai) { if (ai == 1 && u.half) break;
#pragma unroll
            for (int m = 0; m < 4; ++m) { unsigned char* rowp = O + (size_t)(row0 + ai * HALF + m * 16) * 512 + col0;
                f32x4 h0, h1;
#pragma unroll
                for (int j = 0; j < 4; ++j) { h0[j] = silu_f(acc[ai][0][m][0][j] * W8_INV) * (acc[ai][1][m][0][j] * W8_INV); h1[j] = silu_f(acc[ai][0][m][1][j] * W8_INV) * (acc[ai][1][m][1][j] * W8_INV); }
                u32x2 w; w.x = pk4_fp8(h0[0], h0[1], h0[2], h0[3]); w.y = pk4_fp8(h1[0], h1[1], h1[2], h1[3]); *(u32x2*)rowp = w; } }
    }
};
struct EpiStoreF8 {
    static constexpr bool PERM = true;
    unsigned char* O; int ldc;
    __device__ __forceinline__ void operator()(const f32x4 (&acc)[2][2][4][2], const Unit& u, int wr, int wc, int fr, int fq) const {
        const int row0 = u.pm * BM + wr * 64 + fr, col0 = u.pn * BM + wc * 32 + 8 * fq;
        typedef unsigned u32x2 __attribute__((ext_vector_type(2)));
#pragma unroll
        for (int ai = 0; ai < 2; ++ai) { if (ai == 1 && u.half) break;
#pragma unroll
            for (int m = 0; m < 4; ++m) { unsigned char* rowp = O + (size_t)(row0 + ai * HALF + m * 16) * ldc + col0;
#pragma unroll
                for (int bj = 0; bj < 2; ++bj) { u32x2 w; w.x = pk4_fp8(acc[ai][bj][m][0][0], acc[ai][bj][m][0][1], acc[ai][bj][m][0][2], acc[ai][bj][m][0][3]);
                    w.y = pk4_fp8(acc[ai][bj][m][1][0], acc[ai][bj][m][1][1], acc[ai][bj][m][1][2], acc[ai][bj][m][1][3]); *(u32x2*)(rowp + bj * HALF) = w; } } }
    }
};
struct EpiResid {
    static constexpr bool PERM = true;
    const float* xin32; bf16_t* xs; const float* gatev;
    __device__ __forceinline__ void operator()(const f32x4 (&acc)[2][2][4][2], const Unit& u, int wr, int wc, int fr, int fq) const {
        const int row0 = u.pm * BM + wr * 64 + fr, col0 = u.pn * BM + wc * 32 + 8 * fq, b = u.pm >> 3;
        f32x4 gv[2][2];
#pragma unroll
        for (int bj = 0; bj < 2; ++bj)
#pragma unroll
            for (int n = 0; n < 2; ++n) gv[bj][n] = *(const f32x4*)(gatev + b * 3072 + col0 + bj * HALF + n * 4);
#pragma unroll
        for (int ai = 0; ai < 2; ++ai)
#pragma unroll
            for (int m = 0; m < 4; ++m) { const size_t off = (size_t)(row0 + ai * HALF + m * 16) * 1024 + col0;
#pragma unroll
                for (int bj = 0; bj < 2; ++bj) {
                    f32x4 x0, x1;
                    if (xin32) { x0 = *(const f32x4*)(xin32 + off + bj * HALF); x1 = *(const f32x4*)(xin32 + off + bj * HALF + 4); }
                    else { const u32x4 w = *(const u32x4*)(xs + off + bj * HALF);
                        x0 = (f32x4){__builtin_bit_cast(float, w.x << 16), __builtin_bit_cast(float, w.x & 0xffff0000u), __builtin_bit_cast(float, w.y << 16), __builtin_bit_cast(float, w.y & 0xffff0000u)};
                        x1 = (f32x4){__builtin_bit_cast(float, w.z << 16), __builtin_bit_cast(float, w.z & 0xffff0000u), __builtin_bit_cast(float, w.w << 16), __builtin_bit_cast(float, w.w & 0xffff0000u)}; }
                    *(u32x4*)(xs + off + bj * HALF) = pack8(x0 + gv[bj][0] * acc[ai][bj][m][0], x1 + gv[bj][1] * acc[ai][bj][m][1]); } }
    }
};

typedef int i32x8 __attribute__((ext_vector_type(8)));
template <class Epi, class Sched, bool ALIGN_EPI, bool FP8 = false>
__device__ __forceinline__ void gemm_phase(PG8_LAS unsigned char* lds, const int K, const Sched& S, const Epi& E) {
    constexpr bool GATHER = Sched::GATHER;
    const int tid = opaque_v((int)threadIdx.x), wid = __builtin_amdgcn_readfirstlane(tid >> 6), lane = tid & 63, wr = wid >> 2, wc = wid & 3, fr = lane & 15, fq = lane >> 4;
    const int nt = opaque_s(K / BK);
    unsigned voffB[2];
#pragma unroll
    for (int i = 0; i < 2; ++i) { int R, C; stage_rc(tid * 16 + i * 8192, R, C); const int Rb = Epi::PERM ? ((R & ~31) + perm32(R & 31)) : R; voffB[i] = (unsigned)(Rb * K + C) * 2u; }
    const size_t kstep = (size_t)(BK * 2);
    const size_t hstepB = (size_t)HALF * K * 2;
    const size_t hstepA = GATHER ? (size_t)0 : hstepB;
    const unsigned ldsw = (unsigned)wid * 1024u;
    const int aoff = lds_byte(wr * 64 + fr, fq * 8), boff = lds_byte(wc * 32 + fr, fq * 8);
#define PG8_SA(b, h) (((b) * 2 + (h)) * HTB)
#define PG8_SB(b, h) ((4 + (b) * 2 + (h)) * HTB)
#define PG8_STAGE(bufoff, gbase, voff) do { _Pragma("unroll") for (int _i = 0; _i < 2; ++_i) \
        __builtin_amdgcn_global_load_lds((const unsigned*)((const char*)(gbase) + (voff)[_i]), (PG8_LAS unsigned*)(lds + (bufoff) + ldsw + _i * 8192), 16, 0, 0); } while (0)
#define PG8_LDA(dst, b, h) do { _Pragma("unroll") for (int m = 0; m < 4; ++m) _Pragma("unroll") for (int k = 0; k < 2; ++k) dst[m][k] = *(const PG8_LAS bf16x8*)(lds + PG8_SA(b, h) + aoff + m * 2048 + k * 1024); } while (0)
#define PG8_LDB(dst, b, h) do { _Pragma("unroll") for (int n = 0; n < 2; ++n) _Pragma("unroll") for (int k = 0; k < 2; ++k) dst[n][k] = *(const PG8_LAS bf16x8*)(lds + PG8_SB(b, h) + boff + n * 2048 + k * 1024); } while (0)
#define PG8_MMA16(ai, bj, At, Bt) do { __builtin_amdgcn_s_setprio(1); _Pragma("unroll") for (int m = 0; m < 4; ++m) _Pragma("unroll") for (int n = 0; n < 2; ++n) _Pragma("unroll") for (int k = 0; k < 2; ++k) \
        acc[ai][bj][m][n] = __builtin_amdgcn_mfma_f32_16x16x32_bf16(Bt[n][k], At[m][k], acc[ai][bj][m][n], 0, 0, 0); __builtin_amdgcn_s_setprio(0); } while (0)
#define PG8_LDA8(dst, b, h) do { _Pragma("unroll") for (int m = 0; m < 4; ++m) { const u32x4 _lo = *(const PG8_LAS u32x4*)(lds + PG8_SA(b, h) + aoff + m * 2048), _hi = *(const PG8_LAS u32x4*)(lds + PG8_SA(b, h) + aoff + m * 2048 + 1024); \
        dst[m] = __builtin_bit_cast(i32x8, __builtin_shufflevector(_lo, _hi, 0, 1, 2, 3, 4, 5, 6, 7)); } } while (0)
#define PG8_LDB8(dst, b, h) do { _Pragma("unroll") for (int n = 0; n < 2; ++n) { const u32x4 _lo = *(const PG8_LAS u32x4*)(lds + PG8_SB(b, h) + boff + n * 2048), _hi = *(const PG8_LAS u32x4*)(lds + PG8_SB(b, h) + boff + n * 2048 + 1024); \
        dst[n] = __builtin_bit_cast(i32x8, __builtin_shufflevector(_lo, _hi, 0, 1, 2, 3, 4, 5, 6, 7)); } } while (0)
#define PG8_MMA8(ai, bj, At, Bt) do { __builtin_amdgcn_s_setprio(1); asm volatile("s_nop 4"); _Pragma("unroll") for (int m = 0; m < 4; ++m) _Pragma("unroll") for (int n = 0; n < 2; ++n) \
        asm volatile("v_mfma_scale_f32_16x16x128_f8f6f4 %0, %1, %2, %0, %3, %3 op_sel_hi:[0,0,0]" : "+v"(acc[ai][bj][m][n]) : "v"(Bt[n]), "v"(At[m]), "v"(scale1)); __builtin_amdgcn_s_setprio(0); } while (0)
#define PG8_XLDA(b, h) do { if constexpr (FP8) PG8_LDA8(At8, b, h); else PG8_LDA(At, b, h); } while (0)
#define PG8_XLDB(w, b, h) do { if constexpr (FP8) PG8_LDB8(B##w##8, b, h); else PG8_LDB(B##w, b, h); } while (0)
#define PG8_XMMA(ai, bj, w) do { if constexpr (FP8) PG8_MMA8(ai, bj, At8, B##w##8); else PG8_MMA16(ai, bj, At, B##w); } while (0)
#define PG8_WAIT_V(n) asm volatile("s_waitcnt vmcnt(" #n ")" ::: "memory")
#define PG8_WAIT_L(n) asm volatile("s_waitcnt lgkmcnt(" #n ")" ::: "memory")
#define PG8_BAR __builtin_amdgcn_s_barrier()
#define PG8_SCHED __builtin_amdgcn_sched_barrier(0)
    Unit cur, nxt; int ui = 0;
    if (!S.next(0, cur)) return;
    f32x4 acc[2][2][4][2];
#pragma unroll
    for (int a = 0; a < 2; ++a)
#pragma unroll
        for (int b = 0; b < 2; ++b)
#pragma unroll
            for (int m = 0; m < 4; ++m)
#pragma unroll
                for (int n = 0; n < 2; ++n) acc[a][b][m][n] = (f32x4){0.f, 0.f, 0.f, 0.f};
    bf16x8 At[4][2], B0[2][2], B1[2][2]; i32x8 At8[4], B08[2], B18[2]; int scale1 = 0x7F7F7F7F; asm volatile("" : "+v"(scale1));
    const char* cA = S.a_base(cur); const char* cB = S.b_base(cur);
    unsigned vc[2][2], vn[2][2];
    S.a_voff(cur, tid, vc);
    PG8_STAGE(PG8_SB(0, 0), cB, voffB); PG8_STAGE(PG8_SB(0, 1), cB + hstepB, voffB); PG8_STAGE(PG8_SA(0, 0), cA, vc[0]); PG8_STAGE(PG8_SA(0, 1), cA + hstepA, vc[1]);
    if (wr == 1) PG8_BAR;
    PG8_WAIT_V(2); PG8_BAR;
    PG8_STAGE(PG8_SB(1, 0), cB + kstep, voffB); PG8_STAGE(PG8_SA(1, 0), cA + kstep, vc[0]); PG8_STAGE(PG8_SB(1, 1), cB + hstepB + kstep, voffB);
    PG8_WAIT_V(6); PG8_BAR;
    for (;;) {
        const bool has_next = S.next(ui + 1, nxt);
        const char* nA = has_next ? S.a_base(nxt) : cA; const char* nB = has_next ? S.b_base(nxt) : cB;
        if (GATHER && has_next) { S.a_voff(nxt, tid, vn); *(PG8_LAS u32x4*)(lds + STAGE_BYTES + tid * 16) = (u32x4){vn[0][0], vn[0][1], vn[1][0], vn[1][1]}; }
#pragma unroll 1
        for (int t = 0; t < nt; t += 2) {
            const bool last = (t == nt - 2);
            const char* a1 = cA + (size_t)(t + 1) * kstep;
            const char* a2 = last ? nA : cA + (size_t)(t + 2) * kstep; const char* b2 = last ? nB : cB + (size_t)(t + 2) * kstep;
            const char* a3 = a2 + kstep; const char* b3 = b2 + kstep;
            unsigned v2[2][2];
#pragma unroll
            for (int h = 0; h < 2; ++h)
#pragma unroll
                for (int i = 0; i < 2; ++i) v2[h][i] = vc[h][i];
            if (GATHER && last && has_next) { const u32x4 pk = *(const PG8_LAS u32x4*)(lds + STAGE_BYTES + tid * 16); v2[0][0] = pk[0]; v2[0][1] = pk[1]; v2[1][0] = pk[2]; v2[1][1] = pk[3]; }
            PG8_XLDB(0, 0, 0); PG8_XLDB(1, 0, 1); PG8_SCHED; PG8_XLDA(0, 0); PG8_STAGE(PG8_SA(1, 1), a1 + hstepA, vc[1]);
            PG8_WAIT_V(8); PG8_WAIT_L(0); PG8_BAR; PG8_XMMA(0, 0, 0); PG8_XMMA(0, 1, 1); PG8_BAR; PG8_SCHED;
            if (!cur.half) PG8_XLDA(0, 1); PG8_STAGE(PG8_SB(0, 0), b2, voffB); PG8_STAGE(PG8_SB(0, 1), b2 + hstepB, voffB); PG8_STAGE(PG8_SA(0, 0), a2, v2[0]);
            PG8_WAIT_V(8); PG8_WAIT_L(0); PG8_BAR; if (!cur.half) { PG8_XMMA(1, 0, 0); PG8_XMMA(1, 1, 1); } PG8_BAR; PG8_SCHED;
            PG8_XLDB(0, 1, 0); PG8_XLDB(1, 1, 1); PG8_SCHED; PG8_XLDA(1, 0); PG8_STAGE(PG8_SA(0, 1), a2 + hstepA, v2[1]);
            PG8_WAIT_V(8); PG8_WAIT_L(0); PG8_BAR; PG8_XMMA(0, 0, 0); PG8_XMMA(0, 1, 1); PG8_BAR; PG8_SCHED;
            if (!cur.half) PG8_XLDA(1, 1); PG8_STAGE(PG8_SB(1, 0), b3, voffB); PG8_STAGE(PG8_SB(1, 1), b3 + hstepB, voffB); PG8_STAGE(PG8_SA(1, 0), a3, v2[0]);
            PG8_WAIT_V(8); PG8_WAIT_L(0); PG8_BAR; if (!cur.half) { PG8_XMMA(1, 0, 0); PG8_XMMA(1, 1, 1); } PG8_BAR; PG8_SCHED;
        }
        if constexpr (ALIGN_EPI) { if (wr == 0) PG8_BAR; }
        if constexpr (FP8) asm volatile("s_nop 15\n\ts_nop 15" ::: "memory");
        E(acc, cur, wr, wc, fr, fq);
        if (!has_next) break;
#pragma unroll
        for (int a = 0; a < 2; ++a)
#pragma unroll
            for (int b = 0; b < 2; ++b)
#pragma unroll
                for (int m = 0; m < 4; ++m)
#pragma unroll
                    for (int n = 0; n < 2; ++n) acc[a][b][m][n] = (f32x4){0.f, 0.f, 0.f, 0.f};
        cur = nxt; cA = nA; cB = nB; ++ui;
        if (GATHER) { const u32x4 pk = *(const PG8_LAS u32x4*)(lds + STAGE_BYTES + tid * 16); vc[0][0] = pk[0]; vc[0][1] = pk[1]; vc[1][0] = pk[2]; vc[1][1] = pk[3]; }
        if constexpr (ALIGN_EPI) { if (wr == 1) PG8_BAR; }
    }
    PG8_WAIT_V(0);
    if constexpr (!ALIGN_EPI) { if (wr == 0) PG8_BAR; }
    PG8_BAR;
#undef PG8_SA
#undef PG8_SB
#undef PG8_STAGE
#undef PG8_LDA
#undef PG8_LDB
#undef PG8_MMA16
#undef PG8_LDA8
#undef PG8_LDB8
#undef PG8_MMA8
#undef PG8_XLDA
#undef PG8_XLDB
#undef PG8_XMMA
#undef PG8_WAIT_V
#undef PG8_WAIT_L
#undef PG8_BAR
#undef PG8_SCHED
}
}

constexpr int NWAVES = 8, NTHR = 512;
constexpr int D = 1024, BATCH = 8, SEQ = 2048, NTOK = BATCH * SEQ, DEPTH = 4;
constexpr int M_HEADS = 4, M_DK = 128, M_DV = 256, M_PROJ = 3080, NPROJ = 3072;
constexpr int N_EXP = 32, D_FF = 512;
constexpr float EPS = 1e-6f;
constexpr int PMAX = 40960;

constexpr size_t MiB = 1u << 20;
constexpr size_t WS_CTL = 0, CTL_ZERO_BYTES = 1 * MiB;
constexpr size_t WS_MOD = 1 * MiB;
constexpr size_t WS_GATES = 2 * MiB;
constexpr size_t WS_TOKPOS = 3 * MiB;
constexpr size_t WS_TOKW = 3 * MiB + 256 * 1024;
constexpr size_t WS_SLOTTOK = 4 * MiB;
constexpr size_t WS_WMIN = 8 * MiB;
constexpr size_t WS_WMOUT = 20 * MiB;
constexpr size_t WS_WSIN = 24 * MiB;
constexpr size_t WS_WSOUT = 36 * MiB;
constexpr size_t WS_WGU = 40 * MiB;
constexpr size_t WS_WDN = 296 * MiB;
constexpr size_t WS_H = 424 * MiB;
constexpr size_t WS_PROJ = 456 * MiB;
constexpr size_t WS_HS = 552 * MiB;
constexpr size_t WS_A2 = 616 * MiB;
constexpr size_t WS_HMID = 648 * MiB;
constexpr size_t WS_YR = 688 * MiB;
constexpr size_t WS_X = 768 * MiB;
constexpr size_t WS_RTAB = 800 * MiB;
constexpr size_t WS_RCS = 805 * MiB;
constexpr size_t WS_END = 806 * MiB;
constexpr int CW_BAR = 4096;
constexpr int CW_CNT = 16384;

constexpr int LDS_BYTES = 163840;
constexpr int LDSCTL_OFF = 163840 - 1024;
constexpr int LC_TOFF = 16, LC_CNT = 64, LC_LCNT = 96, LC_LBASE = 128, LC_SOFF = 160, LC_SEXP = 200;

#define GAS __attribute__((address_space(1)))
#define LAS __attribute__((address_space(3)))
typedef unsigned short bf16;
typedef unsigned v4u __attribute__((ext_vector_type(4)));
typedef unsigned v2u __attribute__((ext_vector_type(2)));
typedef float f32x4 __attribute__((ext_vector_type(4)));
#define LDS_WAIT() asm volatile("s_waitcnt lgkmcnt(0)" ::: "memory")
__device__ __forceinline__ unsigned f2bf(float f) { unsigned u = __builtin_bit_cast(unsigned, f); return (u + 0x7fffu + ((u >> 16) & 1u)) >> 16; }
__device__ __forceinline__ unsigned pk2(float lo, float hi) { return f2bf(lo) | (f2bf(hi) << 16); }
__device__ __forceinline__ float bflo(unsigned w) { return __builtin_bit_cast(float, w << 16); }
__device__ __forceinline__ float bfhi(unsigned w) { return __builtin_bit_cast(float, w & 0xffff0000u); }
__device__ __forceinline__ float wave_sum(float v) {
#pragma unroll
    for (int o = 1; o < 64; o <<= 1) v += __shfl_xor(v, o);
    return v;
}

#define XB_TMO      128
#define XB_XCNT(j)  (256  + 64 * (j))
#define XB_XSUB(j)  (1280 + 64 * (j))
#define XB_XGEN(j)  (2304 + 64 * (j))
#define XB_TOP      3328
#define XB_TOPGEN   3392
#define XCD_BAR_WORDS 3456
#define XB_SPIN_CAP (1u << 18)
__device__ __forceinline__ unsigned xb_ld(unsigned* p)              { return __hip_atomic_load(p, __ATOMIC_RELAXED, __HIP_MEMORY_SCOPE_AGENT); }
__device__ __forceinline__ unsigned xb_add(unsigned* p, unsigned v) { return __hip_atomic_fetch_add(p, v, __ATOMIC_RELAXED, __HIP_MEMORY_SCOPE_AGENT); }
__device__ __forceinline__ unsigned xb_xcc_id() { return (unsigned)__builtin_amdgcn_s_getreg((3 << 11) | 20) & 0xFu; }
#define XB_SPIN(cond, bar) do { unsigned _sp = 0; while (cond) { __builtin_amdgcn_s_sleep(1); \
    if ((++_sp & 255u) == 0u) { if (xb_ld(&(bar)[XB_TMO])) break; if (_sp > XB_SPIN_CAP) { atomicAdd(&(bar)[XB_TMO], 1u); break; } } } } while (0)
struct XcdBarrier { unsigned* bar; unsigned x; volatile LAS unsigned* st; };
__device__ __forceinline__ XcdBarrier xcd_barrier_post(unsigned* bar, volatile LAS unsigned* st) {
    XcdBarrier b; b.bar = bar; b.x = xb_xcc_id(); b.st = st;
    if (threadIdx.x == 0) (void)xb_add(&bar[XB_XCNT(b.x)], 1u);
    return b;
}
__device__ __forceinline__ void xcd_barrier_complete(unsigned* bar, unsigned x, unsigned& nloc, unsigned& nx) {
    const unsigned G = gridDim.x * gridDim.y * gridDim.z;
    unsigned sum, cnt, mine, sp = 0u;
    for (;;) {
        sum = 0u; cnt = 0u; mine = 0u;
#pragma unroll
        for (unsigned j = 0; j < 16; ++j) { const unsigned c = xb_ld(&bar[XB_XCNT(j)]); sum += c; cnt += (c > 0u) ? 1u : 0u; mine = (j == x) ? c : mine; }
        if (sum == G) break;
        __builtin_amdgcn_s_sleep(1);
        if ((++sp & 255u) == 0u) { if (xb_ld(&bar[XB_TMO])) break; if (sp > XB_SPIN_CAP) { atomicAdd(&bar[XB_TMO], 1u); break; } }
    }
    nloc = mine > 0u ? mine : 1u; nx = cnt > 0u ? cnt : 1u;
}
__device__ __forceinline__ void xcd_barrier(const XcdBarrier& b) {
    asm volatile("s_waitcnt vmcnt(0)" ::: "memory");
    __syncthreads();
    if (threadIdx.x == 0) {
        unsigned* bar = b.bar;
        __builtin_amdgcn_s_waitcnt(0);
        unsigned nloc = b.st[0], nx = b.st[1];
        if (nloc == 0u) { xcd_barrier_complete(bar, b.x, nloc, nx); b.st[0] = nloc; b.st[1] = nx; }
        const unsigned old = xb_add(&bar[XB_XSUB(b.x)], 1u);
        const unsigned gen = old / nloc;
        if (old + 1u == (gen + 1u) * nloc) {
            __builtin_amdgcn_fence(__ATOMIC_RELEASE, "agent");
            asm volatile("s_waitcnt vmcnt(0)" ::: "memory");
            const unsigned og = xb_add(&bar[XB_TOP], 1u);
            const unsigned tg = og / nx;
            if (og + 1u == (tg + 1u) * nx) xb_add(&bar[XB_TOPGEN], 1u);
            else XB_SPIN(xb_ld(&bar[XB_TOPGEN]) == tg, bar);
            __builtin_amdgcn_fence(__ATOMIC_ACQUIRE, "agent");
            xb_add(&bar[XB_XGEN(b.x)], 1u);
            asm volatile("s_waitcnt vmcnt(0)" ::: "memory");
        } else {
            XB_SPIN(xb_ld(&bar[XB_XGEN(b.x)]) == gen, bar);
            __builtin_amdgcn_fence(__ATOMIC_ACQUIRE, "agent");
            asm volatile("s_waitcnt vmcnt(0)" ::: "memory");
        }
    }
    __syncthreads();
}

struct Args { const float* in[20]; float* out; unsigned char* ws; int ph_lo, ph_hi; };
enum InIdx { I_X = 0, I_C, I_ADAW, I_ADAB, I_NORMG, I_FINALG, I_MWIN, I_MBG, I_MNORMG, I_MWOUT, I_SWIN, I_SCONVW, I_SWOUT, I_RWG, I_RBG, I_RWE, I_RBE, I_EWG, I_EWU, I_EWD };

struct Frame {
    LAS unsigned char* lds;
    volatile LAS unsigned* LC;
    unsigned* ctl;
    int tid, lane, wave, G;
    float* out; unsigned char* ws;
};
typedef const __attribute__((address_space(4))) Args* KArgs;
__device__ __forceinline__ KArgs kargs() { auto p = __builtin_amdgcn_kernarg_segment_ptr(); asm volatile("" : "+s"(p)); return (KArgs)p; }
template <class T> __device__ __forceinline__ T* as_global(T* p) { __attribute__((address_space(1))) T* q = (__attribute__((address_space(1))) T*)p; asm volatile("" : "+s"(q)); return (T*)q; }
#define KIN(i) (as_global((const float*)kargs()->in[i]))
template <class T> __device__ __forceinline__ T* launder(T* p) { return as_global(p); }

__device__ __forceinline__ Frame fresh(const Frame& F) { Frame P = F; P.tid = pg8::opaque_v(F.tid); P.lane = P.tid & 63; P.wave = __builtin_amdgcn_readfirstlane(P.tid >> 6); P.G = pg8::opaque_s(F.G); return P; }
__device__ __forceinline__ void p_adaln(Frame& F) {
    LAS float* sc = (LAS float*)F.lds;
    LAS float* red = (LAS float*)(F.lds + 32768);
    const float* c = KIN(I_C); const float* adaw = KIN(I_ADAW); const float* adab = KIN(I_ADAB);
    float* mod = (float*)(F.ws + WS_MOD);
    for (int i = F.tid; i < 8192; i += NTHR) { const float v = c[i]; sc[i] = v / (1.0f + __expf(-v)); }
    __syncthreads();
    const int kq = F.lane >> 4, c4 = (F.lane & 15) * 4;
    for (int item = blockIdx.x; item < 8 * 48; item += F.G) {
        const int ls = item / 48, cg = item % 48;
        const float* W = adaw + (size_t)ls * 1024 * 3072 + cg * 64 + c4;
        float acc[8][4];
#pragma unroll
        for (int b = 0; b < 8; ++b) { acc[b][0] = 0.f; acc[b][1] = 0.f; acc[b][2] = 0.f; acc[b][3] = 0.f; }
#pragma unroll 8
        for (int i = 0; i < 32; ++i) {
            const int k = F.wave * 128 + i * 4 + kq;
            const f32x4 w = *(const f32x4*)(W + (size_t)k * 3072);
#pragma unroll
            for (int b = 0; b < 8; ++b) { const float s = sc[b * 1024 + k]; acc[b][0] += s * w[0]; acc[b][1] += s * w[1]; acc[b][2] += s * w[2]; acc[b][3] += s * w[3]; }
        }
#pragma unroll
        for (int b = 0; b < 8; ++b)
#pragma unroll
            for (int j = 0; j < 4; ++j) { float v = acc[b][j]; v += __shfl_xor(v, 16); v += __shfl_xor(v, 32); acc[b][j] = v; }
        if (kq == 0) {
#pragma unroll
            for (int b = 0; b < 8; ++b) *(LAS f32x4*)(red + (F.wave * 8 + b) * 64 + c4) = (f32x4){acc[b][0], acc[b][1], acc[b][2], acc[b][3]};
        }
        __syncthreads();
        { const int b = F.tid >> 6, col = F.tid & 63; float s = 0.f;
#pragma unroll
          for (int w = 0; w < 8; ++w) s += red[(w * 8 + b) * 64 + col];
          mod[((size_t)ls * 8 + b) * 3072 + cg * 64 + col] = s + adab[ls * 3072 + cg * 64 + col]; }
        __syncthreads();
    }
}

__device__ __forceinline__ void tr_item(const float* W, int ldw, bf16* WT, int ldt, LAS float* scr, int lane) {
#pragma unroll 8
    for (int i = 0; i < 32; ++i) { const int kk = 2 * i + (lane >> 5); scr[kk * 33 + (lane & 31)] = W[(size_t)kk * ldw + (lane & 31)]; }
    LDS_WAIT(); asm volatile("" ::: "memory");
    const int c = lane & 7;
#pragma unroll
    for (int j = 0; j < 4; ++j) { const int n = (lane >> 3) + 8 * j; const LAS float* s = scr + (8 * c) * 33 + n;
        v4u o; o.x = pk2(s[0 * 33], s[1 * 33]); o.y = pk2(s[2 * 33], s[3 * 33]); o.z = pk2(s[4 * 33], s[5 * 33]); o.w = pk2(s[6 * 33], s[7 * 33]);
        *(v4u*)(WT + (size_t)n * ldt + 8 * c) = o; }
    LDS_WAIT(); asm volatile("" ::: "memory");
}
__device__ __forceinline__ void tr_item8(const float* W, int ldw, unsigned char* WT, int ldt, LAS float* scr, int lane) {
#pragma unroll 8
    for (int i = 0; i < 64; ++i) { const int kk = 2 * i + (lane >> 5); scr[kk * 33 + (lane & 31)] = W[(size_t)kk * ldw + (lane & 31)] * 32.0f; }
    LDS_WAIT(); asm volatile("" ::: "memory");
    const int n = lane >> 1, kh = (lane & 1) * 64; const LAS float* sp = scr + kh * 33 + n;
    unsigned char* dst = WT + (size_t)n * ldt + kh;
#pragma unroll
    for (int q = 0; q < 4; ++q) { v4u o;
        o.x = pg8::pk4_fp8(sp[(16 * q + 0) * 33], sp[(16 * q + 1) * 33], sp[(16 * q + 2) * 33], sp[(16 * q + 3) * 33]); o.y = pg8::pk4_fp8(sp[(16 * q + 4) * 33], sp[(16 * q + 5) * 33], sp[(16 * q + 6) * 33], sp[(16 * q + 7) * 33]);
        o.z = pg8::pk4_fp8(sp[(16 * q + 8) * 33], sp[(16 * q + 9) * 33], sp[(16 * q + 10) * 33], sp[(16 * q + 11) * 33]); o.w = pg8::pk4_fp8(sp[(16 * q + 12) * 33], sp[(16 * q + 13) * 33], sp[(16 * q + 14) * 33], sp[(16 * q + 15) * 33]);
        *(v4u*)(dst + 16 * q) = o; }
    LDS_WAIT(); asm volatile("" ::: "memory");
}
__device__ __forceinline__ void p_convert(Frame& F) {
    LAS float* scr = (LAS float*)(F.lds + F.wave * 17408);
    const float* in_mwin = KIN(I_MWIN); const float* in_mwout = KIN(I_MWOUT); const float* in_swin = KIN(I_SWIN); const float* in_swout = KIN(I_SWOUT);
    const float* in_ewg = KIN(I_EWG); const float* in_ewu = KIN(I_EWU); const float* in_ewd = KIN(I_EWD);
    const int gw = blockIdx.x * NWAVES + F.wave, NGW = F.G * NWAVES;
    constexpr int I_A = 2 * 16 * 96, I_B = 2 * 16 * 32, I_C2 = I_A, I_D = I_B, I_E = 128 * 8 * 16, I_F = I_E, I_G = 128 * 4 * 32;
    constexpr int NITEMS = I_A + I_B + I_C2 + I_D + I_E + I_F + I_G;
    for (int it = gw; it < NITEMS; it += NGW) {
        int r = it;
        if (r < I_A) { const int j = r / 1536, q = r % 1536, kb = q / 96, nb = q % 96;
            tr_item(in_mwin + (size_t)j * 1024 * M_PROJ + (size_t)kb * 64 * M_PROJ + nb * 32, M_PROJ, (bf16*)(F.ws + WS_WMIN) + (size_t)j * 3072 * 1024 + (size_t)nb * 32 * 1024 + kb * 64, 1024, scr, F.lane); continue; } r -= I_A;
        if (r < I_B) { const int j = r / 512, q = r % 512, kb = q / 32, nb = q % 32;
            tr_item(in_mwout + (size_t)j * 1024 * 1024 + (size_t)kb * 64 * 1024 + nb * 32, 1024, (bf16*)(F.ws + WS_WMOUT) + (size_t)j * 1024 * 1024 + (size_t)nb * 32 * 1024 + kb * 64, 1024, scr, F.lane); continue; } r -= I_B;
        if (r < I_C2) { const int j = r / 1536, q = r % 1536, kb = q / 96, nb = q % 96, n0 = nb * 32;
            int drow; if (n0 < 1024) drow = 2048 + n0; else if (n0 < 2048) { const int cc = n0 - 1024; drow = 256 * (cc >> 7) + (cc & 127); } else { const int cc = n0 - 2048; drow = 256 * (cc >> 7) + 128 + (cc & 127); }
            tr_item(in_swin + (size_t)j * 1024 * 3072 + (size_t)kb * 64 * 3072 + n0, 3072, (bf16*)(F.ws + WS_WSIN) + (size_t)j * 3072 * 1024 + (size_t)drow * 1024 + kb * 64, 1024, scr, F.lane); continue; } r -= I_C2;
        if (r < I_D) { const int j = r / 512, q = r % 512, kb = q / 32, nb = q % 32;
            tr_item(in_swout + (size_t)j * 1024 * 1024 + (size_t)kb * 64 * 1024 + nb * 32, 1024, (bf16*)(F.ws + WS_WSOUT) + (size_t)j * 1024 * 1024 + (size_t)nb * 32 * 1024 + kb * 64, 1024, scr, F.lane); continue; } r -= I_D;
        if (r < I_E + I_F) { const bool up = r >= I_E; if (up) r -= I_E; const int mat = r / 128, q = r % 128, kb = q / 16, nb = q % 16, n0 = nb * 32;
            const int drow = 256 * (n0 >> 7) + (up ? 128 : 0) + (n0 & 127);
            tr_item8((up ? in_ewu : in_ewg) + (size_t)mat * 1024 * 512 + (size_t)kb * 128 * 512 + n0, 512, (unsigned char*)(F.ws + WS_WGU) + (size_t)mat * 1024 * 1024 + (size_t)drow * 1024 + kb * 128, 1024, scr, F.lane); continue; } r -= I_E + I_F;
        { const int mat = r / 128, q = r % 128, kb = q / 32, nb = q % 32;
            tr_item8(in_ewd + (size_t)mat * 512 * 1024 + (size_t)kb * 128 * 1024 + nb * 32, 1024, (unsigned char*)(F.ws + WS_WDN) + (size_t)mat * 1024 * 512 + (size_t)nb * 32 * 512 + kb * 128, 512, scr, F.lane); }
    }
}

__device__ __forceinline__ void moe_tables(Frame& F, int layer) {
    if (F.tid < 64) {
        const int e = F.tid & 31;
        const int c = (int)__hip_atomic_load(F.ctl + CW_CNT + (layer * 32 + e) * 16, __ATOMIC_RELAXED, __HIP_MEMORY_SCOPE_AGENT);
        const int tl = (c + 255) >> 8, rem = c - (tl - 1) * 256;
        const int sm = (tl > 0 && rem <= 128) ? 1 : 0, nb = tl - sm;
        int incb = (F.tid < 32) ? nb : 0, incs = (F.tid < 32) ? sm : 0;
#pragma unroll
        for (int o = 1; o < 32; o <<= 1) { const int vb = __shfl_up(incb, o), vs = __shfl_up(incs, o); if ((F.tid & 63) >= o) { incb += vb; incs += vs; } }
        if (F.tid < 32) { F.LC[LC_TOFF + e] = (unsigned)(incb - nb); F.LC[LC_SOFF + e] = (unsigned)(incs - sm); F.LC[LC_CNT + e] = (unsigned)c;
            if (sm) F.LC[LC_SEXP + (incs - sm)] = (unsigned)e;
            if (e == 31) { F.LC[LC_TOFF + 32] = (unsigned)incb; F.LC[LC_SOFF + 32] = (unsigned)incs; } }
    }
    __syncthreads();
}
__device__ __forceinline__ int moe_slot(Frame& F, int p) {
    const int e = p & 31, pos = p >> 5, k = pos >> 8, b0 = (int)F.LC[LC_TOFF + e], nb = (int)F.LC[LC_TOFF + e + 1] - b0;
    const int tile = (k < nb) ? b0 + k : (int)F.LC[LC_TOFF + 32] + (int)F.LC[LC_SOFF + e];
    return tile * 256 + (pos & 255);
}
__device__ __forceinline__ void p_rtab(Frame& F) {
    constexpr int NC = 36;
    LAS float* gsL = (LAS float*)F.lds; LAS float* shL = gsL + 128; LAS float* r2 = shL + 128;
    const float* MODp = (const float*)(F.ws + WS_MOD);
    for (int job = blockIdx.x; job < 256; job += F.G) {
        const int part = job & 7, tb = job >> 3, l = tb >> 3, b = tb & 7;
        const float* modn = MODp + (size_t)((l * 2 + 1) * 8 + b) * 3072; const float* ng = KIN(I_NORMG) + (l * 2 + 1) * 1024;
        const float* wg = KIN(I_RWG) + (size_t)l * 1024 * 4; const float* we = KIN(I_RWE) + (size_t)l * 1024 * 32;
        if (F.tid < 128) { const int k = part * 128 + F.tid; gsL[F.tid] = ng[k] * (1.0f + modn[1024 + k]); shL[F.tid] = modn[k]; }
        __syncthreads();
        unsigned char* tab = F.ws + WS_RTAB + (size_t)tb * (NC * 4096);
        for (int t = F.tid; t < 16 * NC; t += NTHR) {
            const int n = t % NC, kcl = t / NC, kc = part * 16 + kcl;
            const float* wcol = (n < 4) ? wg + n : we + (n - 4); const int wstr = (n < 4) ? 4 : 32;
            float wv[8];
#pragma unroll
            for (int jj = 0; jj < 8; ++jj) wv[jj] = wcol[(size_t)(8 * kc + jj) * wstr];
            float cs = 0.f, pv[8];
#pragma unroll
            for (int jj = 0; jj < 8; ++jj) { cs += shL[8 * kcl + jj] * wv[jj]; pv[jj] = wv[jj] * gsL[8 * kcl + jj]; }
            v4u hi, lo; unsigned* hp = (unsigned*)&hi; unsigned* lp = (unsigned*)&lo;
#pragma unroll
            for (int e = 0; e < 4; ++e) { const unsigned w2 = pg8::cvt_pk_bf16(pv[2 * e], pv[2 * e + 1]); hp[e] = w2;
                lp[e] = pg8::cvt_pk_bf16(pv[2 * e] - __builtin_bit_cast(float, w2 << 16), pv[2 * e + 1] - __builtin_bit_cast(float, w2 & 0xffff0000u)); }
            *(v4u*)(tab + (kc * NC + n) * 16) = hi; *(v4u*)(tab + NC * 2048 + (kc * NC + n) * 16) = lo;
            r2[kcl * NC + n] = cs;
        }
        __syncthreads();
        if (F.tid < NC) { float sacc = 0.f;
#pragma unroll
            for (int q = 0; q < 16; ++q) sacc += r2[q * NC + F.tid];
            ((float*)(F.ws + WS_RCS))[(tb * 8 + part) * NC + F.tid] = sacc; }
        __syncthreads();
    }
}
template <int NC> __device__ __forceinline__ void wtab_put(LAS unsigned char* base, int k, int n, float v) {
    const unsigned hi = f2bf(v); const unsigned lo = f2bf(v - __builtin_bit_cast(float, hi << 16));
    const int off = ((k >> 3) * NC + n) * 16 + (k & 7) * 2;
    *(LAS unsigned short*)(base + off) = (unsigned short)hi; *(LAS unsigned short*)(base + NC * 2048 + off) = (unsigned short)lo;
}
typedef short rbf16x8 __attribute__((ext_vector_type(8)));
template <bool COMBINE, int AUX, bool FINAL, bool XF32 = false>
__device__ __forceinline__ void row_phase(Frame& F, const void* xsrc_, void* xdst_, const float* modn, const float* ng, const float* modprev, int prev_layer,
                                          const float* auxw0, const float* auxw1, const float* auxb0, const float* auxb1, int layer) {
    constexpr int NC = (AUX == 2) ? 36 : 8, NT = (NC + 15) / 16;
    constexpr int OFF_RINV = 147456, OFF_LOGIT = OFF_RINV + 256, OFF_ROWE = OFF_LOGIT + 64 * 36 * 4, OFF_ROWW = OFF_ROWE + 512, OFF_CB = OFF_ROWW + 512, OFF_R2 = OFF_CB + 256;
    static_assert(OFF_R2 + 14 * 36 * 4 <= LDSCTL_OFF && 64 * 8 * 4 <= 14 * 36 * 4 + 64, "row phase LDS map");
    const int lane = F.lane;
    const float* xsrc32 = (const float*)xsrc_; const bf16* xsrc16 = (const bf16*)xsrc_;
    float* xdst32 = (float*)xdst_; bf16* xdst16 = (bf16*)xdst_;
    if (COMBINE) moe_tables(F, prev_layer);
    const int* tokpos = (const int*)(F.ws + WS_TOKPOS); const float* tokw = (const float*)(F.ws + WS_TOKW);
    const unsigned char* YR = (const unsigned char*)(F.ws + WS_YR);
    bf16* H = (bf16*)(F.ws + WS_H);
    LAS float* rinvL = (LAS float*)(F.lds + OFF_RINV);
    LAS float* logit = (LAS float*)(F.lds + OFF_LOGIT);
    LAS int* rowE = (LAS int*)(F.lds + OFF_ROWE);
    LAS float* rowW = (LAS float*)(F.lds + OFF_ROWW);
    LAS float* cbL = (LAS float*)(F.lds + OFF_CB);
    LAS float* r2 = (LAS float*)(F.lds + OFF_R2);
    int tab_b = -1;
#ifdef SCAN_SELFCHECK
    const float FLAGSCALE = (FINAL && __hip_atomic_load(F.ctl + 64, __ATOMIC_RELAXED, __HIP_MEMORY_SCOPE_AGENT) != 0u) ? 2.0f : 1.0f;
#else
    const float FLAGSCALE = 1.0f;
#endif
#if defined(TPSUB)
    unsigned long long ts0 = __builtin_amdgcn_s_memrealtime(), ts1 = ts0;
#define TS_MARK(k) do { if (AUX == 2) { asm volatile("s_waitcnt vmcnt(0)" ::: "memory"); __syncthreads(); ts1 = __builtin_amdgcn_s_memrealtime(); if (TPSUB == (k) && F.tid == 0) atomicMax(F.ctl + 80, (unsigned)(ts1 - ts0)); ts0 = ts1; } } while (0)
#else
#define TS_MARK(k)
#endif
    for (int rg = blockIdx.x; rg < NTOK / 64; rg += F.G) {
        const int b = rg >> 5;
        if (AUX == 2 && b != tab_b) {
            tab_b = b;
            const unsigned char* tab = F.ws + WS_RTAB + (size_t)(layer * 8 + b) * (NC * 4096);
            v4u tq[18];
#pragma unroll
            for (int i = 0; i < 18; ++i) tq[i] = *(const v4u*)(tab + (size_t)(F.tid + NTHR * i) * 16);
#pragma unroll
            for (int i = 0; i < 18; ++i) *(LAS v4u*)(F.lds + (F.tid + NTHR * i) * 16) = tq[i];
            if (F.tid < NC) { const float* rcs = (const float*)(F.ws + WS_RCS) + (size_t)(layer * 8 + b) * 8 * NC; float sacc = 0.f;
#pragma unroll
                for (int q = 0; q < 8; ++q) sacc += rcs[q * NC + F.tid];
                cbL[F.tid] = sacc; }
            __syncthreads();
        } else if (AUX == 1 && b != tab_b) {
            tab_b = b;
            const float* shp = modn + b * 3072; const float* scp = shp + 1024;
            LAS float* gsL = logit; LAS float* shL = logit + 1024;
            for (int k = F.tid; k < 1024; k += NTHR) { gsL[k] = ng[k] * (1.0f + scp[k]); shL[k] = shp[k]; }
            __syncthreads();
            constexpr int NQ = (AUX == 2) ? 14 : 4, NI = (AUX == 2) ? 10 : 1;
            if (AUX == 1) {
                float cs4[4] = {0.f, 0.f, 0.f, 0.f};
                if (F.tid < 256) { const int kc = F.tid >> 1, c4 = F.tid & 1; f32x4 wq[8];
#pragma unroll
                    for (int jj = 0; jj < 8; ++jj) wq[jj] = *(const f32x4*)(auxw0 + (size_t)(8 * kc + jj) * M_PROJ + NPROJ + 4 * c4);
#pragma unroll
                    for (int e = 0; e < 4; ++e) { float pv[8];
#pragma unroll
                        for (int jj = 0; jj < 8; ++jj) { const int k = 8 * kc + jj; cs4[e] += shL[k] * wq[jj][e]; pv[jj] = wq[jj][e] * gsL[k]; }
                        v4u hi, lo; unsigned* hp = (unsigned*)&hi; unsigned* lp = (unsigned*)&lo;
#pragma unroll
                        for (int q = 0; q < 4; ++q) { const unsigned w2 = pg8::cvt_pk_bf16(pv[2 * q], pv[2 * q + 1]); hp[q] = w2;
                            lp[q] = pg8::cvt_pk_bf16(pv[2 * q] - __builtin_bit_cast(float, w2 << 16), pv[2 * q + 1] - __builtin_bit_cast(float, w2 & 0xffff0000u)); }
                        *(LAS v4u*)(F.lds + (kc * NC + 4 * c4 + e) * 16) = hi; *(LAS v4u*)(F.lds + NC * 2048 + (kc * NC + 4 * c4 + e) * 16) = lo; } }
#pragma unroll
                for (int e = 0; e < 4; ++e) { float t = cs4[e]; t += __shfl_xor(t, 2); t += __shfl_xor(t, 4); t += __shfl_xor(t, 8); t += __shfl_xor(t, 16); t += __shfl_xor(t, 32); cs4[e] = t; }
                if (F.tid < 256 && lane < 2) {
#pragma unroll
                    for (int e = 0; e < 4; ++e) r2[F.wave * NC + 4 * lane + e] = cs4[e]; }
            } else {
            if (F.tid < NQ * NC) {
                const int n = F.tid % NC, kcq = F.tid / NC; float cs = 0.f;
                const float* wcol = (AUX == 1) ? auxw0 + NPROJ + n : ((n < 4) ? auxw0 + n : auxw1 + (n - 4));
                const int wstr = (AUX == 1) ? M_PROJ : ((n < 4) ? 4 : 32);
                constexpr int NB = (NI + 4) / 5;
#pragma unroll 1
                for (int bt = 0; bt < NB; ++bt) {
                    float wv[5][8];
#pragma unroll
                    for (int i = 0; i < 5; ++i) { const int kcr = kcq + NQ * (5 * bt + i); const int kc = kcr < 128 ? kcr : 127; const float* wp = wcol + (size_t)(8 * kc) * wstr;
#pragma unroll
                        for (int jj = 0; jj < 8; ++jj) wv[i][jj] = wp[jj * wstr]; }
#pragma unroll
                    for (int i = 0; i < 5; ++i) { const int kcr = kcq + NQ * (5 * bt + i); const bool valid = kcr < 128 && (5 * bt + i) < NI; const int kc = kcr < 128 ? kcr : 127;
                        float pv[8];
#pragma unroll
                        for (int jj = 0; jj < 8; ++jj) { const int k = 8 * kc + jj; cs += valid ? shL[k] * wv[i][jj] : 0.f; pv[jj] = wv[i][jj] * gsL[k]; }
                        v4u hi, lo; unsigned* hp = (unsigned*)&hi; unsigned* lp = (unsigned*)&lo;
#pragma unroll
                        for (int e = 0; e < 4; ++e) { const unsigned w2 = pg8::cvt_pk_bf16(pv[2 * e], pv[2 * e + 1]); hp[e] = w2;
                            lp[e] = pg8::cvt_pk_bf16(pv[2 * e] - __builtin_bit_cast(float, w2 << 16), pv[2 * e + 1] - __builtin_bit_cast(float, w2 & 0xffff0000u)); }
                        *(LAS v4u*)(F.lds + (kc * NC + n) * 16) = hi; *(LAS v4u*)(F.lds + NC * 2048 + (kc * NC + n) * 16) = lo;
                    }
                }
                r2[kcq * NC + n] = cs;
            }
            }
            __syncthreads();
            if (F.tid < NC) { float sacc = 0.f; for (int q = 0; q < NQ; ++q) sacc += r2[q * NC + F.tid]; cbL[F.tid] = sacc; }
            __syncthreads();
        }
        TS_MARK(1);
        if (AUX == 2 && F.tid < 32) F.LC[LC_LCNT + F.tid] = 0u;
        {
            constexpr int RB = COMBINE ? 2 : 4;
            f32x4 gsv[4], shv[4], gtv[4];
#pragma unroll
            for (int j = 0; j < 4; ++j) {
                const f32x4 g = *((const f32x4*)ng + lane + 64 * j);
                if (FINAL) { gsv[j] = g; shv[j] = (f32x4){0.f, 0.f, 0.f, 0.f}; }
                else { const f32x4 scl = *((const f32x4*)(modn + b * 3072 + 1024) + lane + 64 * j); gsv[j] = g * (1.0f + scl); shv[j] = *((const f32x4*)(modn + b * 3072) + lane + 64 * j); }
                if (COMBINE) gtv[j] = *((const f32x4*)(modprev + b * 3072 + 2048) + lane + 64 * j);
            }
            for (int i0 = 0; i0 < 8; i0 += RB) {
                const int rowb = rg * 64 + F.wave * 8 + i0;
                f32x4 v[RB][4]; unsigned y0[RB][4], y1[RB][4]; float w0[RB], w1[RB];
#pragma unroll
                for (int r = 0; r < RB; ++r) {
#pragma unroll
                    for (int j = 0; j < 4; ++j) {
                        if (XF32) v[r][j] = *((const f32x4*)(xsrc32 + (size_t)(rowb + r) * D) + lane + 64 * j);
                        else { const v2u w = *((const v2u*)(xsrc16 + (size_t)(rowb + r) * D) + lane + 64 * j); v[r][j] = (f32x4){bflo(w.x), bfhi(w.x), bflo(w.y), bfhi(w.y)}; } }
                    if (COMBINE) {
                        const int p0 = __builtin_amdgcn_readfirstlane(tokpos[(rowb + r) * 2]), p1 = __builtin_amdgcn_readfirstlane(tokpos[(rowb + r) * 2 + 1]);
                        w0[r] = tokw[(rowb + r) * 2] * pg8::W8_INV; w1[r] = tokw[(rowb + r) * 2 + 1] * pg8::W8_INV;
                        const int s0 = moe_slot(F, p0), s1 = moe_slot(F, p1);
#pragma unroll
                        for (int j = 0; j < 4; ++j) { y0[r][j] = *((const unsigned*)(YR + (size_t)s0 * D) + lane + 64 * j); y1[r][j] = *((const unsigned*)(YR + (size_t)s1 * D) + lane + 64 * j); }
                    }
                }
#pragma unroll
                for (int r = 0; r < RB; ++r) {
                    const int row = rowb + r;
                    if (COMBINE) {
#pragma unroll
                        for (int j = 0; j < 4; ++j) {
                            v[r][j][0] += gtv[j][0] * (w0[r] * __builtin_amdgcn_cvt_f32_fp8(y0[r][j], 0) + w1[r] * __builtin_amdgcn_cvt_f32_fp8(y1[r][j], 0)); v[r][j][1] += gtv[j][1] * (w0[r] * __builtin_amdgcn_cvt_f32_fp8(y0[r][j], 1) + w1[r] * __builtin_amdgcn_cvt_f32_fp8(y1[r][j], 1));
                            v[r][j][2] += gtv[j][2] * (w0[r] * __builtin_amdgcn_cvt_f32_fp8(y0[r][j], 2) + w1[r] * __builtin_amdgcn_cvt_f32_fp8(y1[r][j], 2)); v[r][j][3] += gtv[j][3] * (w0[r] * __builtin_amdgcn_cvt_f32_fp8(y0[r][j], 3) + w1[r] * __builtin_amdgcn_cvt_f32_fp8(y1[r][j], 3));
                        }
                        if (!FINAL) {
#pragma unroll
                            for (int j = 0; j < 4; ++j) { v2u o; o.x = pk2(v[r][j][0], v[r][j][1]); o.y = pk2(v[r][j][2], v[r][j][3]); *((v2u*)(xdst16 + (size_t)row * D) + lane + 64 * j) = o;
                                v[r][j] = (f32x4){bflo(o.x), bfhi(o.x), bflo(o.y), bfhi(o.y)}; }
                        }
                    }
                    float ss = 0.f;
#pragma unroll
                    for (int j = 0; j < 4; ++j) ss += (v[r][j][0] * v[r][j][0] + v[r][j][1] * v[r][j][1]) + (v[r][j][2] * v[r][j][2] + v[r][j][3] * v[r][j][3]);
                    const float rinv = 1.0f / sqrtf(wave_sum(ss) * (1.0f / D) + EPS);
                    if (FINAL) {
#pragma unroll
                        for (int j = 0; j < 4; ++j) *((f32x4*)(xdst32 + (size_t)row * D) + lane + 64 * j) = v[r][j] * (rinv * FLAGSCALE) * gsv[j];
                    } else {
                        if (AUX != 0 && lane == 0) rinvL[F.wave * 8 + i0 + r] = rinv;
#pragma unroll
                        for (int j = 0; j < 4; ++j) { const f32x4 h = (v[r][j] * rinv) * gsv[j] + shv[j];
                            if (AUX == 2) *((unsigned*)((unsigned char*)H + (size_t)row * D) + lane + 64 * j) = pg8::pk4_fp8(h[0], h[1], h[2], h[3]);
                            else { v2u o; o.x = pk2(h[0], h[1]); o.y = pk2(h[2], h[3]); *((v2u*)(H + (size_t)row * D) + lane + 64 * j) = o; } }
                    }
                }
            }
        }
        TS_MARK(2);
        if (AUX != 0) {
            __syncthreads();
            const int l15 = lane & 15, g4 = lane >> 4, tile = F.wave >> 1, kh = F.wave & 1;
            const int trow = rg * 64 + tile * 16 + l15;
            const float* xr32 = xsrc32 + (size_t)trow * D; const bf16* xr16 = (COMBINE ? (const bf16*)xdst16 : xsrc16) + (size_t)trow * D;
            f32x4 acc[NT];
#pragma unroll
            for (int nt = 0; nt < NT; ++nt) acc[nt] = (f32x4){0.f, 0.f, 0.f, 0.f};
#pragma unroll 8
            for (int ks = kh * 16; ks < kh * 16 + 16; ++ks) {
                const int k0 = 32 * ks + 8 * g4;
                v4u hi, lo = (v4u){0u, 0u, 0u, 0u};
                if (XF32) {
                    const f32x4 x0 = *(const f32x4*)(xr32 + k0), x1 = *(const f32x4*)(xr32 + k0 + 4);
                    const float hv[8] = {x0[0], x0[1], x0[2], x0[3], x1[0], x1[1], x1[2], x1[3]};
                    unsigned* hp = (unsigned*)&hi; unsigned* lp = (unsigned*)&lo;
#pragma unroll
                    for (int e = 0; e < 4; ++e) { const unsigned w2 = pg8::cvt_pk_bf16(hv[2 * e], hv[2 * e + 1]); hp[e] = w2;
                        lp[e] = pg8::cvt_pk_bf16(hv[2 * e] - __builtin_bit_cast(float, w2 << 16), hv[2 * e + 1] - __builtin_bit_cast(float, w2 & 0xffff0000u)); }
                } else hi = *(const v4u*)(xr16 + k0);
                const rbf16x8 Ahi = __builtin_bit_cast(rbf16x8, hi), Alo = __builtin_bit_cast(rbf16x8, lo);
#pragma unroll
                for (int nt = 0; nt < NT; ++nt) {
                    const int n = (16 * nt + l15) < NC ? (16 * nt + l15) : (NC - 1);
                    const LAS unsigned char* tp = F.lds + ((4 * ks + g4) * NC + n) * 16;
                    const rbf16x8 Bhi = *(const LAS rbf16x8*)tp, Blo = *(const LAS rbf16x8*)(tp + NC * 2048);
                    acc[nt] = __builtin_amdgcn_mfma_f32_16x16x32_bf16(Ahi, Bhi, acc[nt], 0, 0, 0);
                    if (XF32) acc[nt] = __builtin_amdgcn_mfma_f32_16x16x32_bf16(Alo, Bhi, acc[nt], 0, 0, 0);
                    acc[nt] = __builtin_amdgcn_mfma_f32_16x16x32_bf16(Ahi, Blo, acc[nt], 0, 0, 0);
                }
            }
            TS_MARK(5);
            if (kh == 1) {
#pragma unroll
                for (int nt = 0; nt < NT; ++nt) { const int n = 16 * nt + l15;
                    if (n < NC) {
#pragma unroll
                        for (int r = 0; r < 4; ++r) logit[(tile * 16 + 4 * g4 + r) * NC + n] = acc[nt][r]; } }
            }
            __syncthreads();
            if (kh == 0) {
#pragma unroll
                for (int nt = 0; nt < NT; ++nt) { const int n = 16 * nt + l15;
                    if (n < NC) {
#pragma unroll
                        for (int r = 0; r < 4; ++r) logit[(tile * 16 + 4 * g4 + r) * NC + n] += acc[nt][r]; } }
            }
            __syncthreads();
        }
        TS_MARK(3);
        if (AUX == 1) {
            if (F.tid < 64) { const int row = rg * 64 + F.tid; const LAS float* lg = logit + F.tid * NC; const float ri = rinvL[F.tid]; float* gp = (float*)(F.ws + WS_GATES) + (size_t)row * 8;
                *(f32x4*)gp = (f32x4){lg[0] * ri + cbL[0], lg[1] * ri + cbL[1], lg[2] * ri + cbL[2], lg[3] * ri + cbL[3]};
                *(f32x4*)(gp + 4) = (f32x4){lg[4] * ri + cbL[4], lg[5] * ri + cbL[5], lg[6] * ri + cbL[6], lg[7] * ri + cbL[7]}; }
            __syncthreads();
        }
        if (AUX == 2) {
            if (F.tid < 64) {
                const LAS float* lg = logit + F.tid * NC; const float ri = rinvL[F.tid];
                float gl[4];
#pragma unroll
                for (int g = 0; g < 4; ++g) gl[g] = lg[g] * ri + cbL[g] + auxb0[g];
                int gs = 0; float gm = gl[0];
#pragma unroll
                for (int g = 1; g < 4; ++g) if (gl[g] > gm) { gm = gl[g]; gs = g; }
                float den = 0.f;
#pragma unroll
                for (int g = 0; g < 4; ++g) den += __expf(gl[g] - gm);
                const float psel = 1.0f / den;
                float el[8];
#pragma unroll
                for (int q = 0; q < 8; ++q) el[q] = lg[4 + gs * 8 + q] * ri + cbL[4 + gs * 8 + q] + auxb1[gs * 8 + q];
                int i1 = 0; float l1 = el[0];
#pragma unroll
                for (int q = 1; q < 8; ++q) if (el[q] > l1) { l1 = el[q]; i1 = q; }
                int i2 = -1; float l2 = -3.0e38f;
#pragma unroll
                for (int q = 0; q < 8; ++q) if (q != i1 && el[q] > l2) { l2 = el[q]; i2 = q; }
                const float ex = __expf(l2 - l1), w1 = psel / (1.0f + ex), w2 = psel * ex / (1.0f + ex);
                rowE[2 * F.tid] = gs * 8 + i1; rowE[2 * F.tid + 1] = gs * 8 + i2; rowW[2 * F.tid] = w1; rowW[2 * F.tid + 1] = w2;
            }
            __syncthreads();
            int e = 0, lp = 0;
            if (F.tid < 128) { e = rowE[F.tid]; lp = (int)__hip_atomic_fetch_add((LAS unsigned*)(F.LC + LC_LCNT + e), 1u, __ATOMIC_RELAXED, __HIP_MEMORY_SCOPE_WORKGROUP); }
            __syncthreads();
            if (F.tid < 32) F.LC[LC_LBASE + F.tid] = __hip_atomic_fetch_add(F.ctl + CW_CNT + (layer * 32 + F.tid) * 16, F.LC[LC_LCNT + F.tid], __ATOMIC_RELAXED, __HIP_MEMORY_SCOPE_AGENT);
            __syncthreads();
            if (F.tid < 128) { const int row = rg * 64 + (F.tid >> 1); const int pos = (int)F.LC[LC_LBASE + e] + lp;
                ((int*)(F.ws + WS_SLOTTOK))[e * 16384 + pos] = row; ((int*)(F.ws + WS_TOKPOS))[row * 2 + (F.tid & 1)] = pos * 32 + e; ((float*)(F.ws + WS_TOKW))[row * 2 + (F.tid & 1)] = rowW[F.tid]; }
            __syncthreads();
        }
        TS_MARK(4);
    }
}

__device__ __forceinline__ float logsigmoid_f(float x) { return x < 0.f ? x - log1pf(__expf(x)) : -log1pf(__expf(-x)); }
__device__ __forceinline__ void p_scan(Frame& F, int j  ) {
    constexpr int QS = 132;
    LAS float* q = (LAS float*)F.lds;
    LAS float* k = q + 64 * QS;
    LAS float* Cm = k + 64 * QS;
    LAS float* vv = Cm + 32 * QS;
    LAS float* vw = vv + 64 * 32;
    LAS float* Sm = vw + 64 * 32;
    LAS float* nn = Sm + 64 * 68;
    LAS float* ga = nn + 128;
    LAS float* gM = ga + 64;
    LAS float* gb = gM + 64;
    LAS float* gden = gb + 64;
    LAS float* gm = gden + 64;
    const bf16* PROJ = (const bf16*)(F.ws + WS_PROJ);
    const float* GATES = (const float*)(F.ws + WS_GATES);
    float* HS = (float*)(F.ws + WS_HS);
    const float* bg = KIN(I_MBG) + j * 8;
    const int tid = F.tid;
    for (int item = blockIdx.x; item < 256; item += F.G) {
        const int b = item >> 5, hd = (item >> 3) & 3, vs = item & 7;
        for (int i = tid; i < 32 * QS; i += NTHR) Cm[i] = 0.f;
        if (tid < 128) nn[tid] = 0.f;
        if (tid == 0) gm[0] = 0.f;
        __syncthreads();
        for (int ch = 0; ch < 32; ++ch) {
            const int row0 = b * SEQ + ch * 64;
            for (int p = tid; p < 2048; p += NTHR) { const int isk = p >> 10, pp = p & 1023, r = pp >> 4, c8 = (pp & 15) * 8;
                const v4u w = *(const v4u*)(PROJ + (size_t)(row0 + r) * NPROJ + isk * 512 + hd * 128 + c8);
                const float sc = isk ? 1.0f : 0.08838834764831845f;
                LAS float* dst = (isk ? k : q) + r * QS + c8;
                *(LAS f32x4*)dst = (f32x4){bflo(w.x) * sc, bfhi(w.x) * sc, bflo(w.y) * sc, bfhi(w.y) * sc};
                *(LAS f32x4*)(dst + 4) = (f32x4){bflo(w.z) * sc, bfhi(w.z) * sc, bflo(w.w) * sc, bfhi(w.w) * sc}; }
            if (tid < 256) { const int r = tid >> 2, c8 = (tid & 3) * 8;
                const v4u w = *(const v4u*)(PROJ + (size_t)(row0 + r) * NPROJ + 1024 + hd * 256 + vs * 32 + c8);
                LAS float* dst = vv + r * 32 + c8;
                *(LAS f32x4*)dst = (f32x4){bflo(w.x), bfhi(w.x), bflo(w.y), bfhi(w.y)}; *(LAS f32x4*)(dst + 4) = (f32x4){bflo(w.z), bfhi(w.z), bflo(w.w), bfhi(w.w)}; }
            if (tid < 64) {
                const float ig = GATES[(size_t)(row0 + tid) * 8 + hd] + bg[hd];
                const float lf = logsigmoid_f(GATES[(size_t)(row0 + tid) * 8 + 4 + hd] + bg[4 + hd]);
                float bc = lf;
#pragma unroll
                for (int o = 1; o < 64; o <<= 1) { const float t = __shfl_up(bc, o); if (tid >= o) bc += t; }
                const float a = ig - bc;
                float pm = a;
#pragma unroll
                for (int o = 1; o < 64; o <<= 1) { const float t = __shfl_up(pm, o); if (tid >= o) pm = fmaxf(pm, t); }
                const float m = gm[0];
                ga[tid] = a; gM[tid] = fmaxf(m, pm); gb[tid] = bc;
            }
            __syncthreads();
            {
                const int s = tid & 63, t0 = (tid >> 6) * 8;
                float acc[8];
#pragma unroll
                for (int i = 0; i < 8; ++i) acc[i] = 0.f;
                for (int d4 = 0; d4 < 32; ++d4) {
                    const f32x4 kv = *(const LAS f32x4*)(k + s * QS + d4 * 4);
#pragma unroll
                    for (int i = 0; i < 8; ++i) { const f32x4 qv = *(const LAS f32x4*)(q + (t0 + i) * QS + d4 * 4); acc[i] += qv[0] * kv[0] + qv[1] * kv[1] + qv[2] * kv[2] + qv[3] * kv[3]; }
                }
                const float as = ga[s];
#pragma unroll
                for (int i = 0; i < 8; ++i) { const int t = t0 + i; Sm[t * 68 + s] = (s <= t) ? acc[i] * __expf(as - gM[t]) : 0.f; }
            }
            __syncthreads();
            {
                const int t = tid >> 3, part = tid & 7; float sden = 0.f, nq = 0.f;
#pragma unroll
                for (int s = 0; s < 8; ++s) sden += Sm[t * 68 + part * 8 + s];
#pragma unroll
                for (int d = 0; d < 16; ++d) nq += nn[part * 16 + d] * q[t * QS + part * 16 + d];
                float tot = sden + __expf(gm[0] - gM[t]) * nq;
                tot += __shfl_xor(tot, 1); tot += __shfl_xor(tot, 2); tot += __shfl_xor(tot, 4);
                if (part == 0) gden[t] = tot;
            }
            __syncthreads();
            {
                const int v = tid & 31, t0 = (tid >> 5) * 4;
                float a1[4] = {0.f, 0.f, 0.f, 0.f}, a2[4] = {0.f, 0.f, 0.f, 0.f};
                for (int s4 = 0; s4 < 16; ++s4) {
                    float vx[4];
#pragma unroll
                    for (int e = 0; e < 4; ++e) vx[e] = vv[(s4 * 4 + e) * 32 + v];
#pragma unroll
                    for (int i = 0; i < 4; ++i) { const f32x4 sv = *(const LAS f32x4*)(Sm + (t0 + i) * 68 + s4 * 4); a1[i] += sv[0] * vx[0] + sv[1] * vx[1] + sv[2] * vx[2] + sv[3] * vx[3]; }
                }
                for (int d4 = 0; d4 < 32; ++d4) {
                    const f32x4 cv = *(const LAS f32x4*)(Cm + v * QS + d4 * 4);
#pragma unroll
                    for (int i = 0; i < 4; ++i) { const f32x4 qv = *(const LAS f32x4*)(q + (t0 + i) * QS + d4 * 4); a2[i] += qv[0] * cv[0] + qv[1] * cv[1] + qv[2] * cv[2] + qv[3] * cv[3]; }
                }
                const float m = gm[0];
#pragma unroll
                for (int i = 0; i < 4; ++i) { const int t = t0 + i; const float Mt = gM[t];
                    const float num = a1[i] + __expf(m - Mt) * a2[i];
                    const float dn = fmaxf(fabsf(gden[t]), __expf(-(gb[t] + Mt)));
                    HS[(size_t)(row0 + t) * D + hd * 256 + vs * 32 + v] = num / dn; }
            }
            for (int p = tid; p < 2048; p += NTHR) { const int s = p >> 5; vw[p] = vv[p] * __expf(ga[s] - gM[63]); }
            __syncthreads();
            {
                const float decay = __expf(gm[0] - gM[63]);
                const int d = tid & 127, v0 = (tid >> 7) * 8;
                float acc[8];
#pragma unroll
                for (int i = 0; i < 8; ++i) acc[i] = decay * Cm[(v0 + i) * QS + d];
                for (int s = 0; s < 64; ++s) {
                    const float kv = k[s * QS + d];
                    const f32x4 w0 = *(const LAS f32x4*)(vw + s * 32 + v0), w1 = *(const LAS f32x4*)(vw + s * 32 + v0 + 4);
                    acc[0] += w0[0] * kv; acc[1] += w0[1] * kv; acc[2] += w0[2] * kv; acc[3] += w0[3] * kv;
                    acc[4] += w1[0] * kv; acc[5] += w1[1] * kv; acc[6] += w1[2] * kv; acc[7] += w1[3] * kv;
                }
                float nacc = 0.f;
                if (tid < 128) { nacc = decay * nn[d]; for (int s = 0; s < 64; ++s) nacc += __expf(ga[s] - gM[63]) * k[s * QS + d]; }
                __syncthreads();
#pragma unroll
                for (int i = 0; i < 8; ++i) Cm[(v0 + i) * QS + d] = acc[i];
                if (tid < 128) nn[d] = nacc;
                if (tid == 0) gm[0] = gb[63] + gM[63];
            }
            __syncthreads();
        }
    }
}

typedef short s16x4 __attribute__((ext_vector_type(4)));
typedef short sbf16x8 __attribute__((ext_vector_type(8)));
#define TR16(p) __builtin_amdgcn_ds_read_tr16_b64_v4i16((LAS s16x4*)(p))
__device__ __forceinline__ sbf16x8 cat4(s16x4 a, s16x4 b) { return __builtin_shufflevector(a, b, 0, 1, 2, 3, 4, 5, 6, 7); }
__device__ __forceinline__ f32x4 mfma16(sbf16x8 a, sbf16x8 b, f32x4 c) { return __builtin_amdgcn_mfma_f32_16x16x32_bf16(a, b, c, 0, 0, 0); }
__device__ __forceinline__ sbf16x8 pack8s(float a0, float a1, float a2, float a3, float a4, float a5, float a6, float a7) {
    v4u w; w.x = pg8::cvt_pk_bf16(a0, a1); w.y = pg8::cvt_pk_bf16(a2, a3); w.z = pg8::cvt_pk_bf16(a4, a5); w.w = pg8::cvt_pk_bf16(a6, a7); return __builtin_bit_cast(sbf16x8, w); }
__device__ __forceinline__ float bf_s(short x) { return __builtin_bit_cast(float, ((unsigned)(unsigned short)x) << 16); }
template <int NSB>
__device__ __forceinline__ void scan_chunk_body(LAS unsigned char* Qs, LAS unsigned char* Ks, LAS unsigned char* Vs, LAS unsigned char* Vw, LAS unsigned char* Cr, LAS unsigned char* Cw,
                                                const LAS float* WS, const LAS float* ETS, const LAS float* WI, const LAS float* EM, const LAS unsigned short* WSB, const LAS float* DEC,
                                                const int ch, const int tb, const int vt, const int w, const int l15, const int g, const int ql, const int pl, f32x4 (&accC)[3], bf16* orow) {
            constexpr int QB = 272, VB = 80;
            const sbf16x8 ones = (sbf16x8){0x3F80, 0x3F80, 0x3F80, 0x3F80, 0x3F80, 0x3F80, 0x3F80, 0x3F80};
            const int tt = tb * 16 + l15;
            sbf16x8 qf[4], kf[NSB][4]; f32x4 wv[NSB];
#pragma unroll
            for (int kd = 0; kd < 4; ++kd) qf[kd] = *(const LAS sbf16x8*)(Qs + (tb * 16 + l15) * QB + (32 * kd + 8 * g) * 2);
#pragma unroll
            for (int kd = 0; kd < 4; ++kd)
#pragma unroll
                for (int sb = 0; sb < NSB; ++sb) kf[sb][kd] = *(const LAS sbf16x8*)(Ks + (sb * 16 + l15) * QB + (32 * kd + 8 * g) * 2);
            const float ets = ETS[ch * 64 + tt];
#pragma unroll
            for (int sb = 0; sb < NSB; ++sb) wv[sb] = *(const LAS f32x4*)(WS + ch * 64 + sb * 16 + 4 * g);
            __builtin_amdgcn_sched_barrier(0);
            f32x4 sacc[NSB]; f32x4 pv = (f32x4){0.f, 0.f, 0.f, 0.f}, qc = pv, qn = pv, psum = pv;
#pragma unroll
            for (int sb = 0; sb < NSB; ++sb) sacc[sb] = (f32x4){0.f, 0.f, 0.f, 0.f};
#pragma unroll
            for (int kd = 0; kd < 4; ++kd) {
#pragma unroll
                for (int sb = 0; sb < NSB; ++sb) sacc[sb] = mfma16(kf[sb][kd], qf[kd], sacc[sb]);
            }
            __builtin_amdgcn_sched_barrier(0);
            sbf16x8 cf[4], nf[4]; s16x4 va[2], vb[2];
#pragma unroll
            for (int ks = 0; ks < 2; ++ks) { va[ks] = TR16(Vs + (32 * ks + 4 * g + ql) * VB + (16 * vt + 4 * pl) * 2); vb[ks] = TR16(Vs + (32 * ks + 16 + 4 * g + ql) * VB + (16 * vt + 4 * pl) * 2); }
#pragma unroll
            for (int kd = 0; kd < 4; ++kd) { cf[kd] = *(const LAS sbf16x8*)(Cr + (16 * vt + l15) * QB + (32 * kd + 8 * g) * 2); nf[kd] = *(const LAS sbf16x8*)(Cr + (32 + l15) * QB + (32 * kd + 8 * g) * 2); }
            const f32x4 wiv = *(const LAS f32x4*)(WI + ch * 64 + tb * 16 + 4 * g), emv = *(const LAS f32x4*)(EM + ch * 64 + tb * 16 + 4 * g);
            __builtin_amdgcn_sched_barrier(0);
            float P[4][4];
#pragma unroll
            for (int sb = 0; sb < 4; ++sb) {
                if (sb < NSB) {
#pragma unroll
                    for (int r = 0; r < 4; ++r) P[sb][r] = ((sb * 16 + 4 * g + r) <= tt) ? sacc[sb < NSB ? sb : 0][r] * wv[sb < NSB ? sb : 0][r] * ets : 0.f;
                } else {
#pragma unroll
                    for (int r = 0; r < 4; ++r) P[sb][r] = 0.f;
                }
            }
#pragma unroll
            for (int ks = 0; ks < 2; ++ks) {
                const sbf16x8 pf = pack8s(P[2 * ks][0], P[2 * ks][1], P[2 * ks][2], P[2 * ks][3], P[2 * ks + 1][0], P[2 * ks + 1][1], P[2 * ks + 1][2], P[2 * ks + 1][3]);
                pv = mfma16(pf, cat4(va[ks], vb[ks]), pv); psum = mfma16(pf, ones, psum);
            }
#pragma unroll
            for (int kd = 0; kd < 4; ++kd) { qc = mfma16(qf[kd], cf[kd], qc); qn = mfma16(qf[kd], nf[kd], qn); }
            __builtin_amdgcn_sched_barrier(0);
            s16x4 k0[2], k1[2], x0[2][2], x1[2][2]; sbf16x8 of[2];
#pragma unroll
            for (int ks = 0; ks < 2; ++ks) {
                const int sr = 32 * ks + 8 * g;
                k0[ks] = TR16(Ks + (sr + ql) * QB + (16 * w + 4 * pl) * 2); k1[ks] = TR16(Ks + (sr + 4 + ql) * QB + (16 * w + 4 * pl) * 2);
#pragma unroll
                for (int v = 0; v < 2; ++v) { x0[ks][v] = TR16(Vw + (sr + ql) * VB + (16 * v + 4 * pl) * 2); x1[ks][v] = TR16(Vw + (sr + 4 + ql) * VB + (16 * v + 4 * pl) * 2); }
                of[ks] = *(const LAS sbf16x8*)(WSB + ch * 64 + sr);
            }
            const float decay = DEC[ch];
            __builtin_amdgcn_sched_barrier(0);
#pragma unroll
            for (int r = 0; r < 4; ++r) { const float den = psum[r] + wiv[r] * qn[r], num = pv[r] + wiv[r] * qc[r]; orow[(size_t)r * D] = (bf16)f2bf(num * __builtin_amdgcn_rcpf(fmaxf(fabsf(den), emv[r]))); }
#pragma unroll
            for (int v = 0; v < 3; ++v) accC[v] = accC[v] * decay;
#pragma unroll
            for (int ks = 0; ks < 2; ++ks) {
                const sbf16x8 kt = cat4(k0[ks], k1[ks]);
#pragma unroll
                for (int v = 0; v < 2; ++v) accC[v] = mfma16(kt, cat4(x0[ks][v], x1[ks][v]), accC[v]);
                accC[2] = mfma16(kt, of[ks], accC[2]);
            }
#pragma unroll
            for (int v = 0; v < 3; ++v) { v2u o; o.x = pg8::cvt_pk_bf16(accC[v][0], accC[v][1]); o.y = pg8::cvt_pk_bf16(accC[v][2], accC[v][3]); *(LAS v2u*)(Cw + (16 * v + l15) * QB + (16 * w + 4 * g) * 2) = o; }
}
__device__ __forceinline__ void p_scan_mfma(Frame& F, int j, bf16* HS) {
    constexpr int QB = 272, VB = 80;
    constexpr int OFF_Q = 0, OFF_K = 2 * 64 * QB, OFF_V = 4 * 64 * QB, OFF_VW = OFF_V + 2 * 64 * VB, OFF_C = OFF_VW + 2 * 64 * VB;
    constexpr int OFF_WS = OFF_C + 2 * 48 * QB, OFF_ETS = OFF_WS + 8192, OFF_WI = OFF_ETS + 8192, OFF_EM = OFF_WI + 8192, OFF_WSB = OFF_EM + 8192, OFF_DEC = OFF_WSB + 4096, OFF_PM63 = OFF_DEC + 128, OFF_B63 = OFF_PM63 + 128;
    static_assert(OFF_B63 + 128 <= LDSCTL_OFF, "scan LDS map");
    LAS unsigned char* L = F.lds;
    const int tid = F.tid, lane = F.lane, w = F.wave, l15 = lane & 15, g = lane >> 4, ql = l15 >> 2, pl = l15 & 3, tb = w & 3, vt = w >> 2;
    LAS float* WS = (LAS float*)(L + OFF_WS); LAS float* ETS = (LAS float*)(L + OFF_ETS); LAS float* WI = (LAS float*)(L + OFF_WI); LAS float* EM = (LAS float*)(L + OFF_EM);
    LAS unsigned short* WSB = (LAS unsigned short*)(L + OFF_WSB); LAS float* DEC = (LAS float*)(L + OFF_DEC); LAS float* PM63 = (LAS float*)(L + OFF_PM63); LAS float* B63 = (LAS float*)(L + OFF_B63);
    const bf16* PROJ = (const bf16*)(F.ws + WS_PROJ);
    const float* GATES = (const float*)(F.ws + WS_GATES);
    const float* bg = KIN(I_MBG) + j * 8;
    const float scale = 0.08838834764831845f;
    const sbf16x8 ones = (sbf16x8){0x3F80, 0x3F80, 0x3F80, 0x3F80, 0x3F80, 0x3F80, 0x3F80, 0x3F80};
    for (int item0 = blockIdx.x; item0 < 256; item0 += F.G) {
        const int item = (((item0 & 7) * 4 + (item0 >> 6)) << 3) | ((item0 >> 3) & 7);
        const int b = item >> 5, hd = (item >> 3) & 3, vs = item & 7;
        const float bi = bg[hd], bfg = bg[4 + hd];
        const bf16* qbase = PROJ + (size_t)(b * SEQ) * NPROJ + hd * 128;
        const bf16* vbase = PROJ + (size_t)(b * SEQ) * NPROJ + 1024 + hd * 256 + vs * 32;
        const float* gbase = GATES + (size_t)(b * SEQ) * 8 + hd;
#ifdef SCAN_ZERO_LDS
        for (int i = tid; i < (OFF_B63 + 128) / 4; i += NTHR) ((LAS unsigned*)L)[i] = 0u;
        __syncthreads();
#endif
        for (int i = tid; i < 48 * QB / 4; i += NTHR) ((LAS unsigned*)(L + OFF_C))[i] = 0u;
#pragma unroll
        for (int cc = 0; cc < 4; ++cc) {
            const int c = 4 * w + cc, pos = c * 64 + lane;
            const float ipre = gbase[(size_t)pos * 8] + bi, lf = logsigmoid_f(gbase[(size_t)pos * 8 + 4] + bfg);
            float bc = lf;
#pragma unroll
            for (int o = 1; o < 64; o <<= 1) { const float t = __shfl_up(bc, o); if (lane >= o) bc += t; }
            const float a = ipre - bc;
            float pm = a;
#pragma unroll
            for (int o = 1; o < 64; o <<= 1) { const float t = __shfl_up(pm, o); if (lane >= o) pm = fmaxf(pm, t); }
            WS[pos] = a; ETS[pos] = bc; WI[pos] = pm;
            if (lane == 63) { PM63[c] = pm; B63[c] = bc; }
        }
        __syncthreads();
        {
            float mw[4] = {0.f, 0.f, 0.f, 0.f}; float mc = 0.f;
#pragma unroll
            for (int c = 0; c < 32; ++c) { if ((c >> 2) == w) mw[c & 3] = mc; mc = B63[c] + fmaxf(mc, PM63[c]); }
#pragma unroll
            for (int cc = 0; cc < 4; ++cc) {
                const int c = 4 * w + cc, pos = c * 64 + lane; const float m_c = mw[cc];
                const float a = WS[pos], bc = ETS[pos], pm = WI[pos];
                const float M63 = fmaxf(m_c, PM63[c]), Mt = fmaxf(m_c, pm);
                const float wsv = __expf(a - M63);
                WS[pos] = wsv; WSB[pos] = (unsigned short)f2bf(wsv); ETS[pos] = __expf(M63 - Mt) * scale; WI[pos] = __expf(m_c - Mt) * scale; EM[pos] = __expf(-(bc + Mt));
                if (lane == 0) DEC[c] = __expf(m_c - M63);
            }
        }
        __syncthreads();
        f32x4 accC[3];
#pragma unroll
        for (int v = 0; v < 3; ++v) accC[v] = (f32x4){0.f, 0.f, 0.f, 0.f};
        const int sr0 = tid >> 4, sc0 = (tid & 15) * 8, svr = (tid >> 2) & 63, svc = (tid & 3) * 8;
        const bf16* gq = qbase + (size_t)sr0 * NPROJ + sc0; const bf16* gv = vbase + (size_t)svr * NPROJ + svc;
        const int lq0 = sr0 * QB + sc0 * 2, lv0 = svr * VB + svc * 2;
        v4u qr[2], kr[2], vr = (v4u){0u, 0u, 0u, 0u};
#pragma unroll
        for (int i = 0; i < 2; ++i) { qr[i] = *(const v4u*)(gq + (size_t)(32 * i) * NPROJ); kr[i] = *(const v4u*)(gq + (size_t)(32 * i) * NPROJ + 512); }
        if (tid < 256) vr = *(const v4u*)gv;
#define SCAN_STAGE(buf, chn) do { \
            _Pragma("unroll") for (int i = 0; i < 2; ++i) { *(LAS v4u*)(L + OFF_Q + (buf) * 64 * QB + lq0 + 32 * i * QB) = qr[i]; *(LAS v4u*)(L + OFF_K + (buf) * 64 * QB + lq0 + 32 * i * QB) = kr[i]; } \
            if (tid < 256) { *(LAS v4u*)(L + OFF_V + (buf) * 64 * VB + lv0) = vr; const float wsr = WS[(chn) * 64 + svr]; \
                v4u sw; sw.x = pg8::cvt_pk_bf16(bflo(vr.x) * wsr, bfhi(vr.x) * wsr); sw.y = pg8::cvt_pk_bf16(bflo(vr.y) * wsr, bfhi(vr.y) * wsr); sw.z = pg8::cvt_pk_bf16(bflo(vr.z) * wsr, bfhi(vr.z) * wsr); sw.w = pg8::cvt_pk_bf16(bflo(vr.w) * wsr, bfhi(vr.w) * wsr); \
                *(LAS v4u*)(L + OFF_VW + (buf) * 64 * VB + lv0) = sw; } } while (0)
        SCAN_STAGE(0, 0);
        __syncthreads();
        bf16* obase = HS + (size_t)(b * SEQ + tb * 16 + 4 * g) * D + hd * 256 + vs * 32 + vt * 16 + l15;
        for (int ch = 0; ch < 32; ++ch) {
            const int cb = ch & 1, nb = cb ^ 1;
            LAS unsigned char* Qs = L + OFF_Q + cb * 64 * QB; LAS unsigned char* Ks = L + OFF_K + cb * 64 * QB; LAS unsigned char* Vs = L + OFF_V + cb * 64 * VB; LAS unsigned char* Vw = L + OFF_VW + cb * 64 * VB;
            LAS unsigned char* Cr = L + OFF_C + cb * 48 * QB; LAS unsigned char* Cw = L + OFF_C + nb * 48 * QB;
            { const size_t nro = (size_t)((ch < 31 ? ch + 1 : ch) * 64) * NPROJ;
#pragma unroll
              for (int i = 0; i < 2; ++i) { qr[i] = *(const v4u*)(gq + nro + (size_t)(32 * i) * NPROJ); kr[i] = *(const v4u*)(gq + nro + (size_t)(32 * i) * NPROJ + 512); }
              if (tid < 256) vr = *(const v4u*)(gv + nro); }
            { bf16* orow = obase + (size_t)(ch * 64) * D;
              if (tb == 0) scan_chunk_body<1>(Qs, Ks, Vs, Vw, Cr, Cw, WS, ETS, WI, EM, WSB, DEC, ch, tb, vt, w, l15, g, ql, pl, accC, orow);
              else if (tb == 1) scan_chunk_body<2>(Qs, Ks, Vs, Vw, Cr, Cw, WS, ETS, WI, EM, WSB, DEC, ch, tb, vt, w, l15, g, ql, pl, accC, orow);
              else if (tb == 2) scan_chunk_body<3>(Qs, Ks, Vs, Vw, Cr, Cw, WS, ETS, WI, EM, WSB, DEC, ch, tb, vt, w, l15, g, ql, pl, accC, orow);
              else scan_chunk_body<4>(Qs, Ks, Vs, Vw, Cr, Cw, WS, ETS, WI, EM, WSB, DEC, ch, tb, vt, w, l15, g, ql, pl, accC, orow); }
#ifdef SCAN_EXTRA_SYNC
            __syncthreads();
#endif
            SCAN_STAGE(nb, (ch < 31 ? ch + 1 : ch));
            __syncthreads();
        }
#undef SCAN_STAGE
    }
}

__device__ __forceinline__ void p_mnorm(Frame& F, int j) {
    const bf16* HS = (const bf16*)(F.ws + WS_HS); const bf16* PROJ = (const bf16*)(F.ws + WS_PROJ); bf16* A2 = (bf16*)(F.ws + WS_A2);
    const float* ng = KIN(I_MNORMG) + j * 1024;
    const int gw = blockIdx.x * NWAVES + F.wave, NGW = F.G * NWAVES, lane = F.lane;
    f32x4 g[4];
#pragma unroll
    for (int hd = 0; hd < 4; ++hd) g[hd] = *((const f32x4*)ng + lane + 64 * hd);
    for (int row0 = gw * 2; row0 < NTOK; row0 += NGW * 2) {
        f32x4 v[2][4]; v2u ow[2][4];
#pragma unroll
        for (int r = 0; r < 2; ++r)
#pragma unroll
            for (int hd = 0; hd < 4; ++hd) { const v2u hw = *((const v2u*)(HS + (size_t)(row0 + r) * D) + lane + 64 * hd); v[r][hd] = (f32x4){bflo(hw.x), bfhi(hw.x), bflo(hw.y), bfhi(hw.y)}; ow[r][hd] = *((const v2u*)(PROJ + (size_t)(row0 + r) * NPROJ + 2048) + lane + 64 * hd); }
#pragma unroll
        for (int r = 0; r < 2; ++r)
#pragma unroll
            for (int hd = 0; hd < 4; ++hd) {
                const f32x4 x = v[r][hd];
                const float ss = wave_sum((x[0] * x[0] + x[1] * x[1]) + (x[2] * x[2] + x[3] * x[3]));
                const float rinv = 1.0f / sqrtf(ss * (1.0f / 256.0f) + EPS);
                const float o0 = bflo(ow[r][hd].x), o1 = bfhi(ow[r][hd].x), o2 = bflo(ow[r][hd].y), o3 = bfhi(ow[r][hd].y);
                f32x4 q;
                q[0] = x[0] * rinv * g[hd][0] * __builtin_amdgcn_rcpf(1.0f + __expf(-o0)); q[1] = x[1] * rinv * g[hd][1] * __builtin_amdgcn_rcpf(1.0f + __expf(-o1));
                q[2] = x[2] * rinv * g[hd][2] * __builtin_amdgcn_rcpf(1.0f + __expf(-o2)); q[3] = x[3] * rinv * g[hd][3] * __builtin_amdgcn_rcpf(1.0f + __expf(-o3));
                v2u o; o.x = pk2(q[0], q[1]); o.y = pk2(q[2], q[3]);
                *((v2u*)(A2 + (size_t)(row0 + r) * D) + lane + 64 * hd) = o;
            }
    }
}

__device__ __forceinline__ void p_conv(Frame& F, int j) {
    const bf16* PROJ = (const bf16*)(F.ws + WS_PROJ); bf16* A2 = (bf16*)(F.ws + WS_A2);
    const float* cw = KIN(I_SCONVW) + (size_t)j * 3 * 1024;
    for (int item = blockIdx.x * NTHR + F.tid; item < (NTOK / 16) * 128; item += F.G * NTHR) {
        const int cg = item & 127, rc = item >> 7, row0 = rc * 16, ch = cg * 8;
        float w0[8], w1[8], w2[8], um2[8], um1[8];
#pragma unroll
        for (int c = 0; c < 8; ++c) { w0[c] = cw[ch + c]; w1[c] = cw[1024 + ch + c]; w2[c] = cw[2048 + ch + c]; um2[c] = 0.f; um1[c] = 0.f; }
        if ((row0 & (SEQ - 1)) != 0) {
            const v4u a = *(const v4u*)(PROJ + (size_t)(row0 - 2) * NPROJ + ch), bq = *(const v4u*)(PROJ + (size_t)(row0 - 1) * NPROJ + ch);
            um2[0] = bflo(a.x); um2[1] = bfhi(a.x); um2[2] = bflo(a.y); um2[3] = bfhi(a.y); um2[4] = bflo(a.z); um2[5] = bfhi(a.z); um2[6] = bflo(a.w); um2[7] = bfhi(a.w);
            um1[0] = bflo(bq.x); um1[1] = bfhi(bq.x); um1[2] = bflo(bq.y); um1[3] = bfhi(bq.y); um1[4] = bflo(bq.z); um1[5] = bfhi(bq.z); um1[6] = bflo(bq.w); um1[7] = bfhi(bq.w);
        }
        for (int r = 0; r < 16; ++r) {
            const v4u uw = *(const v4u*)(PROJ + (size_t)(row0 + r) * NPROJ + ch), gw = *(const v4u*)(PROJ + (size_t)(row0 + r) * NPROJ + 1024 + ch);
            float u0[8], g[8], y[8];
            u0[0] = bflo(uw.x); u0[1] = bfhi(uw.x); u0[2] = bflo(uw.y); u0[3] = bfhi(uw.y); u0[4] = bflo(uw.z); u0[5] = bfhi(uw.z); u0[6] = bflo(uw.w); u0[7] = bfhi(uw.w);
            g[0] = bflo(gw.x); g[1] = bfhi(gw.x); g[2] = bflo(gw.y); g[3] = bfhi(gw.y); g[4] = bflo(gw.z); g[5] = bfhi(gw.z); g[6] = bflo(gw.w); g[7] = bfhi(gw.w);
#pragma unroll
            for (int c = 0; c < 8; ++c) { y[c] = g[c] * (w0[c] * um2[c] + w1[c] * um1[c] + w2[c] * u0[c]); um2[c] = um1[c]; um1[c] = u0[c]; }
            v4u o; o.x = pk2(y[0], y[1]); o.y = pk2(y[2], y[3]); o.z = pk2(y[4], y[5]); o.w = pk2(y[6], y[7]);
            *(v4u*)(A2 + (size_t)(row0 + r) * D + ch) = o;
        }
    }
}

constexpr int N_STEPS = 2 + 2 * (8 + 7);
__global__ void __launch_bounds__(NTHR, 2) trunk_fwd(Args args) {
    extern __shared__ __attribute__((aligned(16))) unsigned char lds_raw[];
    Frame F;
    F.lds = (LAS unsigned char*)lds_raw;
    F.LC = (volatile LAS unsigned*)(F.lds + LDSCTL_OFF);
    F.tid = threadIdx.x; F.lane = F.tid & 63; F.wave = __builtin_amdgcn_readfirstlane(F.tid >> 6); F.G = gridDim.x;
    F.out = as_global(args.out); F.ws = as_global(args.ws); F.ctl = as_global((unsigned*)(args.ws + WS_CTL));
    for (int u = F.tid; u < 256; u += NTHR) F.LC[u] = 0u;
    __syncthreads();
    if (!N_LAUNCH_SPLIT) (void)xcd_barrier_post(F.ctl + CW_BAR, F.LC);
    const int lo = N_LAUNCH_SPLIT ? args.ph_lo : 0, hi = N_LAUNCH_SPLIT ? args.ph_hi : N_STEPS;
    int step = 0;
#ifndef EN_MASK
#define EN_MASK 0xFFFFFFFFu
#endif
#define EN(k) (((EN_MASK) >> (k)) & 1u)
#ifndef OUTPROJ_WGM
#define OUTPROJ_WGM 4
#endif
#ifndef INPROJ_WGM
#define INPROJ_WGM 4
#endif
#ifndef MOE_WGM
#define MOE_WGM 4
#endif
#ifndef BAR_REP
#define BAR_REP 0
#endif
#ifndef REP_MASK
#define REP_MASK 0u
#endif
#define REP(k) for (int _r = 0; _r < 1 + (int)(((REP_MASK) >> (k)) & 1u); ++_r)
#define IN_STEP() (lo <= step && step < hi)
#ifdef TPROBE
    int tp_cur = -1; unsigned long long tp_t0 = 0;
#define TP0(k) tp_cur = (k); if (TPROBE == (k)) tp_t0 = __builtin_amdgcn_s_memrealtime();
#define TP_PRE() unsigned long long _t1 = 0; if (tp_cur == TPROBE) { asm volatile("s_waitcnt vmcnt(0)" ::: "memory"); __syncthreads(); _t1 = __builtin_amdgcn_s_memrealtime(); \
        if (TPMODE == 0 && threadIdx.x == 0) atomicMax(F.ctl + 80, (unsigned)(_t1 - tp_t0)); }
#define TP_POST() if (tp_cur == TPROBE && TPMODE != 0 && threadIdx.x == 0) { const unsigned d = (unsigned)(__builtin_amdgcn_s_memrealtime() - _t1); atomicMax(F.ctl + 80, TPMODE == 1 ? 0x40000000u - d : d); }
#else
#define TP0(k)
#define TP_PRE()
#define TP_POST()
#endif
#define END_STEP() do { TP_PRE(); if (!N_LAUNCH_SPLIT) { XcdBarrier _b; _b.bar = (unsigned*)launder(F.ws) + CW_BAR; _b.x = xb_xcc_id(); _b.st = F.LC; xcd_barrier(_b); if (BAR_REP) xcd_barrier(_b); } TP_POST(); ++step; } while (0)
#define X (launder(F.out))
#define WSB (launder(F.ws))
#define XS ((bf16*)(WSB + WS_X))
#define MOD ((const float*)(WSB + WS_MOD))
#define H ((bf16*)(WSB + WS_H))
#define PROJ ((bf16*)(WSB + WS_PROJ))
#define A2 ((bf16*)(WSB + WS_A2))

    TP0(0) if (EN(0) && IN_STEP()) { Frame P = fresh(F); REP(15) { p_adaln(P); __syncthreads(); } REP(0) { p_convert(P); } } END_STEP();
    TP0(1) if (EN(1) && IN_STEP()) REP(1) { Frame P = fresh(F); p_rtab(P); row_phase<false, 1, false, true>(P, KIN(I_X), nullptr, MOD, KIN(I_NORMG), nullptr, 0, KIN(I_MWIN), nullptr, nullptr, nullptr, 0); } END_STEP();

    for (int l = 0; l < DEPTH; ++l) {
        const int lp = l >> 1;
        if ((l & 1) == 0) {
            TP0(2) if (EN(2) && IN_STEP()) REP(2) { pg8::DenseSched S; S.T.init(NTOK / 256, NPROJ / 256, pg8::opaque_s(F.G), pg8::opaque_s((int)blockIdx.x), INPROJ_WGM); S.A = (const char*)H; S.Bt = (const char*)(WSB + WS_WMIN) + (size_t)lp * 3072 * 1024 * 2; S.K = 1024;
                pg8::EpiStoreBf16 E{PROJ, NPROJ, 1.0f}; pg8::gemm_phase<pg8::EpiStoreBf16, pg8::DenseSched, true>(F.lds, 1024, S, E); } END_STEP();
            TP0(3) if (EN(3) && IN_STEP()) REP(3) { Frame P = fresh(F); p_scan_mfma(P, lp, (bf16*)(P.ws + WS_HS));
#ifdef SCAN_SELFCHECK
                { float* H1 = (float*)(P.ws + WS_HMID); float* H2 = (float*)(P.ws + WS_END);
                  __syncthreads(); p_scan_mfma(P, lp, H1); __syncthreads(); p_scan_mfma(P, lp, H2); asm volatile("s_waitcnt vmcnt(0)" ::: "memory"); __syncthreads();
                  for (int item = blockIdx.x; item < 256; item += P.G) { const int b = item >> 5, hd = (item >> 3) & 3, vs = item & 7; int bad = 0;
                      for (int i = P.tid; i < 2048 * 32; i += NTHR) { const size_t o = (size_t)(b * SEQ + (i >> 5)) * D + hd * 256 + vs * 32 + (i & 31);
                          const unsigned a1 = __hip_atomic_load((const unsigned*)H1 + o, __ATOMIC_RELAXED, __HIP_MEMORY_SCOPE_AGENT), a2 = __hip_atomic_load((const unsigned*)H2 + o, __ATOMIC_RELAXED, __HIP_MEMORY_SCOPE_AGENT); if (a1 != a2) bad = 1; }
                      if (bad) __hip_atomic_fetch_or(P.ctl + 64, 1u, __ATOMIC_RELAXED, __HIP_MEMORY_SCOPE_AGENT); } }
#endif
#ifdef SCAN_BOTH
                __syncthreads(); p_scan(P, lp);
#endif
            } END_STEP();
            TP0(4) if (EN(4) && IN_STEP()) REP(4) { Frame P = fresh(F); p_mnorm(P, lp); } END_STEP();
            TP0(5) if (EN(5) && IN_STEP()) REP(5) { pg8::DenseSched S; S.T.init(NTOK / 256, 4, pg8::opaque_s(F.G), pg8::opaque_s((int)blockIdx.x), OUTPROJ_WGM); S.A = (const char*)A2; S.Bt = (const char*)(WSB + WS_WMOUT) + (size_t)lp * 1024 * 1024 * 2; S.K = 1024;
                pg8::EpiResid E{l == 0 ? KIN(I_X) : (const float*)nullptr, XS, MOD + (size_t)(l * 2) * 8 * 3072 + 2048}; pg8::gemm_phase<pg8::EpiResid, pg8::DenseSched, true>(F.lds, 1024, S, E); } END_STEP();
        } else {
            TP0(10) if (EN(10) && IN_STEP()) REP(10) { pg8::DenseSched S; S.T.init(NTOK / 256, NPROJ / 256, pg8::opaque_s(F.G), pg8::opaque_s((int)blockIdx.x), INPROJ_WGM); S.A = (const char*)H; S.Bt = (const char*)(WSB + WS_WSIN) + (size_t)lp * 3072 * 1024 * 2; S.K = 1024;
                pg8::EpiConvIn E{PROJ, NPROJ}; pg8::gemm_phase<pg8::EpiConvIn, pg8::DenseSched, true>(F.lds, 1024, S, E); } END_STEP();
            TP0(11) if (EN(11) && IN_STEP()) REP(11) { Frame P = fresh(F); p_conv(P, lp); } END_STEP();
            TP0(12) if (EN(12) && IN_STEP()) REP(12) { pg8::DenseSched S; S.T.init(NTOK / 256, 4, pg8::opaque_s(F.G), pg8::opaque_s((int)blockIdx.x), OUTPROJ_WGM); S.A = (const char*)A2; S.Bt = (const char*)(WSB + WS_WSOUT) + (size_t)lp * 1024 * 1024 * 2; S.K = 1024;
                pg8::EpiResid E{nullptr, XS, MOD + (size_t)(l * 2) * 8 * 3072 + 2048}; pg8::gemm_phase<pg8::EpiResid, pg8::DenseSched, true>(F.lds, 1024, S, E); } END_STEP();
        }
        TP0(6) if (EN(6) && IN_STEP()) REP(6) { Frame P = fresh(F); row_phase<false, 2, false>(P, XS, nullptr, MOD + (size_t)(l * 2 + 1) * 8 * 3072, KIN(I_NORMG) + (l * 2 + 1) * 1024, nullptr, 0,
                                                  KIN(I_RWG) + (size_t)l * 1024 * 4, KIN(I_RWE) + (size_t)l * 1024 * 32, KIN(I_RBG) + l * 4, KIN(I_RBE) + l * 32, l + 4 * _r); } END_STEP();
        TP0(7) if (EN(7) && IN_STEP()) REP(7) { Frame P = fresh(F); moe_tables(P, l); pg8::GuSched S; S.T.init((int)F.LC[LC_TOFF + 32], 4, pg8::opaque_s(F.G), pg8::opaque_s((int)blockIdx.x), MOE_WGM); S.A = (const char*)H; S.K = 512; S.Bt = (const char*)(WSB + WS_WGU) + (size_t)l * 32 * 1024 * 1024;
            S.slot_tok = (const int*)(WSB + WS_SLOTTOK); S.toff = (const PG8_LAS int*)(F.lds + LDSCTL_OFF + LC_TOFF * 4); S.cnt = (const PG8_LAS int*)(F.lds + LDSCTL_OFF + LC_CNT * 4); S.soff = (const PG8_LAS int*)(F.lds + LDSCTL_OFF + LC_SOFF * 4); S.sexp = (const PG8_LAS int*)(F.lds + LDSCTL_OFF + LC_SEXP * 4);
            pg8::EpiGateUp E{(unsigned char*)(WSB + WS_HMID)}; pg8::gemm_phase<pg8::EpiGateUp, pg8::GuSched, true, true>(F.lds, 512, S, E); } END_STEP();
        TP0(8) if (EN(8) && IN_STEP()) REP(8) { Frame P = fresh(F); moe_tables(P, l); pg8::DnSched S; S.T.init((int)F.LC[LC_TOFF + 32], 4, pg8::opaque_s(F.G), pg8::opaque_s((int)blockIdx.x), MOE_WGM); S.A = (const char*)(WSB + WS_HMID); S.K = 256; S.Bt = (const char*)(WSB + WS_WDN) + (size_t)l * 32 * 1024 * 512;
            S.toff = (const PG8_LAS int*)(F.lds + LDSCTL_OFF + LC_TOFF * 4); S.soff = (const PG8_LAS int*)(F.lds + LDSCTL_OFF + LC_SOFF * 4); S.sexp = (const PG8_LAS int*)(F.lds + LDSCTL_OFF + LC_SEXP * 4);
            pg8::EpiStoreF8 E{(unsigned char*)(WSB + WS_YR), 1024}; pg8::gemm_phase<pg8::EpiStoreF8, pg8::DnSched, true, true>(F.lds, 256, S, E); } END_STEP();
        if (l == 3) {
            TP0(14) if (EN(14) && IN_STEP()) REP(14) { Frame P = fresh(F); row_phase<true, 0, true>(P, XS, X, nullptr, KIN(I_FINALG), MOD + (size_t)(l * 2 + 1) * 8 * 3072, l, nullptr, nullptr, nullptr, nullptr, 0); } ++step;
        } else if (l == 1) {
            TP0(13) if (EN(13) && IN_STEP()) REP(13) { Frame P = fresh(F); row_phase<true, 1, false>(P, XS, XS, MOD + (size_t)((l + 1) * 2) * 8 * 3072, KIN(I_NORMG) + ((l + 1) * 2) * 1024, MOD + (size_t)(l * 2 + 1) * 8 * 3072, l,
                                                     KIN(I_MWIN) + (size_t)1 * 1024 * M_PROJ, nullptr, nullptr, nullptr, 0); } END_STEP();
        } else {
            TP0(9) if (EN(9) && IN_STEP()) REP(9) { Frame P = fresh(F); row_phase<true, 0, false>(P, XS, XS, MOD + (size_t)((l + 1) * 2) * 8 * 3072, KIN(I_NORMG) + ((l + 1) * 2) * 1024, MOD + (size_t)(l * 2 + 1) * 8 * 3072, l, nullptr, nullptr, nullptr, nullptr, 0); } END_STEP();
        }
    }
#if defined(TPROBE) || defined(TPSUB)
#ifndef TPMODE
#define TPMODE 0
#endif
    __syncthreads();
    if (blockIdx.x == 0 && threadIdx.x == 0) { asm volatile("s_waitcnt vmcnt(0)" ::: "memory"); unsigned d = __hip_atomic_load(F.ctl + 80, __ATOMIC_RELAXED, __HIP_MEMORY_SCOPE_AGENT); if (TPMODE == 1) d = 0x40000000u - d;
        F.out[0] = (float)d * (0.01f / (float)(TPSCALE)); }
#endif
#undef IN_STEP
#undef END_STEP
#undef X
#undef WSB
#undef XS
#undef MOD
#undef H
#undef PROJ
#undef A2
}

extern "C" void kernel_launch(void* const* d_in, const int* in_sizes, int n_in, void* d_out, int out_size, void* d_ws, size_t ws_size, hipStream_t stream) {
    static int grid = 0;
    if (grid == 0) {
        if (n_in != 20 || in_sizes[0] != NTOK * D || out_size != NTOK * D || ws_size < WS_END) { fprintf(stderr, "kernel_launch: unexpected shapes (n_in %d, ws %zu)\n", n_in, ws_size); grid = -1; return; }
        int dev = 0, cus = 0, per_cu = 0;
        if (hipGetDevice(&dev) != hipSuccess || hipDeviceGetAttribute(&cus, hipDeviceAttributeMultiprocessorCount, dev) != hipSuccess) { grid = -1; return; }
        if (hipFuncSetAttribute((const void*)trunk_fwd, hipFuncAttributeMaxDynamicSharedMemorySize, LDS_BYTES) != hipSuccess) { fprintf(stderr, "kernel_launch: hipFuncSetAttribute failed\n"); grid = -1; return; }
        if (hipOccupancyMaxActiveBlocksPerMultiprocessor(&per_cu, (const void*)trunk_fwd, NTHR, LDS_BYTES) != hipSuccess || per_cu < 1) fprintf(stderr, "kernel_launch: occupancy query reports %d\n", per_cu);
        (void)hipGetLastError();
        grid = cus;
    }
    if (grid < 0) return;
    if (hipMemsetAsync((char*)d_ws + WS_CTL, 0, CTL_ZERO_BYTES, stream) != hipSuccess) return;
    Args a{};
    for (int i = 0; i < 20; ++i) a.in[i] = (const float*)d_in[i];
    a.out = (float*)d_out; a.ws = (unsigned char*)d_ws;
    if (N_LAUNCH_SPLIT) {
        for (int s = 0; s < N_STEPS; ++s) { a.ph_lo = s; a.ph_hi = s + 1; hipLaunchKernelGGL(trunk_fwd, dim3(grid), dim3(NTHR), LDS_BYTES, stream, a); }
    } else {
        a.ph_lo = 0; a.ph_hi = N_STEPS; hipLaunchKernelGGL(trunk_fwd, dim3(grid), dim3(NTHR), LDS_BYTES, stream, a);
    }
}
```

```cpp
#include <hip/hip_runtime.h>
#include <cstdio>
#include <cstdint>

#ifndef SCAN_MFMA
#define SCAN_MFMA 1
#endif
#ifndef N_LAUNCH_SPLIT
#define N_LAUNCH_SPLIT 0
#endif

namespace pg8 {
#define PG8_LAS __attribute__((address_space(3)))
typedef unsigned short bf16_t;
typedef short bf16x8 __attribute__((ext_vector_type(8)));
typedef float f32x4 __attribute__((ext_vector_type(4)));
typedef unsigned u32x4 __attribute__((ext_vector_type(4)));
constexpr int BM = 256, BK = 64, HALF = 128, HTB = HALF * BK * 2, STAGE_BYTES = 8 * HTB, NXCD = 8, WGM = 8;

__host__ __device__ __forceinline__ int lds_byte(int r, int c) { const int st = (r >> 4) * 2 + (c >> 5), rr = r & 15, cc = c & 31, ob = rr * 64 + cc * 2; return st * 1024 + (ob ^ (((ob >> 9) & 1) << 5)); }
__host__ __device__ __forceinline__ void stage_rc(int b, int& R, int& C) { const int st = b / 1024, sb = b % 1024, swz = sb ^ (((sb >> 9) & 1) << 5); R = (st >> 1) * 16 + swz / 64; C = (st & 1) * 32 + (swz % 64) / 2; }
__host__ __device__ __forceinline__ int perm32(int rho) { const int n = rho >> 4, i = rho & 15; return 8 * (i >> 2) + 4 * n + (i & 3); }

__device__ __forceinline__ int opaque_v(int x) { asm volatile("" : "+v"(x)); return x; }
__device__ __forceinline__ int opaque_s(int x) { asm volatile("" : "+s"(x)); return x; }
struct Unit { int pm, pn, e, r0, half; };

struct TileOrder {
    int nM, nN, nwg, G, c, wgm;
    __device__ __forceinline__ void init(int nM_, int nN_, int G_, int c_, int wgm_ = WGM) { nM = nM_; nN = nN_; nwg = nM * nN; G = G_; c = c_; wgm = wgm_; }
    __device__ __forceinline__ bool map(int i, int& pm, int& pn) const {
        const long L = (long)i * G + c; if (L >= nwg) return false;
        int wgid = (int)L; { const int q = nwg / NXCD, r = nwg % NXCD, xcd = wgid % NXCD, off = wgid / NXCD; wgid = (xcd < r ? xcd * (q + 1) : r * (q + 1) + (xcd - r) * q) + off; }
        const int nig = wgm * nN, gid = wgid / nig, fm = gid * wgm, gsz = (nM - fm) < wgm ? (nM - fm) : wgm;
        pm = fm + ((wgid % nig) % gsz); pn = (wgid % nig) / gsz; return true;
    }
};
struct DenseSched {
    static constexpr bool GATHER = false;
    TileOrder T; const char* A; const char* Bt; int K;
    __device__ __forceinline__ bool next(int i, Unit& u) const { u.e = 0; u.r0 = 0; u.half = 0; return T.map(i, u.pm, u.pn); }
    __device__ __forceinline__ const char* a_base(const Unit& u) const { return A + (size_t)u.pm * 256 * K * 2; }
    __device__ __forceinline__ const char* b_base(const Unit& u) const { return Bt + (size_t)u.pn * 256 * K * 2; }
    __device__ __forceinline__ void a_voff(const Unit&, int tid, unsigned (&v)[2][2]) const {
#pragma unroll
        for (int i = 0; i < 2; ++i) { int R, C; stage_rc(tid * 16 + i * 8192, R, C); v[0][i] = (unsigned)(R * K + C) * 2u; v[1][i] = v[0][i]; }
    }
};
struct GuSched {
    static constexpr bool GATHER = true;
    TileOrder T; const char* A; const char* Bt; const int* slot_tok; const PG8_LAS int* toff; const PG8_LAS int* cnt; const PG8_LAS int* soff; const PG8_LAS int* sexp; int K;
    __device__ __forceinline__ bool next(int i, Unit& u) const {
        if (T.map(i, u.pm, u.pn)) {
            int e = 0;
#pragma unroll
            for (int j = 1; j < 32; ++j) e += (toff[j] <= u.pm) ? 1 : 0;
            u.e = e; u.r0 = (u.pm - toff[e]) * 256; u.half = 0; return true;
        }
        const long sidx = (long)i * T.G + T.c - T.nwg; if (sidx >= 4 * soff[32]) return false;
        const int t = (int)sidx >> 2; u.pn = (int)sidx & 3; u.pm = toff[32] + t; u.e = sexp[t]; u.r0 = (toff[u.e + 1] - toff[u.e]) * 256; u.half = 1; return true;
    }
    __device__ __forceinline__ const char* a_base(const Unit&) const { return A; }
    __device__ __forceinline__ const char* b_base(const Unit& u) const { return Bt + ((size_t)u.e * 1024 + (size_t)u.pn * 256) * K * 2; }
    __device__ __forceinline__ void a_voff(const Unit& u, int tid, unsigned (&v)[2][2]) const {
        const int c1 = cnt[u.e] - 1;
#pragma unroll
        for (int h = 0; h < 2; ++h)
#pragma unroll
            for (int i = 0; i < 2; ++i) { int R, C; stage_rc(tid * 16 + i * 8192, R, C); int idx = u.r0 + h * 128 + R; idx = idx < c1 ? idx : c1;
                const int tok = slot_tok[u.e * 16384 + idx]; v[h][i] = (unsigned)(tok * K + C) * 2u; }
    }
};
struct DnSched {
    static constexpr bool GATHER = false;
    TileOrder T; const char* A; const char* Bt; const PG8_LAS int* toff; const PG8_LAS int* soff; const PG8_LAS int* sexp; int K;
    __device__ __forceinline__ bool next(int i, Unit& u) const {
        u.r0 = 0;
        if (T.map(i, u.pm, u.pn)) {
            int e = 0;
#pragma unroll
            for (int j = 1; j < 32; ++j) e += (toff[j] <= u.pm) ? 1 : 0;
            u.e = e; u.half = 0; return true;
        }
        const long sidx = (long)i * T.G + T.c - T.nwg; if (sidx >= 4 * soff[32]) return false;
        const int t = (int)sidx >> 2; u.pn = (int)sidx & 3; u.pm = toff[32] + t; u.e = sexp[t]; u.half = 1; return true;
    }
    __device__ __forceinline__ const char* a_base(const Unit& u) const { return A + (size_t)u.pm * 256 * K * 2; }
    __device__ __forceinline__ const char* b_base(const Unit& u) const { return Bt + ((size_t)u.e * 1024 + (size_t)u.pn * 256) * K * 2; }
    __device__ __forceinline__ void a_voff(const Unit&, int tid, unsigned (&v)[2][2]) const {
#pragma unroll
        for (int i = 0; i < 2; ++i) { int R, C; stage_rc(tid * 16 + i * 8192, R, C); v[0][i] = (unsigned)(R * K + C) * 2u; v[1][i] = v[0][i]; }
    }
};

typedef __bf16 bf16x2_t __attribute__((ext_vector_type(2)));
__device__ __forceinline__ unsigned cvt_pk_bf16(float lo, float hi) { bf16x2_t v; v[0] = (__bf16)lo; v[1] = (__bf16)hi; return __builtin_bit_cast(unsigned, v); }
__device__ __forceinline__ u32x4 pack8(const f32x4 a, const f32x4 b) { u32x4 w; w.x = cvt_pk_bf16(a[0], a[1]); w.y = cvt_pk_bf16(a[2], a[3]); w.z = cvt_pk_bf16(b[0], b[1]); w.w = cvt_pk_bf16(b[2], b[3]); return w; }

struct EpiStoreBf16 {
    static constexpr bool PERM = true;
    bf16_t* O; int ldc; float sc;
    __device__ __forceinline__ void operator()(const f32x4 (&acc)[2][2][4][2], const Unit& u, int wr, int wc, int fr, int fq) const {
        const int row0 = u.pm * BM + wr * 64 + fr, col0 = u.pn * BM + wc * 32 + 8 * fq;
#pragma unroll
        for (int ai = 0; ai < 2; ++ai) { if (ai == 1 && u.half) break;
#pragma unroll
            for (int m = 0; m < 4; ++m) { bf16_t* rowp = O + (size_t)(row0 + ai * HALF + m * 16) * ldc + col0;
#pragma unroll
                for (int bj = 0; bj < 2; ++bj) *(u32x4*)(rowp + bj * HALF) = pack8(acc[ai][bj][m][0] * sc, acc[ai][bj][m][1] * sc); } }
    }
};
struct EpiConvIn {
    static constexpr bool PERM = true;
    bf16_t* O; int ldc;
    __device__ __forceinline__ void operator()(const f32x4 (&acc)[2][2][4][2], const Unit& u, int wr, int wc, int fr, int fq) const {
        const int row0 = u.pm * BM + wr * 64 + fr;
        if (u.pn < 8) {
            const int col0 = u.pn * HALF + wc * 32 + 8 * fq;
#pragma unroll
            for (int ai = 0; ai < 2; ++ai)
#pragma unroll
                for (int m = 0; m < 4; ++m) { bf16_t* rowp = O + (size_t)(row0 + ai * HALF + m * 16) * ldc + col0;
                    *(u32x4*)rowp = pack8(acc[ai][0][m][0] * acc[ai][1][m][0], acc[ai][0][m][1] * acc[ai][1][m][1]); }
        } else {
            const int col0 = 1024 + (u.pn - 8) * BM + wc * 32 + 8 * fq;
#pragma unroll
            for (int ai = 0; ai < 2; ++ai)
#pragma unroll
                for (int m = 0; m < 4; ++m) { bf16_t* rowp = O + (size_t)(row0 + ai * HALF + m * 16) * ldc + col0;
#pragma unroll
                    for (int bj = 0; bj < 2; ++bj) *(u32x4*)(rowp + bj * HALF) = pack8(acc[ai][bj][m][0], acc[ai][bj][m][1]); }
        }
    }
};
__device__ __forceinline__ float silu_f(float g) { return g * __builtin_amdgcn_rcpf(1.0f + __expf(-g)); }
__device__ __forceinline__ unsigned pk4_fp8(float a, float b, float c, float d) { unsigned w = 0; w = __builtin_amdgcn_cvt_pk_fp8_f32(a, b, w, false); w = __builtin_amdgcn_cvt_pk_fp8_f32(c, d, w, true); return w; }
constexpr float W8_INV = 1.0f / 32.0f;
struct EpiGateUp {
    static constexpr bool PERM = true;
    unsigned char* O;
    __device__ __forceinline__ void operator()(const f32x4 (&acc)[2][2][4][2], const Unit& u, int wr, int wc, int fr, int fq) const {
        const int row0 = u.pm * BM + wr * 64 + fr, col0 = u.pn * HALF + wc * 32 + 8 * fq;
        typedef unsigned u32x2 __attribute__((ext_vector_type(2)));
#pragma unroll
        for (int ai = 0; ai < 2; ++ai) { if (ai == 1 && u.half) break;
#pragma unroll
            for (int m = 0; m < 4; ++m) { unsigned char* rowp = O + (size_t)(row0 + ai * HALF + m * 16) * 512 + col0;
                f32x4 h0, h1;
#pragma unroll
                for (int j = 0; j < 4; ++j) { h0[j] = silu_f(acc[ai][0][m][0][j] * W8_INV) * (acc[ai][1][m][0][j] * W8_INV); h1[j] = silu_f(acc[ai][0][m][1][j] * W8_INV) * (acc[ai][1][m][1][j] * W8_INV); }
                u32x2 w; w.x = pk4_fp8(h0[0], h0[1], h0[2], h0[3]); w.y = pk4_fp8(h1[0], h1[1], h1[2], h1[3]); *(u32x2*)rowp = w; } }
    }
};
struct EpiStoreF8 {
    static constexpr bool PERM = true;
    unsigned char* O; int ldc;
    __device__ __forceinline__ void operator()(const f32x4 (&acc)[2][2][4][2], const Unit& u, int wr, int wc, int fr, int fq) const {
        const int row0 = u.pm * BM + wr * 64 + fr, col0 = u.pn * BM + wc * 32 + 8 * fq;
        typedef unsigned u32x2 __attribute__((ext_vector_type(2)));
#pragma unroll
        for (int ai = 0; ai < 2; ++ai) { if (ai == 1 && u.half) break;
#pragma unroll
            for (int m = 0; m < 4; ++m) { unsigned char* rowp = O + (size_t)(row0 + ai * HALF + m * 16) * ldc + col0;
#pragma unroll
                for (int bj = 0; bj < 2; ++bj) { u32x2 w; w.x = pk4_fp8(acc[ai][bj][m][0][0], acc[ai][bj][m][0][1], acc[ai][bj][m][0][2], acc[ai][bj][m][0][3]);
                    w.y = pk4_fp8(acc[ai][bj][m][1][0], acc[ai][bj][m][1][1], acc[ai][bj][m][1][2], acc[ai][bj][m][1][3]); *(u32x2*)(rowp + bj * HALF) = w; } } }
    }
};
struct EpiResid {
    static constexpr bool PERM = true;
    const float* xin32; bf16_t* xs; const float* gatev;
    __device__ __forceinline__ void operator()(const f32x4 (&acc)[2][2][4][2], const Unit& u, int wr, int wc, int fr, int fq) const {
        const int row0 = u.pm * BM + wr * 64 + fr, col0 = u.pn * BM + wc * 32 + 8 * fq, b = u.pm >> 3;
        f32x4 gv[2][2];
#pragma unroll
        for (int bj = 0; bj < 2; ++bj)
#pragma unroll
            for (int n = 0; n < 2; ++n) gv[bj][n] = *(const f32x4*)(gatev + b * 3072 + col0 + bj * HALF + n * 4);
#pragma unroll
        for (int ai = 0; ai < 2; ++ai)
#pragma unroll
            for (int m = 0; m < 4; ++m) { const size_t off = (size_t)(row0 + ai * HALF + m * 16) * 1024 + col0;
#pragma unroll
                for (int bj = 0; bj < 2; ++bj) {
                    f32x4 x0, x1;
                    if (xin32) { x0 = *(const f32x4*)(xin32 + off + bj * HALF); x1 = *(const f32x4*)(xin32 + off + bj * HALF + 4); }
                    else { const u32x4 w = *(const u32x4*)(xs + off + bj * HALF);
                        x0 = (f32x4){__builtin_bit_cast(float, w.x << 16), __builtin_bit_cast(float, w.x & 0xffff0000u), __builtin_bit_cast(float, w.y << 16), __builtin_bit_cast(float, w.y & 0xffff0000u)};
                        x1 = (f32x4){__builtin_bit_cast(float, w.z << 16), __builtin_bit_cast(float, w.z & 0xffff0000u), __builtin_bit_cast(float, w.w << 16), __builtin_bit_cast(float, w.w & 0xffff0000u)}; }
                    *(u32x4*)(xs + off + bj * HALF) = pack8(x0 + gv[bj][0] * acc[ai][bj][m][0], x1 + gv[bj][1] * acc[ai][bj][m][1]); } }
    }
};

typedef int i32x8 __attribute__((ext_vector_type(8)));
template <class Epi, class Sched, bool ALIGN_EPI, bool FP8 = false>
__device__ __forceinline__ void gemm_phase(PG8_LAS unsigned char* lds, const int K, const Sched& S, const Epi& E) {
    constexpr bool GATHER = Sched::GATHER;
    const int tid = opaque_v((int)threadIdx.x), wid = __builtin_amdgcn_readfirstlane(tid >> 6), lane = tid & 63, wr = wid >> 2, wc = wid & 3, fr = lane & 15, fq = lane >> 4;
    const int nt = opaque_s(K / BK);
    unsigned voffB[2];
#pragma unroll
    for (int i = 0; i < 2; ++i) { int R, C; stage_rc(tid * 16 + i * 8192, R, C); const int Rb = Epi::PERM ? ((R & ~31) + perm32(R & 31)) : R; voffB[i] = (unsigned)(Rb * K + C) * 2u; }
    const size_t kstep = (size_t)(BK * 2);
    const size_t hstepB = (size_t)HALF * K * 2;
    const size_t hstepA = GATHER ? (size_t)0 : hstepB;
    const unsigned ldsw = (unsigned)wid * 1024u;
    const int aoff = lds_byte(wr * 64 + fr, fq * 8), boff = lds_byte(wc * 32 + fr, fq * 8);
#define PG8_SA(b, h) (((b) * 2 + (h)) * HTB)
#define PG8_SB(b, h) ((4 + (b) * 2 + (h)) * HTB)
#define PG8_STAGE(bufoff, gbase, voff) do { _Pragma("unroll") for (int _i = 0; _i < 2; ++_i) \
        __builtin_amdgcn_global_load_lds((const unsigned*)((const char*)(gbase) + (voff)[_i]), (PG8_LAS unsigned*)(lds + (bufoff) + ldsw + _i * 8192), 16, 0, 0); } while (0)
#define PG8_LDA(dst, b, h) do { _Pragma("unroll") for (int m = 0; m < 4; ++m) _Pragma("unroll") for (int k = 0; k < 2; ++k) dst[m][k] = *(const PG8_LAS bf16x8*)(lds + PG8_SA(b, h) + aoff + m * 2048 + k * 1024); } while (0)
#define PG8_LDB(dst, b, h) do { _Pragma("unroll") for (int n = 0; n < 2; ++n) _Pragma("unroll") for (int k = 0; k < 2; ++k) dst[n][k] = *(const PG8_LAS bf16x8*)(lds + PG8_SB(b, h) + boff + n * 2048 + k * 1024); } while (0)
#define PG8_MMA16(ai, bj, At, Bt) do { __builtin_amdgcn_s_setprio(1); _Pragma("unroll") for (int m = 0; m < 4; ++m) _Pragma("unroll") for (int n = 0; n < 2; ++n) _Pragma("unroll") for (int k = 0; k < 2; ++k) \
        acc[ai][bj][m][n] = __builtin_amdgcn_mfma_f32_16x16x32_bf16(Bt[n][k], At[m][k], acc[ai][bj][m][n], 0, 0, 0); __builtin_amdgcn_s_setprio(0); } while (0)
#define PG8_LDA8(dst, b, h) do { _Pragma("unroll") for (int m = 0; m < 4; ++m) { const u32x4 _lo = *(const PG8_LAS u32x4*)(lds + PG8_SA(b, h) + aoff + m * 2048), _hi = *(const PG8_LAS u32x4*)(lds + PG8_SA(b, h) + aoff + m * 2048 + 1024); \
        dst[m] = __builtin_bit_cast(i32x8, __builtin_shufflevector(_lo, _hi, 0, 1, 2, 3, 4, 5, 6, 7)); } } while (0)
#define PG8_LDB8(dst, b, h) do { _Pragma("unroll") for (int n = 0; n < 2; ++n) { const u32x4 _lo = *(const PG8_LAS u32x4*)(lds + PG8_SB(b, h) + boff + n * 2048), _hi = *(const PG8_LAS u32x4*)(lds + PG8_SB(b, h) + boff + n * 2048 + 1024); \
        dst[n] = __builtin_bit_cast(i32x8, __builtin_shufflevector(_lo, _hi, 0, 1, 2, 3, 4, 5, 6, 7)); } } while (0)
#define PG8_MMA8(ai, bj, At, Bt) do { __builtin_amdgcn_s_setprio(1); asm volatile("s_nop 4"); _Pragma("unroll") for (int m = 0; m < 4; ++m) _Pragma("unroll") for (int n = 0; n < 2; ++n) \
        asm volatile("v_mfma_scale_f32_16x16x128_f8f6f4 %0, %1, %2, %0, %3, %3 op_sel_hi:[0,0,0]" : "+v"(acc[ai][bj][m][n]) : "v"(Bt[n]), "v"(At[m]), "v"(scale1)); __builtin_amdgcn_s_setprio(0); } while (0)
#define PG8_XLDA(b, h) do { if constexpr (FP8) PG8_LDA8(At8, b, h); else PG8_LDA(At, b, h); } while (0)
#define PG8_XLDB(w, b, h) do { if constexpr (FP8) PG8_LDB8(B##w##8, b, h); else PG8_LDB(B##w, b, h); } while (0)
#define PG8_XMMA(ai, bj, w) do { if constexpr (FP8) PG8_MMA8(ai, bj, At8, B##w##8); else PG8_MMA16(ai, bj, At, B##w); } while (0)
#define PG8_WAIT_V(n) asm volatile("s_waitcnt vmcnt(" #n ")" ::: "memory")
#define PG8_WAIT_L(n) asm volatile("s_waitcnt lgkmcnt(" #n ")" ::: "memory")
#define PG8_BAR __builtin_amdgcn_s_barrier()
#define PG8_SCHED __builtin_amdgcn_sched_barrier(0)
    Unit cur, nxt; int ui = 0;
    if (!S.next(0, cur)) return;
    f32x4 acc[2][2][4][2];
#pragma unroll
    for (int a = 0; a < 2; ++a)
#pragma unroll
        for (int b = 0; b < 2; ++b)
#pragma unroll
            for (int m = 0; m < 4; ++m)
#pragma unroll
                for (int n = 0; n < 2; ++n) acc[a][b][m][n] = (f32x4){0.f, 0.f, 0.f, 0.f};
    bf16x8 At[4][2], B0[2][2], B1[2][2]; i32x8 At8[4], B08[2], B18[2]; int scale1 = 0x7F7F7F7F; asm volatile("" : "+v"(scale1));
    const char* cA = S.a_base(cur); const char* cB = S.b_base(cur);
    unsigned vc[2][2], vn[2][2];
    S.a_voff(cur, tid, vc);
    PG8_STAGE(PG8_SB(0, 0), cB, voffB); PG8_STAGE(PG8_SB(0, 1), cB + hstepB, voffB); PG8_STAGE(PG8_SA(0, 0), cA, vc[0]); PG8_STAGE(PG8_SA(0, 1), cA + hstepA, vc[1]);
    if (wr == 1) PG8_BAR;
    PG8_WAIT_V(2); PG8_BAR;
    PG8_STAGE(PG8_SB(1, 0), cB + kstep, voffB); PG8_STAGE(PG8_SA(1, 0), cA + kstep, vc[0]); PG8_STAGE(PG8_SB(1, 1), cB + hstepB + kstep, voffB);
    PG8_WAIT_V(6); PG8_BAR;
    for (;;) {
        const bool has_next = S.next(ui + 1, nxt);
        const char* nA = has_next ? S.a_base(nxt) : cA; const char* nB = has_next ? S.b_base(nxt) : cB;
        if (GATHER && has_next) { S.a_voff(nxt, tid, vn); *(PG8_LAS u32x4*)(lds + STAGE_BYTES + tid * 16) = (u32x4){vn[0][0], vn[0][1], vn[1][0], vn[1][1]}; }
#pragma unroll 1
        for (int t = 0; t < nt; t += 2) {
            const bool last = (t == nt - 2);
            const char* a1 = cA + (size_t)(t + 1) * kstep;
            const char* a2 = last ? nA : cA + (size_t)(t + 2) * kstep; const char* b2 = last ? nB : cB + (size_t)(t + 2) * kstep;
            const char* a3 = a2 + kstep; const char* b3 = b2 + kstep;
            unsigned v2[2][2];
#pragma unroll
            for (int h = 0; h < 2; ++h)
#pragma unroll
                for (int i = 0; i < 2; ++i) v2[h][i] = vc[h][i];
            if (GATHER && last && has_next) { const u32x4 pk = *(const PG8_LAS u32x4*)(lds + STAGE_BYTES + tid * 16); v2[0][0] = pk[0]; v2[0][1] = pk[1]; v2[1][0] = pk[2]; v2[1][1] = pk[3]; }
            PG8_XLDB(0, 0, 0); PG8_XLDB(1, 0, 1); PG8_SCHED; PG8_XLDA(0, 0); PG8_STAGE(PG8_SA(1, 1), a1 + hstepA, vc[1]);
            PG8_WAIT_V(8); PG8_WAIT_L(0); PG8_BAR; PG8_XMMA(0, 0, 0); PG8_XMMA(0, 1, 1); PG8_BAR; PG8_SCHED;
            if (!cur.half) PG8_XLDA(0, 1); PG8_STAGE(PG8_SB(0, 0), b2, voffB); PG8_STAGE(PG8_SB(0, 1), b2 + hstepB, voffB); PG8_STAGE(PG8_SA(0, 0), a2, v2[0]);
            PG8_WAIT_V(8); PG8_WAIT_L(0); PG8_BAR; if (!cur.half) { PG8_XMMA(1, 0, 0); PG8_XMMA(1, 1, 1); } PG8_BAR; PG8_SCHED;
            PG8_XLDB(0, 1, 0); PG8_XLDB(1, 1, 1); PG8_SCHED; PG8_XLDA(1, 0); PG8_STAGE(PG8_SA(0, 1), a2 + hstepA, v2[1]);
            PG8_WAIT_V(8); PG8_WAIT_L(0); PG8_BAR; PG8_XMMA(0, 0, 0); PG8_XMMA(0, 1, 1); PG8_BAR; PG8_SCHED;
            if (!cur.half) PG8_XLDA(1, 1); PG8_STAGE(PG8_SB(1, 0), b3, voffB); PG8_STAGE(PG8_SB(1, 1), b3 + hstepB, voffB); PG8_STAGE(PG8_SA(1, 0), a3, v2[0]);
            PG8_WAIT_V(8); PG8_WAIT_L(0); PG8_BAR; if (!cur.half) { PG8_XMMA(1, 0, 0); PG8_XMMA(1, 1, 1); } PG8_BAR; PG8_SCHED;
        }
        if constexpr (ALIGN_EPI) { if (wr == 0) PG8_BAR; }
        if constexpr (FP8) asm volatile("s_nop 15\n\ts_nop 15" ::: "memory");
        E(acc, cur, wr, wc, fr, fq);
        if (!has_next) break;
#pragma unroll
        for (int a = 0; a < 2; ++a)
#pragma unroll
            for (int b = 0; b < 2; ++b)
#pragma unroll
                for (int m = 0; m < 4; ++m)
#pragma unroll
                    for (int n = 0; n < 2; ++n) acc[a][b][m][n] = (f32x4){0.f, 0.f, 0.f, 0.f};
        cur = nxt; cA = nA; cB = nB; ++ui;
        if (GATHER) { const u32x4 pk = *(const PG8_LAS u32x4*)(lds + STAGE_BYTES + tid * 16); vc[0][0] = pk[0]; vc[0][1] = pk[1]; vc[1][0] = pk[2]; vc[1][1] = pk[3]; }
        if constexpr (ALIGN_EPI) { if (wr == 1) PG8_BAR; }
    }
    PG8_WAIT_V(0);
    if constexpr (!ALIGN_EPI) { if (wr == 0) PG8_BAR; }
    PG8_BAR;
#undef PG8_SA
#undef PG8_SB
#undef PG8_STAGE
#undef PG8_LDA
#undef PG8_LDB
#undef PG8_MMA16
#undef PG8_LDA8
#undef PG8_LDB8
#undef PG8_MMA8
#undef PG8_XLDA
#undef PG8_XLDB
#undef PG8_XMMA
#undef PG8_WAIT_V
#undef PG8_WAIT_L
#undef PG8_BAR
#undef PG8_SCHED
}
}

constexpr int NWAVES = 8, NTHR = 512;
constexpr int D = 1024, BATCH = 8, SEQ = 2048, NTOK = BATCH * SEQ, DEPTH = 4;
constexpr int M_HEADS = 4, M_DK = 128, M_DV = 256, M_PROJ = 3080, NPROJ = 3072;
constexpr int N_EXP = 32, D_FF = 512;
constexpr float EPS = 1e-6f;
constexpr int PMAX = 40960;

constexpr size_t MiB = 1u << 20;
constexpr size_t WS_CTL = 0, CTL_ZERO_BYTES = 1 * MiB;
constexpr size_t WS_MOD = 1 * MiB;
constexpr size_t WS_GATES = 2 * MiB;
constexpr size_t WS_TOKPOS = 3 * MiB;
constexpr size_t WS_TOKW = 3 * MiB + 256 * 1024;
constexpr size_t WS_SLOTTOK = 4 * MiB;
constexpr size_t WS_WMIN = 8 * MiB;
constexpr size_t WS_WMOUT = 20 * MiB;
constexpr size_t WS_WSIN = 24 * MiB;
constexpr size_t WS_WSOUT = 36 * MiB;
constexpr size_t WS_WGU = 40 * MiB;
constexpr size_t WS_WDN = 296 * MiB;
constexpr size_t WS_H = 424 * MiB;
constexpr size_t WS_PROJ = 456 * MiB;
constexpr size_t WS_HS = 552 * MiB;
constexpr size_t WS_A2 = 616 * MiB;
constexpr size_t WS_HMID = 648 * MiB;
constexpr size_t WS_YR = 688 * MiB;
constexpr size_t WS_X = 768 * MiB;
constexpr size_t WS_RTAB = 800 * MiB;
constexpr size_t WS_RCS = 805 * MiB;
constexpr size_t WS_END = 806 * MiB;
constexpr int CW_BAR = 4096;
constexpr int CW_CNT = 16384;

constexpr int LDS_BYTES = 163840;
constexpr int LDSCTL_OFF = 163840 - 1024;
constexpr int LC_TOFF = 16, LC_CNT = 64, LC_LCNT = 96, LC_LBASE = 128, LC_SOFF = 160, LC_SEXP = 200;

#define GAS __attribute__((address_space(1)))
#define LAS __attribute__((address_space(3)))
typedef unsigned short bf16;
typedef unsigned v4u __attribute__((ext_vector_type(4)));
typedef unsigned v2u __attribute__((ext_vector_type(2)));
typedef float f32x4 __attribute__((ext_vector_type(4)));
#define LDS_WAIT() asm volatile("s_waitcnt lgkmcnt(0)" ::: "memory")
__device__ __forceinline__ unsigned f2bf(float f) { unsigned u = __builtin_bit_cast(unsigned, f); return (u + 0x7fffu + ((u >> 16) & 1u)) >> 16; }
__device__ __forceinline__ unsigned pk2(float lo, float hi) { return f2bf(lo) | (f2bf(hi) << 16); }
__device__ __forceinline__ float bflo(unsigned w) { return __builtin_bit_cast(float, w << 16); }
__device__ __forceinline__ float bfhi(unsigned w) { return __builtin_bit_cast(float, w & 0xffff0000u); }
__device__ __forceinline__ float wave_sum(float v) {
#pragma unroll
    for (int o = 1; o < 64; o <<= 1) v += __shfl_xor(v, o);
    return v;
}

#define XB_TMO      128
#define XB_XCNT(j)  (256  + 64 * (j))
#define XB_XSUB(j)  (1280 + 64 * (j))
#define XB_XGEN(j)  (2304 + 64 * (j))
#define XB_TOP      3328
#define XB_TOPGEN   3392
#define XCD_BAR_WORDS 3456
#define XB_SPIN_CAP (1u << 18)
__device__ __forceinline__ unsigned xb_ld(unsigned* p)              { return __hip_atomic_load(p, __ATOMIC_RELAXED, __HIP_MEMORY_SCOPE_AGENT); }
__device__ __forceinline__ unsigned xb_add(unsigned* p, unsigned v) { return __hip_atomic_fetch_add(p, v, __ATOMIC_RELAXED, __HIP_MEMORY_SCOPE_AGENT); }
__device__ __forceinline__ unsigned xb_xcc_id() { return (unsigned)__builtin_amdgcn_s_getreg((3 << 11) | 20) & 0xFu; }
#define XB_SPIN(cond, bar) do { unsigned _sp = 0; while (cond) { __builtin_amdgcn_s_sleep(1); \
    if ((++_sp & 255u) == 0u) { if (xb_ld(&(bar)[XB_TMO])) break; if (_sp > XB_SPIN_CAP) { atomicAdd(&(bar)[XB_TMO], 1u); break; } } } } while (0)
struct XcdBarrier { unsigned* bar; unsigned x; volatile LAS unsigned* st; };
__device__ __forceinline__ XcdBarrier xcd_barrier_post(unsigned* bar, volatile LAS unsigned* st) {
    XcdBarrier b; b.bar = bar; b.x = xb_xcc_id(); b.st = st;
    if (threadIdx.x == 0) (void)xb_add(&bar[XB_XCNT(b.x)], 1u);
    return b;
}
__device__ __forceinline__ void xcd_barrier_complete(unsigned* bar, unsigned x, unsigned& nloc, unsigned& nx) {
    const unsigned G = gridDim.x * gridDim.y * gridDim.z;
    unsigned sum, cnt, mine, sp = 0u;
    for (;;) {
        sum = 0u; cnt = 0u; mine = 0u;
#pragma unroll
        for (unsigned j = 0; j < 16; ++j) { const unsigned c = xb_ld(&bar[XB_XCNT(j)]); sum += c; cnt += (c > 0u) ? 1u : 0u; mine = (j == x) ? c : mine; }
        if (sum == G) break;
        __builtin_amdgcn_s_sleep(1);
        if ((++sp & 255u) == 0u) { if (xb_ld(&bar[XB_TMO])) break; if (sp > XB_SPIN_CAP) { atomicAdd(&bar[XB_TMO], 1u); break; } }
    }
    nloc = mine > 0u ? mine : 1u; nx = cnt > 0u ? cnt : 1u;
}
__device__ __forceinline__ void xcd_barrier(const XcdBarrier& b) {
    asm volatile("s_waitcnt vmcnt(0)" ::: "memory");
    __syncthreads();
    if (threadIdx.x == 0) {
        unsigned* bar = b.bar;
        __builtin_amdgcn_s_waitcnt(0);
        unsigned nloc = b.st[0], nx = b.st[1];
        if (nloc == 0u) { xcd_barrier_complete(bar, b.x, nloc, nx); b.st[0] = nloc; b.st[1] = nx; }
        const unsigned old = xb_add(&bar[XB_XSUB(b.x)], 1u);
        const unsigned gen = old / nloc;
        if (old + 1u == (gen + 1u) * nloc) {
            __builtin_amdgcn_fence(__ATOMIC_RELEASE, "agent");
            asm volatile("s_waitcnt vmcnt(0)" ::: "memory");
            const unsigned og = xb_add(&bar[XB_TOP], 1u);
            const unsigned tg = og / nx;
            if (og + 1u == (tg + 1u) * nx) xb_add(&bar[XB_TOPGEN], 1u);
            else XB_SPIN(xb_ld(&bar[XB_TOPGEN]) == tg, bar);
            __builtin_amdgcn_fence(__ATOMIC_ACQUIRE, "agent");
            xb_add(&bar[XB_XGEN(b.x)], 1u);
            asm volatile("s_waitcnt vmcnt(0)" ::: "memory");
        } else {
            XB_SPIN(xb_ld(&bar[XB_XGEN(b.x)]) == gen, bar);
            __builtin_amdgcn_fence(__ATOMIC_ACQUIRE, "agent");
            asm volatile("s_waitcnt vmcnt(0)" ::: "memory");
        }
    }
    __syncthreads();
}

struct Args { const float* in[20]; float* out; unsigned char* ws; int ph_lo, ph_hi; };
enum InIdx { I_X = 0, I_C, I_ADAW, I_ADAB, I_NORMG, I_FINALG, I_MWIN, I_MBG, I_MNORMG, I_MWOUT, I_SWIN, I_SCONVW, I_SWOUT, I_RWG, I_RBG, I_RWE, I_RBE, I_EWG, I_EWU, I_EWD };

struct Frame {
    LAS unsigned char* lds;
    volatile LAS unsigned* LC;
    unsigned* ctl;
    int tid, lane, wave, G;
    float* out; unsigned char* ws;
};
typedef const __attribute__((address_space(4))) Args* KArgs;
__device__ __forceinline__ KArgs kargs() { auto p = __builtin_amdgcn_kernarg_segment_ptr(); asm volatile("" : "+s"(p)); return (KArgs)p; }
template <class T> __device__ __forceinline__ T* as_global(T* p) { __attribute__((address_space(1))) T* q = (__attribute__((address_space(1))) T*)p; asm volatile("" : "+s"(q)); return (T*)q; }
#define KIN(i) (as_global((const float*)kargs()->in[i]))
template <class T> __device__ __forceinline__ T* launder(T* p) { return as_global(p); }

__device__ __forceinline__ Frame fresh(const Frame& F) { Frame P = F; P.tid = pg8::opaque_v(F.tid); P.lane = P.tid & 63; P.wave = __builtin_amdgcn_readfirstlane(P.tid >> 6); P.G = pg8::opaque_s(F.G); return P; }
__device__ __forceinline__ void p_adaln(Frame& F) {
    LAS float* sc = (LAS float*)F.lds;
    LAS float* red = (LAS float*)(F.lds + 32768);
    const float* c = KIN(I_C); const float* adaw = KIN(I_ADAW); const float* adab = KIN(I_ADAB);
    float* mod = (float*)(F.ws + WS_MOD);
    for (int i = F.tid; i < 8192; i += NTHR) { const float v = c[i]; sc[i] = v / (1.0f + __expf(-v)); }
    __syncthreads();
    const int kq = F.lane >> 4, c4 = (F.lane & 15) * 4;
    for (int item = blockIdx.x; item < 8 * 48; item += F.G) {
        const int ls = item / 48, cg = item % 48;
        const float* W = adaw + (size_t)ls * 1024 * 3072 + cg * 64 + c4;
        float acc[8][4];
#pragma unroll
        for (int b = 0; b < 8; ++b) { acc[b][0] = 0.f; acc[b][1] = 0.f; acc[b][2] = 0.f; acc[b][3] = 0.f; }
#pragma unroll 8
        for (int i = 0; i < 32; ++i) {
            const int k = F.wave * 128 + i * 4 + kq;
            const f32x4 w = *(const f32x4*)(W + (size_t)k * 3072);
#pragma unroll
            for (int b = 0; b < 8; ++b) { const float s = sc[b * 1024 + k]; acc[b][0] += s * w[0]; acc[b][1] += s * w[1]; acc[b][2] += s * w[2]; acc[b][3] += s * w[3]; }
        }
#pragma unroll
        for (int b = 0; b < 8; ++b)
#pragma unroll
            for (int j = 0; j < 4; ++j) { float v = acc[b][j]; v += __shfl_xor(v, 16); v += __shfl_xor(v, 32); acc[b][j] = v; }
        if (kq == 0) {
#pragma unroll
            for (int b = 0; b < 8; ++b) *(LAS f32x4*)(red + (F.wave * 8 + b) * 64 + c4) = (f32x4){acc[b][0], acc[b][1], acc[b][2], acc[b][3]};
        }
        __syncthreads();
        { const int b = F.tid >> 6, col = F.tid & 63; float s = 0.f;
#pragma unroll
          for (int w = 0; w < 8; ++w) s += red[(w * 8 + b) * 64 + col];
          mod[((size_t)ls * 8 + b) * 3072 + cg * 64 + col] = s + adab[ls * 3072 + cg * 64 + col]; }
        __syncthreads();
    }
}

__device__ __forceinline__ void tr_item(const float* W, int ldw, bf16* WT, int ldt, LAS float* scr, int lane) {
#pragma unroll 8
    for (int i = 0; i < 32; ++i) { const int kk = 2 * i + (lane >> 5); scr[kk * 33 + (lane & 31)] = W[(size_t)kk * ldw + (lane & 31)]; }
    LDS_WAIT(); asm volatile("" ::: "memory");
    const int c = lane & 7;
#pragma unroll
    for (int j = 0; j < 4; ++j) { const int n = (lane >> 3) + 8 * j; const LAS float* s = scr + (8 * c) * 33 + n;
        v4u o; o.x = pk2(s[0 * 33], s[1 * 33]); o.y = pk2(s[2 * 33], s[3 * 33]); o.z = pk2(s[4 * 33], s[5 * 33]); o.w = pk2(s[6 * 33], s[7 * 33]);
        *(v4u*)(WT + (size_t)n * ldt + 8 * c) = o; }
    LDS_WAIT(); asm volatile("" ::: "memory");
}
__device__ __forceinline__ void tr_item8(const float* W, int ldw, unsigned char* WT, int ldt, LAS float* scr, int lane) {
#pragma unroll 8
    for (int i = 0; i < 64; ++i) { const int kk = 2 * i + (lane >> 5); scr[kk * 33 + (lane & 31)] = W[(size_t)kk * ldw + (lane & 31)] * 32.0f; }
    LDS_WAIT(); asm volatile("" ::: "memory");
    const int n = lane >> 1, kh = (lane & 1) * 64; const LAS float* sp = scr + kh * 33 + n;
    unsigned char* dst = WT + (size_t)n * ldt + kh;
#pragma unroll
    for (int q = 0; q < 4; ++q) { v4u o;
        o.x = pg8::pk4_fp8(sp[(16 * q + 0) * 33], sp[(16 * q + 1) * 33], sp[(16 * q + 2) * 33], sp[(16 * q + 3) * 33]); o.y = pg8::pk4_fp8(sp[(16 * q + 4) * 33], sp[(16 * q + 5) * 33], sp[(16 * q + 6) * 33], sp[(16 * q + 7) * 33]);
        o.z = pg8::pk4_fp8(sp[(16 * q + 8) * 33], sp[(16 * q + 9) * 33], sp[(16 * q + 10) * 33], sp[(16 * q + 11) * 33]); o.w = pg8::pk4_fp8(sp[(16 * q + 12) * 33], sp[(16 * q + 13) * 33], sp[(16 * q + 14) * 33], sp[(16 * q + 15) * 33]);
        *(v4u*)(dst + 16 * q) = o; }
    LDS_WAIT(); asm volatile("" ::: "memory");
}
__device__ __forceinline__ void p_convert(Frame& F) {
    LAS float* scr = (LAS float*)(F.lds + F.wave * 17408);
    const float* in_mwin = KIN(I_MWIN); const float* in_mwout = KIN(I_MWOUT); const float* in_swin = KIN(I_SWIN); const float* in_swout = KIN(I_SWOUT);
    const float* in_ewg = KIN(I_EWG); const float* in_ewu = KIN(I_EWU); const float* in_ewd = KIN(I_EWD);
    const int gw = blockIdx.x * NWAVES + F.wave, NGW = F.G * NWAVES;
    constexpr int I_A = 2 * 16 * 96, I_B = 2 * 16 * 32, I_C2 = I_A, I_D = I_B, I_E = 128 * 8 * 16, I_F = I_E, I_G = 128 * 4 * 32;
    constexpr int NITEMS = I_A + I_B + I_C2 + I_D + I_E + I_F + I_G;
    for (int it = gw; it < NITEMS; it += NGW) {
        int r = it;
        if (r < I_A) { const int j = r / 1536, q = r % 1536, kb = q / 96, nb = q % 96;
            tr_item(in_mwin + (size_t)j * 1024 * M_PROJ + (size_t)kb * 64 * M_PROJ + nb * 32, M_PROJ, (bf16*)(F.ws + WS_WMIN) + (size_t)j * 3072 * 1024 + (size_t)nb * 32 * 1024 + kb * 64, 1024, scr, F.lane); continue; } r -= I_A;
        if (r < I_B) { const int j = r / 512, q = r % 512, kb = q / 32, nb = q % 32;
            tr_item(in_mwout + (size_t)j * 1024 * 1024 + (size_t)kb * 64 * 1024 + nb * 32, 1024, (bf16*)(F.ws + WS_WMOUT) + (size_t)j * 1024 * 1024 + (size_t)nb * 32 * 1024 + kb * 64, 1024, scr, F.lane); continue; } r -= I_B;
        if (r < I_C2) { const int j = r / 1536, q = r % 1536, kb = q / 96, nb = q % 96, n0 = nb * 32;
            int drow; if (n0 < 1024) drow = 2048 + n0; else if (n0 < 2048) { const int cc = n0 - 1024; drow = 256 * (cc >> 7) + (cc & 127); } else { const int cc = n0 - 2048; drow = 256 * (cc >> 7) + 128 + (cc & 127); }
            tr_item(in_swin + (size_t)j * 1024 * 3072 + (size_t)kb * 64 * 3072 + n0, 3072, (bf16*)(F.ws + WS_WSIN) + (size_t)j * 3072 * 1024 + (size_t)drow * 1024 + kb * 64, 1024, scr, F.lane); continue; } r -= I_C2;
        if (r < I_D) { const int j = r / 512, q = r % 512, kb = q / 32, nb = q % 32;
            tr_item(in_swout + (size_t)j * 1024 * 1024 + (size_t)kb * 64 * 1024 + nb * 32, 1024, (bf16*)(F.ws + WS_WSOUT) + (size_t)j * 1024 * 1024 + (size_t)nb * 32 * 1024 + kb * 64, 1024, scr, F.lane); continue; } r -= I_D;
        if (r < I_E + I_F) { const bool up = r >= I_E; if (up) r -= I_E; const int mat = r / 128, q = r % 128, kb = q / 16, nb = q % 16, n0 = nb * 32;
            const int drow = 256 * (n0 >> 7) + (up ? 128 : 0) + (n0 & 127);
            tr_item8((up ? in_ewu : in_ewg) + (size_t)mat * 1024 * 512 + (size_t)kb * 128 * 512 + n0, 512, (unsigned char*)(F.ws + WS_WGU) + (size_t)mat * 1024 * 1024 + (size_t)drow * 1024 + kb * 128, 1024, scr, F.lane); continue; } r -= I_E + I_F;
        { const int mat = r / 128, q = r % 128, kb = q / 32, nb = q % 32;
            tr_item8(in_ewd + (size_t)mat * 512 * 1024 + (size_t)kb * 128 * 1024 + nb * 32, 1024, (unsigned char*)(F.ws + WS_WDN) + (size_t)mat * 1024 * 512 + (size_t)nb * 32 * 512 + kb * 128, 512, scr, F.lane); }
    }
}

__device__ __forceinline__ void moe_tables(Frame& F, int layer) {
    if (F.tid < 64) {
        const int e = F.tid & 31;
        const int c = (int)__hip_atomic_load(F.ctl + CW_CNT + (layer * 32 + e) * 16, __ATOMIC_RELAXED, __HIP_MEMORY_SCOPE_AGENT);
        const int tl = (c + 255) >> 8, rem = c - (tl - 1) * 256;
        const int sm = (tl > 0 && rem <= 128) ? 1 : 0, nb = tl - sm;
        int incb = (F.tid < 32) ? nb : 0, incs = (F.tid < 32) ? sm : 0;
#pragma unroll
        for (int o = 1; o < 32; o <<= 1) { const int vb = __shfl_up(incb, o), vs = __shfl_up(incs, o); if ((F.tid & 63) >= o) { incb += vb; incs += vs; } }
        if (F.tid < 32) { F.LC[LC_TOFF + e] = (unsigned)(incb - nb); F.LC[LC_SOFF + e] = (unsigned)(incs - sm); F.LC[LC_CNT + e] = (unsigned)c;
            if (sm) F.LC[LC_SEXP + (incs - sm)] = (unsigned)e;
            if (e == 31) { F.LC[LC_TOFF + 32] = (unsigned)incb; F.LC[LC_SOFF + 32] = (unsigned)incs; } }
    }
    __syncthreads();
}
__device__ __forceinline__ int moe_slot(Frame& F, int p) {
    const int e = p & 31, pos = p >> 5, k = pos >> 8, b0 = (int)F.LC[LC_TOFF + e], nb = (int)F.LC[LC_TOFF + e + 1] - b0;
    const int tile = (k < nb) ? b0 + k : (int)F.LC[LC_TOFF + 32] + (int)F.LC[LC_SOFF + e];
    return tile * 256 + (pos & 255);
}
__device__ __forceinline__ void p_rtab(Frame& F) {
    constexpr int NC = 36;
    LAS float* gsL = (LAS float*)F.lds; LAS float* shL = gsL + 128; LAS float* r2 = shL + 128;
    const float* MODp = (const float*)(F.ws + WS_MOD);
    for (int job = blockIdx.x; job < 256; job += F.G) {
        const int part = job & 7, tb = job >> 3, l = tb >> 3, b = tb & 7;
        const float* modn = MODp + (size_t)((l * 2 + 1) * 8 + b) * 3072; const float* ng = KIN(I_NORMG) + (l * 2 + 1) * 1024;
        const float* wg = KIN(I_RWG) + (size_t)l * 1024 * 4; const float* we = KIN(I_RWE) + (size_t)l * 1024 * 32;
        if (F.tid < 128) { const int k = part * 128 + F.tid; gsL[F.tid] = ng[k] * (1.0f + modn[1024 + k]); shL[F.tid] = modn[k]; }
        __syncthreads();
        unsigned char* tab = F.ws + WS_RTAB + (size_t)tb * (NC * 4096);
        for (int t = F.tid; t < 16 * NC; t += NTHR) {
            const int n = t % NC, kcl = t / NC, kc = part * 16 + kcl;
            const float* wcol = (n < 4) ? wg + n : we + (n - 4); const int wstr = (n < 4) ? 4 : 32;
            float wv[8];
#pragma unroll
            for (int jj = 0; jj < 8; ++jj) wv[jj] = wcol[(size_t)(8 * kc + jj) * wstr];
            float cs = 0.f, pv[8];
#pragma unroll
            for (int jj = 0; jj < 8; ++jj) { cs += shL[8 * kcl + jj] * wv[jj]; pv[jj] = wv[jj] * gsL[8 * kcl + jj]; }
            v4u hi, lo; unsigned* hp = (unsigned*)&hi; unsigned* lp = (unsigned*)&lo;
#pragma unroll
            for (int e = 0; e < 4; ++e) { const unsigned w2 = pg8::cvt_pk_bf16(pv[2 * e], pv[2 * e + 1]); hp[e] = w2;
                lp[e] = pg8::cvt_pk_bf16(pv[2 * e] - __builtin_bit_cast(float, w2 << 16), pv[2 * e + 1] - __builtin_bit_cast(float, w2 & 0xffff0000u)); }
            *(v4u*)(tab + (kc * NC + n) * 16) = hi; *(v4u*)(tab + NC * 2048 + (kc * NC + n) * 16) = lo;
            r2[kcl * NC + n] = cs;
        }
        __syncthreads();
        if (F.tid < NC) { float sacc = 0.f;
#pragma unroll
            for (int q = 0; q < 16; ++q) sacc += r2[q * NC + F.tid];
            ((float*)(F.ws + WS_RCS))[(tb * 8 + part) * NC + F.tid] = sacc; }
        __syncthreads();
    }
}
template <int NC> __device__ __forceinline__ void wtab_put(LAS unsigned char* base, int k, int n, float v) {
    const unsigned hi = f2bf(v); const unsigned lo = f2bf(v - __builtin_bit_cast(float, hi << 16));
    const int off = ((k >> 3) * NC + n) * 16 + (k & 7) * 2;
    *(LAS unsigned short*)(base + off) = (unsigned short)hi; *(LAS unsigned short*)(base + NC * 2048 + off) = (unsigned short)lo;
}
typedef short rbf16x8 __attribute__((ext_vector_type(8)));
template <bool COMBINE, int AUX, bool FINAL, bool XF32 = false>
__device__ __forceinline__ void row_phase(Frame& F, const void* xsrc_, void* xdst_, const float* modn, const float* ng, const float* modprev, int prev_layer,
                                          const float* auxw0, const float* auxw1, const float* auxb0, const float* auxb1, int layer) {
    constexpr int NC = (AUX == 2) ? 36 : 8, NT = (NC + 15) / 16;
    constexpr int OFF_RINV = 147456, OFF_LOGIT = OFF_RINV + 256, OFF_ROWE = OFF_LOGIT + 64 * 36 * 4, OFF_ROWW = OFF_ROWE + 512, OFF_CB = OFF_ROWW + 512, OFF_R2 = OFF_CB + 256;
    static_assert(OFF_R2 + 14 * 36 * 4 <= LDSCTL_OFF && 64 * 8 * 4 <= 14 * 36 * 4 + 64, "row phase LDS map");
    const int lane = F.lane;
    const float* xsrc32 = (const float*)xsrc_; const bf16* xsrc16 = (const bf16*)xsrc_;
    float* xdst32 = (float*)xdst_; bf16* xdst16 = (bf16*)xdst_;
    if (COMBINE) moe_tables(F, prev_layer);
    const int* tokpos = (const int*)(F.ws + WS_TOKPOS); const float* tokw = (const float*)(F.ws + WS_TOKW);
    const unsigned char* YR = (const unsigned char*)(F.ws + WS_YR);
    bf16* H = (bf16*)(F.ws + WS_H);
    LAS float* rinvL = (LAS float*)(F.lds + OFF_RINV);
    LAS float* logit = (LAS float*)(F.lds + OFF_LOGIT);
    LAS int* rowE = (LAS int*)(F.lds + OFF_ROWE);
    LAS float* rowW = (LAS float*)(F.lds + OFF_ROWW);
    LAS float* cbL = (LAS float*)(F.lds + OFF_CB);
    LAS float* r2 = (LAS float*)(F.lds + OFF_R2);
    int tab_b = -1;
#ifdef SCAN_SELFCHECK
    const float FLAGSCALE = (FINAL && __hip_atomic_load(F.ctl + 64, __ATOMIC_RELAXED, __HIP_MEMORY_SCOPE_AGENT) != 0u) ? 2.0f : 1.0f;
#else
    const float FLAGSCALE = 1.0f;
#endif
#if defined(TPSUB)
    unsigned long long ts0 = __builtin_amdgcn_s_memrealtime(), ts1 = ts0;
#define TS_MARK(k) do { if (AUX == 2) { asm volatile("s_waitcnt vmcnt(0)" ::: "memory"); __syncthreads(); ts1 = __builtin_amdgcn_s_memrealtime(); if (TPSUB == (k) && F.tid == 0) atomicMax(F.ctl + 80, (unsigned)(ts1 - ts0)); ts0 = ts1; } } while (0)
#else
#define TS_MARK(k)
#endif
    for (int rg = blockIdx.x; rg < NTOK / 64; rg += F.G) {
        const int b = rg >> 5;
        if (AUX == 2 && b != tab_b) {
            tab_b = b;
            const unsigned char* tab = F.ws + WS_RTAB + (size_t)(layer * 8 + b) * (NC * 4096);
#pragma unroll
            for (int i = 0; i < 18; ++i) __builtin_amdgcn_global_load_lds((const unsigned*)(tab + (size_t)(F.tid + NTHR * i) * 16), (LAS unsigned*)(F.lds + F.wave * 1024 + i * 8192), 16, 0, 0);
            if (F.tid < NC) { const float* rcs = (const float*)(F.ws + WS_RCS) + (size_t)(layer * 8 + b) * 8 * NC; float sacc = 0.f;
#pragma unroll
                for (int q = 0; q < 8; ++q) sacc += rcs[q * NC + F.tid];
                cbL[F.tid] = sacc; }
        } else if (AUX == 1 && b != tab_b) {
            tab_b = b;
            const float* shp = modn + b * 3072; const float* scp = shp + 1024;
            LAS float* gsL = logit; LAS float* shL = logit + 1024;
            for (int k = F.tid; k < 1024; k += NTHR) { gsL[k] = ng[k] * (1.0f + scp[k]); shL[k] = shp[k]; }
            __syncthreads();
            constexpr int NQ = (AUX == 2) ? 14 : 4, NI = (AUX == 2) ? 10 : 1;
            if (AUX == 1) {
                float cs4[4] = {0.f, 0.f, 0.f, 0.f};
                if (F.tid < 256) { const int kc = F.tid >> 1, c4 = F.tid & 1; f32x4 wq[8];
#pragma unroll
                    for (int jj = 0; jj < 8; ++jj) wq[jj] = *(const f32x4*)(auxw0 + (size_t)(8 * kc + jj) * M_PROJ + NPROJ + 4 * c4);
#pragma unroll
                    for (int e = 0; e < 4; ++e) { float pv[8];
#pragma unroll
                        for (int jj = 0; jj < 8; ++jj) { const int k = 8 * kc + jj; cs4[e] += shL[k] * wq[jj][e]; pv[jj] = wq[jj][e] * gsL[k]; }
                        v4u hi, lo; unsigned* hp = (unsigned*)&hi; unsigned* lp = (unsigned*)&lo;
#pragma unroll
                        for (int q = 0; q < 4; ++q) { const unsigned w2 = pg8::cvt_pk_bf16(pv[2 * q], pv[2 * q + 1]); hp[q] = w2;
                            lp[q] = pg8::cvt_pk_bf16(pv[2 * q] - __builtin_bit_cast(float, w2 << 16), pv[2 * q + 1] - __builtin_bit_cast(float, w2 & 0xffff0000u)); }
                        *(LAS v4u*)(F.lds + (kc * NC + 4 * c4 + e) * 16) = hi; *(LAS v4u*)(F.lds + NC * 2048 + (kc * NC + 4 * c4 + e) * 16) = lo; } }
#pragma unroll
                for (int e = 0; e < 4; ++e) { float t = cs4[e]; t += __shfl_xor(t, 2); t += __shfl_xor(t, 4); t += __shfl_xor(t, 8); t += __shfl_xor(t, 16); t += __shfl_xor(t, 32); cs4[e] = t; }
                if (F.tid < 256 && lane < 2) {
#pragma unroll
                    for (int e = 0; e < 4; ++e) r2[F.wave * NC + 4 * lane + e] = cs4[e]; }
            } else {
            if (F.tid < NQ * NC) {
                const int n = F.tid % NC, kcq = F.tid / NC; float cs = 0.f;
                const float* wcol = (AUX == 1) ? auxw0 + NPROJ + n : ((n < 4) ? auxw0 + n : auxw1 + (n - 4));
                const int wstr = (AUX == 1) ? M_PROJ : ((n < 4) ? 4 : 32);
                constexpr int NB = (NI + 4) / 5;
#pragma unroll 1
                for (int bt = 0; bt < NB; ++bt) {
                    float wv[5][8];
#pragma unroll
                    for (int i = 0; i < 5; ++i) { const int kcr = kcq + NQ * (5 * bt + i); const int kc = kcr < 128 ? kcr : 127; const float* wp = wcol + (size_t)(8 * kc) * wstr;
#pragma unroll
                        for (int jj = 0; jj < 8; ++jj) wv[i][jj] = wp[jj * wstr]; }
#pragma unroll
                    for (int i = 0; i < 5; ++i) { const int kcr = kcq + NQ * (5 * bt + i); const bool valid = kcr < 128 && (5 * bt + i) < NI; const int kc = kcr < 128 ? kcr : 127;
                        float pv[8];
#pragma unroll
                        for (int jj = 0; jj < 8; ++jj) { const int k = 8 * kc + jj; cs += valid ? shL[k] * wv[i][jj] : 0.f; pv[jj] = wv[i][jj] * gsL[k]; }
                        v4u hi, lo; unsigned* hp = (unsigned*)&hi; unsigned* lp = (unsigned*)&lo;
#pragma unroll
                        for (int e = 0; e < 4; ++e) { const unsigned w2 = pg8::cvt_pk_bf16(pv[2 * e], pv[2 * e + 1]); hp[e] = w2;
                            lp[e] = pg8::cvt_pk_bf16(pv[2 * e] - __builtin_bit_cast(float, w2 << 16), pv[2 * e + 1] - __builtin_bit_cast(float, w2 & 0xffff0000u)); }
                        *(LAS v4u*)(F.lds + (kc * NC + n) * 16) = hi; *(LAS v4u*)(F.lds + NC * 2048 + (kc * NC + n) * 16) = lo;
                    }
                }
                r2[kcq * NC + n] = cs;
            }
            }
            __syncthreads();
            if (F.tid < NC) { float sacc = 0.f; for (int q = 0; q < NQ; ++q) sacc += r2[q * NC + F.tid]; cbL[F.tid] = sacc; }
            __syncthreads();
        }
        TS_MARK(1);
        if (AUX == 2 && F.tid < 32) F.LC[LC_LCNT + F.tid] = 0u;
        {
            constexpr int RB = COMBINE ? 2 : 4;
            f32x4 gsv[4], shv[4], gtv[4];
#pragma unroll
            for (int j = 0; j < 4; ++j) {
                const f32x4 g = *((const f32x4*)ng + lane + 64 * j);
                if (FINAL) { gsv[j] = g; shv[j] = (f32x4){0.f, 0.f, 0.f, 0.f}; }
                else { const f32x4 scl = *((const f32x4*)(modn + b * 3072 + 1024) + lane + 64 * j); gsv[j] = g * (1.0f + scl); shv[j] = *((const f32x4*)(modn + b * 3072) + lane + 64 * j); }
                if (COMBINE) gtv[j] = *((const f32x4*)(modprev + b * 3072 + 2048) + lane + 64 * j);
            }
            for (int i0 = 0; i0 < 8; i0 += RB) {
                const int rowb = rg * 64 + F.wave * 8 + i0;
                f32x4 v[RB][4]; unsigned y0[RB][4], y1[RB][4]; float w0[RB], w1[RB];
#pragma unroll
                for (int r = 0; r < RB; ++r) {
#pragma unroll
                    for (int j = 0; j < 4; ++j) {
                        if (XF32) v[r][j] = *((const f32x4*)(xsrc32 + (size_t)(rowb + r) * D) + lane + 64 * j);
                        else { const v2u w = *((const v2u*)(xsrc16 + (size_t)(rowb + r) * D) + lane + 64 * j); v[r][j] = (f32x4){bflo(w.x), bfhi(w.x), bflo(w.y), bfhi(w.y)}; } }
                    if (COMBINE) {
                        const int p0 = __builtin_amdgcn_readfirstlane(tokpos[(rowb + r) * 2]), p1 = __builtin_amdgcn_readfirstlane(tokpos[(rowb + r) * 2 + 1]);
                        w0[r] = tokw[(rowb + r) * 2] * pg8::W8_INV; w1[r] = tokw[(rowb + r) * 2 + 1] * pg8::W8_INV;
                        const int s0 = moe_slot(F, p0), s1 = moe_slot(F, p1);
#pragma unroll
                        for (int j = 0; j < 4; ++j) { y0[r][j] = *((const unsigned*)(YR + (size_t)s0 * D) + lane + 64 * j); y1[r][j] = *((const unsigned*)(YR + (size_t)s1 * D) + lane + 64 * j); }
                    }
                }
#pragma unroll
                for (int r = 0; r < RB; ++r) {
                    const int row = rowb + r;
                    if (COMBINE) {
#pragma unroll
                        for (int j = 0; j < 4; ++j) {
                            v[r][j][0] += gtv[j][0] * (w0[r] * __builtin_amdgcn_cvt_f32_fp8(y0[r][j], 0) + w1[r] * __builtin_amdgcn_cvt_f32_fp8(y1[r][j], 0)); v[r][j][1] += gtv[j][1] * (w0[r] * __builtin_amdgcn_cvt_f32_fp8(y0[r][j], 1) + w1[r] * __builtin_amdgcn_cvt_f32_fp8(y1[r][j], 1));
                            v[r][j][2] += gtv[j][2] * (w0[r] * __builtin_amdgcn_cvt_f32_fp8(y0[r][j], 2) + w1[r] * __builtin_amdgcn_cvt_f32_fp8(y1[r][j], 2)); v[r][j][3] += gtv[j][3] * (w0[r] * __builtin_amdgcn_cvt_f32_fp8(y0[r][j], 3) + w1[r] * __builtin_amdgcn_cvt_f32_fp8(y1[r][j], 3));
                        }
                        if (!FINAL) {
#pragma unroll
                            for (int j = 0; j < 4; ++j) { v2u o; o.x = pk2(v[r][j][0], v[r][j][1]); o.y = pk2(v[r][j][2], v[r][j][3]); *((v2u*)(xdst16 + (size_t)row * D) + lane + 64 * j) = o;
                                v[r][j] = (f32x4){bflo(o.x), bfhi(o.x), bflo(o.y), bfhi(o.y)}; }
                        }
                    }
                    float ss = 0.f;
#pragma unroll
                    for (int j = 0; j < 4; ++j) ss += (v[r][j][0] * v[r][j][0] + v[r][j][1] * v[r][j][1]) + (v[r][j][2] * v[r][j][2] + v[r][j][3] * v[r][j][3]);
                    const float rinv = 1.0f / sqrtf(wave_sum(ss) * (1.0f / D) + EPS);
                    if (FINAL) {
#pragma unroll
                        for (int j = 0; j < 4; ++j) *((f32x4*)(xdst32 + (size_t)row * D) + lane + 64 * j) = v[r][j] * (rinv * FLAGSCALE) * gsv[j];
                    } else {
                        if (AUX != 0 && lane == 0) rinvL[F.wave * 8 + i0 + r] = rinv;
#pragma unroll
                        for (int j = 0; j < 4; ++j) { const f32x4 h = (v[r][j] * rinv) * gsv[j] + shv[j];
                            if (AUX == 2) *((unsigned*)((unsigned char*)H + (size_t)row * D) + lane + 64 * j) = pg8::pk4_fp8(h[0], h[1], h[2], h[3]);
                            else { v2u o; o.x = pk2(h[0], h[1]); o.y = pk2(h[2], h[3]); *((v2u*)(H + (size_t)row * D) + lane + 64 * j) = o; } }
                    }
                }
            }
        }
        TS_MARK(2);
        if (AUX != 0) {
            if (AUX == 2) asm volatile("s_waitcnt vmcnt(0)" ::: "memory");
            __syncthreads();
            const int l15 = lane & 15, g4 = lane >> 4, tile = F.wave >> 1, kh = F.wave & 1;
            const int trow = rg * 64 + tile * 16 + l15;
            const float* xr32 = xsrc32 + (size_t)trow * D; const bf16* xr16 = (COMBINE ? (const bf16*)xdst16 : xsrc16) + (size_t)trow * D;
            f32x4 acc[NT];
#pragma unroll
            for (int nt = 0; nt < NT; ++nt) acc[nt] = (f32x4){0.f, 0.f, 0.f, 0.f};
#pragma unroll 8
            for (int ks = kh * 16; ks < kh * 16 + 16; ++ks) {
                const int k0 = 32 * ks + 8 * g4;
                v4u hi, lo = (v4u){0u, 0u, 0u, 0u};
                if (XF32) {
                    const f32x4 x0 = *(const f32x4*)(xr32 + k0), x1 = *(const f32x4*)(xr32 + k0 + 4);
                    const float hv[8] = {x0[0], x0[1], x0[2], x0[3], x1[0], x1[1], x1[2], x1[3]};
                    unsigned* hp = (unsigned*)&hi; unsigned* lp = (unsigned*)&lo;
#pragma unroll
                    for (int e = 0; e < 4; ++e) { const unsigned w2 = pg8::cvt_pk_bf16(hv[2 * e], hv[2 * e + 1]); hp[e] = w2;
                        lp[e] = pg8::cvt_pk_bf16(hv[2 * e] - __builtin_bit_cast(float, w2 << 16), hv[2 * e + 1] - __builtin_bit_cast(float, w2 & 0xffff0000u)); }
                } else hi = *(const v4u*)(xr16 + k0);
                const rbf16x8 Ahi = __builtin_bit_cast(rbf16x8, hi), Alo = __builtin_bit_cast(rbf16x8, lo);
#pragma unroll
                for (int nt = 0; nt < NT; ++nt) {
                    const int n = (16 * nt + l15) < NC ? (16 * nt + l15) : (NC - 1);
                    const LAS unsigned char* tp = F.lds + ((4 * ks + g4) * NC + n) * 16;
                    const rbf16x8 Bhi = *(const LAS rbf16x8*)tp, Blo = *(const LAS rbf16x8*)(tp + NC * 2048);
                    acc[nt] = __builtin_amdgcn_mfma_f32_16x16x32_bf16(Ahi, Bhi, acc[nt], 0, 0, 0);
                    if (XF32) acc[nt] = __builtin_amdgcn_mfma_f32_16x16x32_bf16(Alo, Bhi, acc[nt], 0, 0, 0);
                    acc[nt] = __builtin_amdgcn_mfma_f32_16x16x32_bf16(Ahi, Blo, acc[nt], 0, 0, 0);
                }
            }
            TS_MARK(5);
            if (kh == 1) {
#pragma unroll
                for (int nt = 0; nt < NT; ++nt) { const int n = 16 * nt + l15;
                    if (n < NC) {
#pragma unroll
                        for (int r = 0; r < 4; ++r) logit[(tile * 16 + 4 * g4 + r) * NC + n] = acc[nt][r]; } }
            }
            __syncthreads();
            if (kh == 0) {
#pragma unroll
                for (int nt = 0; nt < NT; ++nt) { const int n = 16 * nt + l15;
                    if (n < NC) {
#pragma unroll
                        for (int r = 0; r < 4; ++r) logit[(tile * 16 + 4 * g4 + r) * NC + n] += acc[nt][r]; } }
            }
            __syncthreads();
        }
        TS_MARK(3);
        if (AUX == 1) {
            if (F.tid < 64) { const int row = rg * 64 + F.tid; const LAS float* lg = logit + F.tid * NC; const float ri = rinvL[F.tid]; float* gp = (float*)(F.ws + WS_GATES) + (size_t)row * 8;
                *(f32x4*)gp = (f32x4){lg[0] * ri + cbL[0], lg[1] * ri + cbL[1], lg[2] * ri + cbL[2], lg[3] * ri + cbL[3]};
                *(f32x4*)(gp + 4) = (f32x4){lg[4] * ri + cbL[4], lg[5] * ri + cbL[5], lg[6] * ri + cbL[6], lg[7] * ri + cbL[7]}; }
            __syncthreads();
        }
        if (AUX == 2) {
            if (F.tid < 64) {
                const LAS float* lg = logit + F.tid * NC; const float ri = rinvL[F.tid];
                float gl[4];
#pragma unroll
                for (int g = 0; g < 4; ++g) gl[g] = lg[g] * ri + cbL[g] + auxb0[g];
                int gs = 0; float gm = gl[0];
#pragma unroll
                for (int g = 1; g < 4; ++g) if (gl[g] > gm) { gm = gl[g]; gs = g; }
                float den = 0.f;
#pragma unroll
                for (int g = 0; g < 4; ++g) den += __expf(gl[g] - gm);
                const float psel = 1.0f / den;
                float el[8];
#pragma unroll
                for (int q = 0; q < 8; ++q) el[q] = lg[4 + gs * 8 + q] * ri + cbL[4 + gs * 8 + q] + auxb1[gs * 8 + q];
                int i1 = 0; float l1 = el[0];
#pragma unroll
                for (int q = 1; q < 8; ++q) if (el[q] > l1) { l1 = el[q]; i1 = q; }
                int i2 = -1; float l2 = -3.0e38f;
#pragma unroll
                for (int q = 0; q < 8; ++q) if (q != i1 && el[q] > l2) { l2 = el[q]; i2 = q; }
                const float ex = __expf(l2 - l1), w1 = psel / (1.0f + ex), w2 = psel * ex / (1.0f + ex);
                rowE[2 * F.tid] = gs * 8 + i1; rowE[2 * F.tid + 1] = gs * 8 + i2; rowW[2 * F.tid] = w1; rowW[2 * F.tid + 1] = w2;
            }
            __syncthreads();
            int e = 0, lp = 0;
            if (F.tid < 128) { e = rowE[F.tid]; lp = (int)__hip_atomic_fetch_add((LAS unsigned*)(F.LC + LC_LCNT + e), 1u, __ATOMIC_RELAXED, __HIP_MEMORY_SCOPE_WORKGROUP); }
            __syncthreads();
            if (F.tid < 32) F.LC[LC_LBASE + F.tid] = __hip_atomic_fetch_add(F.ctl + CW_CNT + (layer * 32 + F.tid) * 16, F.LC[LC_LCNT + F.tid], __ATOMIC_RELAXED, __HIP_MEMORY_SCOPE_AGENT);
            __syncthreads();
            if (F.tid < 128) { const int row = rg * 64 + (F.tid >> 1); const int pos = (int)F.LC[LC_LBASE + e] + lp;
                ((int*)(F.ws + WS_SLOTTOK))[e * 16384 + pos] = row; ((int*)(F.ws + WS_TOKPOS))[row * 2 + (F.tid & 1)] = pos * 32 + e; ((float*)(F.ws + WS_TOKW))[row * 2 + (F.tid & 1)] = rowW[F.tid]; }
            __syncthreads();
        }
        TS_MARK(4);
    }
}

__device__ __forceinline__ float logsigmoid_f(float x) { return x < 0.f ? x - log1pf(__expf(x)) : -log1pf(__expf(-x)); }
__device__ __forceinline__ void p_scan(Frame& F, int j  ) {
    constexpr int QS = 132;
    LAS float* q = (LAS float*)F.lds;
    LAS float* k = q + 64 * QS;
    LAS float* Cm = k + 64 * QS;
    LAS float* vv = Cm + 32 * QS;
    LAS float* vw = vv + 64 * 32;
    LAS float* Sm = vw + 64 * 32;
    LAS float* nn = Sm + 64 * 68;
    LAS float* ga = nn + 128;
    LAS float* gM = ga + 64;
    LAS float* gb = gM + 64;
    LAS float* gden = gb + 64;
    LAS float* gm = gden + 64;
    const bf16* PROJ = (const bf16*)(F.ws + WS_PROJ);
    const float* GATES = (const float*)(F.ws + WS_GATES);
    float* HS = (float*)(F.ws + WS_HS);
    const float* bg = KIN(I_MBG) + j * 8;
    const int tid = F.tid;
    for (int item = blockIdx.x; item < 256; item += F.G) {
        const int b = item >> 5, hd = (item >> 3) & 3, vs = item & 7;
        for (int i = tid; i < 32 * QS; i += NTHR) Cm[i] = 0.f;
        if (tid < 128) nn[tid] = 0.f;
        if (tid == 0) gm[0] = 0.f;
        __syncthreads();
        for (int ch = 0; ch < 32; ++ch) {
            const int row0 = b * SEQ + ch * 64;
            for (int p = tid; p < 2048; p += NTHR) { const int isk = p >> 10, pp = p & 1023, r = pp >> 4, c8 = (pp & 15) * 8;
                const v4u w = *(const v4u*)(PROJ + (size_t)(row0 + r) * NPROJ + isk * 512 + hd * 128 + c8);
                const float sc = isk ? 1.0f : 0.08838834764831845f;
                LAS float* dst = (isk ? k : q) + r * QS + c8;
                *(LAS f32x4*)dst = (f32x4){bflo(w.x) * sc, bfhi(w.x) * sc, bflo(w.y) * sc, bfhi(w.y) * sc};
                *(LAS f32x4*)(dst + 4) = (f32x4){bflo(w.z) * sc, bfhi(w.z) * sc, bflo(w.w) * sc, bfhi(w.w) * sc}; }
            if (tid < 256) { const int r = tid >> 2, c8 = (tid & 3) * 8;
                const v4u w = *(const v4u*)(PROJ + (size_t)(row0 + r) * NPROJ + 1024 + hd * 256 + vs * 32 + c8);
                LAS float* dst = vv + r * 32 + c8;
                *(LAS f32x4*)dst = (f32x4){bflo(w.x), bfhi(w.x), bflo(w.y), bfhi(w.y)}; *(LAS f32x4*)(dst + 4) = (f32x4){bflo(w.z), bfhi(w.z), bflo(w.w), bfhi(w.w)}; }
            if (tid < 64) {
                const float ig = GATES[(size_t)(row0 + tid) * 8 + hd] + bg[hd];
                const float lf = logsigmoid_f(GATES[(size_t)(row0 + tid) * 8 + 4 + hd] + bg[4 + hd]);
                float bc = lf;
#pragma unroll
                for (int o = 1; o < 64; o <<= 1) { const float t = __shfl_up(bc, o); if (tid >= o) bc += t; }
                const float a = ig - bc;
                float pm = a;
#pragma unroll
                for (int o = 1; o < 64; o <<= 1) { const float t = __shfl_up(pm, o); if (tid >= o) pm = fmaxf(pm, t); }
                const float m = gm[0];
                ga[tid] = a; gM[tid] = fmaxf(m, pm); gb[tid] = bc;
            }
            __syncthreads();
            {
                const int s = tid & 63, t0 = (tid >> 6) * 8;
                float acc[8];
#pragma unroll
                for (int i = 0; i < 8; ++i) acc[i] = 0.f;
                for (int d4 = 0; d4 < 32; ++d4) {
                    const f32x4 kv = *(const LAS f32x4*)(k + s * QS + d4 * 4);
#pragma unroll
                    for (int i = 0; i < 8; ++i) { const f32x4 qv = *(const LAS f32x4*)(q + (t0 + i) * QS + d4 * 4); acc[i] += qv[0] * kv[0] + qv[1] * kv[1] + qv[2] * kv[2] + qv[3] * kv[3]; }
                }
                const float as = ga[s];
#pragma unroll
                for (int i = 0; i < 8; ++i) { const int t = t0 + i; Sm[t * 68 + s] = (s <= t) ? acc[i] * __expf(as - gM[t]) : 0.f; }
            }
            __syncthreads();
            {
                const int t = tid >> 3, part = tid & 7; float sden = 0.f, nq = 0.f;
#pragma unroll
                for (int s = 0; s < 8; ++s) sden += Sm[t * 68 + part * 8 + s];
#pragma unroll
                for (int d = 0; d < 16; ++d) nq += nn[part * 16 + d] * q[t * QS + part * 16 + d];
                float tot = sden + __expf(gm[0] - gM[t]) * nq;
                tot += __shfl_xor(tot, 1); tot += __shfl_xor(tot, 2); tot += __shfl_xor(tot, 4);
                if (part == 0) gden[t] = tot;
            }
            __syncthreads();
            {
                const int v = tid & 31, t0 = (tid >> 5) * 4;
                float a1[4] = {0.f, 0.f, 0.f, 0.f}, a2[4] = {0.f, 0.f, 0.f, 0.f};
                for (int s4 = 0; s4 < 16; ++s4) {
                    float vx[4];
#pragma unroll
                    for (int e = 0; e < 4; ++e) vx[e] = vv[(s4 * 4 + e) * 32 + v];
#pragma unroll
                    for (int i = 0; i < 4; ++i) { const f32x4 sv = *(const LAS f32x4*)(Sm + (t0 + i) * 68 + s4 * 4); a1[i] += sv[0] * vx[0] + sv[1] * vx[1] + sv[2] * vx[2] + sv[3] * vx[3]; }
                }
                for (int d4 = 0; d4 < 32; ++d4) {
                    const f32x4 cv = *(const LAS f32x4*)(Cm + v * QS + d4 * 4);
#pragma unroll
                    for (int i = 0; i < 4; ++i) { const f32x4 qv = *(const LAS f32x4*)(q + (t0 + i) * QS + d4 * 4); a2[i] += qv[0] * cv[0] + qv[1] * cv[1] + qv[2] * cv[2] + qv[3] * cv[3]; }
                }
                const float m = gm[0];
#pragma unroll
                for (int i = 0; i < 4; ++i) { const int t = t0 + i; const float Mt = gM[t];
                    const float num = a1[i] + __expf(m - Mt) * a2[i];
                    const float dn = fmaxf(fabsf(gden[t]), __expf(-(gb[t] + Mt)));
                    HS[(size_t)(row0 + t) * D + hd * 256 + vs * 32 + v] = num / dn; }
            }
            for (int p = tid; p < 2048; p += NTHR) { const int s = p >> 5; vw[p] = vv[p] * __expf(ga[s] - gM[63]); }
            __syncthreads();
            {
                const float decay = __expf(gm[0] - gM[63]);
                const int d = tid & 127, v0 = (tid >> 7) * 8;
                float acc[8];
#pragma unroll
                for (int i = 0; i < 8; ++i) acc[i] = decay * Cm[(v0 + i) * QS + d];
                for (int s = 0; s < 64; ++s) {
                    const float kv = k[s * QS + d];
                    const f32x4 w0 = *(const LAS f32x4*)(vw + s * 32 + v0), w1 = *(const LAS f32x4*)(vw + s * 32 + v0 + 4);
                    acc[0] += w0[0] * kv; acc[1] += w0[1] * kv; acc[2] += w0[2] * kv; acc[3] += w0[3] * kv;
                    acc[4] += w1[0] * kv; acc[5] += w1[1] * kv; acc[6] += w1[2] * kv; acc[7] += w1[3] * kv;
                }
                float nacc = 0.f;
                if (tid < 128) { nacc = decay * nn[d]; for (int s = 0; s < 64; ++s) nacc += __expf(ga[s] - gM[63]) * k[s * QS + d]; }
                __syncthreads();
#pragma unroll
                for (int i = 0; i < 8; ++i) Cm[(v0 + i) * QS + d] = acc[i];
                if (tid < 128) nn[d] = nacc;
                if (tid == 0) gm[0] = gb[63] + gM[63];
            }
            __syncthreads();
        }
    }
}

typedef short s16x4 __attribute__((ext_vector_type(4)));
typedef short sbf16x8 __attribute__((ext_vector_type(8)));
#define TR16(p) __builtin_amdgcn_ds_read_tr16_b64_v4i16((LAS s16x4*)(p))
__device__ __forceinline__ sbf16x8 cat4(s16x4 a, s16x4 b) { return __builtin_shufflevector(a, b, 0, 1, 2, 3, 4, 5, 6, 7); }
__device__ __forceinline__ f32x4 mfma16(sbf16x8 a, sbf16x8 b, f32x4 c) { return __builtin_amdgcn_mfma_f32_16x16x32_bf16(a, b, c, 0, 0, 0); }
__device__ __forceinline__ sbf16x8 pack8s(float a0, float a1, float a2, float a3, float a4, float a5, float a6, float a7) {
    v4u w; w.x = pg8::cvt_pk_bf16(a0, a1); w.y = pg8::cvt_pk_bf16(a2, a3); w.z = pg8::cvt_pk_bf16(a4, a5); w.w = pg8::cvt_pk_bf16(a6, a7); return __builtin_bit_cast(sbf16x8, w); }
__device__ __forceinline__ float bf_s(short x) { return __builtin_bit_cast(float, ((unsigned)(unsigned short)x) << 16); }
template <int NSB>
__device__ __forceinline__ void scan_chunk_body(LAS unsigned char* Qs, LAS unsigned char* Ks, LAS unsigned char* Vs, LAS unsigned char* Vw, LAS unsigned char* Cr, LAS unsigned char* Cw,
                                                const LAS float* WS, const LAS float* ETS, const LAS float* WI, const LAS float* EM, const LAS unsigned short* WSB, const LAS float* DEC,
                                                const int ch, const int tb, const int vt, const int w, const int l15, const int g, const int ql, const int pl, f32x4 (&accC)[3], bf16* orow) {
            constexpr int QB = 272, VB = 80;
            const sbf16x8 ones = (sbf16x8){0x3F80, 0x3F80, 0x3F80, 0x3F80, 0x3F80, 0x3F80, 0x3F80, 0x3F80};
            const int tt = tb * 16 + l15;
            sbf16x8 qf[4], kf[NSB][4]; f32x4 wv[NSB];
#pragma unroll
            for (int kd = 0; kd < 4; ++kd) qf[kd] = *(const LAS sbf16x8*)(Qs + (tb * 16 + l15) * QB + (32 * kd + 8 * g) * 2);
#pragma unroll
            for (int kd = 0; kd < 4; ++kd)
#pragma unroll
                for (int sb = 0; sb < NSB; ++sb) kf[sb][kd] = *(const LAS sbf16x8*)(Ks + (sb * 16 + l15) * QB + (32 * kd + 8 * g) * 2);
            const float ets = ETS[ch * 64 + tt];
#pragma unroll
            for (int sb = 0; sb < NSB; ++sb) wv[sb] = *(const LAS f32x4*)(WS + ch * 64 + sb * 16 + 4 * g);
            __builtin_amdgcn_sched_barrier(0);
            f32x4 sacc[NSB]; f32x4 pv = (f32x4){0.f, 0.f, 0.f, 0.f}, qc = pv, qn = pv, psum = pv;
#pragma unroll
            for (int sb = 0; sb < NSB; ++sb) sacc[sb] = (f32x4){0.f, 0.f, 0.f, 0.f};
#pragma unroll
            for (int kd = 0; kd < 4; ++kd) {
#pragma unroll
                for (int sb = 0; sb < NSB; ++sb) sacc[sb] = mfma16(kf[sb][kd], qf[kd], sacc[sb]);
            }
            __builtin_amdgcn_sched_barrier(0);
            sbf16x8 cf[4], nf[4]; s16x4 va[2], vb[2];
#pragma unroll
            for (int ks = 0; ks < 2; ++ks) { va[ks] = TR16(Vs + (32 * ks + 4 * g + ql) * VB + (16 * vt + 4 * pl) * 2); vb[ks] = TR16(Vs + (32 * ks + 16 + 4 * g + ql) * VB + (16 * vt + 4 * pl) * 2); }
#pragma unroll
            for (int kd = 0; kd < 4; ++kd) { cf[kd] = *(const LAS sbf16x8*)(Cr + (16 * vt + l15) * QB + (32 * kd + 8 * g) * 2); nf[kd] = *(const LAS sbf16x8*)(Cr + (32 + l15) * QB + (32 * kd + 8 * g) * 2); }
            const f32x4 wiv = *(const LAS f32x4*)(WI + ch * 64 + tb * 16 + 4 * g), emv = *(const LAS f32x4*)(EM + ch * 64 + tb * 16 + 4 * g);
            __builtin_amdgcn_sched_barrier(0);
            float P[4][4];
#pragma unroll
            for (int sb = 0; sb < 4; ++sb) {
                if (sb < NSB) {
#pragma unroll
                    for (int r = 0; r < 4; ++r) P[sb][r] = ((sb * 16 + 4 * g + r) <= tt) ? sacc[sb < NSB ? sb : 0][r] * wv[sb < NSB ? sb : 0][r] * ets : 0.f;
                } else {
#pragma unroll
                    for (int r = 0; r < 4; ++r) P[sb][r] = 0.f;
                }
            }
#pragma unroll
            for (int ks = 0; ks < 2; ++ks) {
                const sbf16x8 pf = pack8s(P[2 * ks][0], P[2 * ks][1], P[2 * ks][2], P[2 * ks][3], P[2 * ks + 1][0], P[2 * ks + 1][1], P[2 * ks + 1][2], P[2 * ks + 1][3]);
                pv = mfma16(pf, cat4(va[ks], vb[ks]), pv); psum = mfma16(pf, ones, psum);
            }
#pragma unroll
            for (int kd = 0; kd < 4; ++kd) { qc = mfma16(qf[kd], cf[kd], qc); qn = mfma16(qf[kd], nf[kd], qn); }
            __builtin_amdgcn_sched_barrier(0);
            s16x4 k0[2], k1[2], x0[2][2], x1[2][2]; sbf16x8 of[2];
#pragma unroll
            for (int ks = 0; ks < 2; ++ks) {
                const int sr = 32 * ks + 8 * g;
                k0[ks] = TR16(Ks + (sr + ql) * QB + (16 * w + 4 * pl) * 2); k1[ks] = TR16(Ks + (sr + 4 + ql) * QB + (16 * w + 4 * pl) * 2);
#pragma unroll
                for (int v = 0; v < 2; ++v) { x0[ks][v] = TR16(Vw + (sr + ql) * VB + (16 * v + 4 * pl) * 2); x1[ks][v] = TR16(Vw + (sr + 4 + ql) * VB + (16 * v + 4 * pl) * 2); }
                of[ks] = *(const LAS sbf16x8*)(WSB + ch * 64 + sr);
            }
            const float decay = DEC[ch];
            __builtin_amdgcn_sched_barrier(0);
#pragma unroll
            for (int r = 0; r < 4; ++r) { const float den = psum[r] + wiv[r] * qn[r], num = pv[r] + wiv[r] * qc[r]; orow[(size_t)r * D] = (bf16)f2bf(num * __builtin_amdgcn_rcpf(fmaxf(fabsf(den), emv[r]))); }
#pragma unroll
            for (int v = 0; v < 3; ++v) accC[v] = accC[v] * decay;
#pragma unroll
            for (int ks = 0; ks < 2; ++ks) {
                const sbf16x8 kt = cat4(k0[ks], k1[ks]);
#pragma unroll
                for (int v = 0; v < 2; ++v) accC[v] = mfma16(kt, cat4(x0[ks][v], x1[ks][v]), accC[v]);
                accC[2] = mfma16(kt, of[ks], accC[2]);
            }
#pragma unroll
            for (int v = 0; v < 3; ++v) { v2u o; o.x = pg8::cvt_pk_bf16(accC[v][0], accC[v][1]); o.y = pg8::cvt_pk_bf16(accC[v][2], accC[v][3]); *(LAS v2u*)(Cw + (16 * v + l15) * QB + (16 * w + 4 * g) * 2) = o; }
}
__device__ __forceinline__ void p_scan_mfma(Frame& F, int j, bf16* HS) {
    constexpr int QB = 272, VB = 80;
    constexpr int OFF_Q = 0, OFF_K = 2 * 64 * QB, OFF_V = 4 * 64 * QB, OFF_VW = OFF_V + 2 * 64 * VB, OFF_C = OFF_VW + 2 * 64 * VB;
    constexpr int OFF_WS = OFF_C + 2 * 48 * QB, OFF_ETS = OFF_WS + 8192, OFF_WI = OFF_ETS + 8192, OFF_EM = OFF_WI + 8192, OFF_WSB = OFF_EM + 8192, OFF_DEC = OFF_WSB + 4096, OFF_PM63 = OFF_DEC + 128, OFF_B63 = OFF_PM63 + 128;
    static_assert(OFF_B63 + 128 <= LDSCTL_OFF, "scan LDS map");
    LAS unsigned char* L = F.lds;
    const int tid = F.tid, lane = F.lane, w = F.wave, l15 = lane & 15, g = lane >> 4, ql = l15 >> 2, pl = l15 & 3, tb = w & 3, vt = w >> 2;
    LAS float* WS = (LAS float*)(L + OFF_WS); LAS float* ETS = (LAS float*)(L + OFF_ETS); LAS float* WI = (LAS float*)(L + OFF_WI); LAS float* EM = (LAS float*)(L + OFF_EM);
    LAS unsigned short* WSB = (LAS unsigned short*)(L + OFF_WSB); LAS float* DEC = (LAS float*)(L + OFF_DEC); LAS float* PM63 = (LAS float*)(L + OFF_PM63); LAS float* B63 = (LAS float*)(L + OFF_B63);
    const bf16* PROJ = (const bf16*)(F.ws + WS_PROJ);
    const float* GATES = (const float*)(F.ws + WS_GATES);
    const float* bg = KIN(I_MBG) + j * 8;
    const float scale = 0.08838834764831845f;
    const sbf16x8 ones = (sbf16x8){0x3F80, 0x3F80, 0x3F80, 0x3F80, 0x3F80, 0x3F80, 0x3F80, 0x3F80};
    for (int item0 = blockIdx.x; item0 < 256; item0 += F.G) {
        const int item = (((item0 & 7) * 4 + (item0 >> 6)) << 3) | ((item0 >> 3) & 7);
        const int b = item >> 5, hd = (item >> 3) & 3, vs = item & 7;
        const float bi = bg[hd], bfg = bg[4 + hd];
        const bf16* qbase = PROJ + (size_t)(b * SEQ) * NPROJ + hd * 128;
        const bf16* vbase = PROJ + (size_t)(b * SEQ) * NPROJ + 1024 + hd * 256 + vs * 32;
        const float* gbase = GATES + (size_t)(b * SEQ) * 8 + hd;
#ifdef SCAN_ZERO_LDS
        for (int i = tid; i < (OFF_B63 + 128) / 4; i += NTHR) ((LAS unsigned*)L)[i] = 0u;
        __syncthreads();
#endif
        for (int i = tid; i < 48 * QB / 4; i += NTHR) ((LAS unsigned*)(L + OFF_C))[i] = 0u;
#pragma unroll
        for (int cc = 0; cc < 4; ++cc) {
            const int c = 4 * w + cc, pos = c * 64 + lane;
            const float ipre = gbase[(size_t)pos * 8] + bi, lf = logsigmoid_f(gbase[(size_t)pos * 8 + 4] + bfg);
            float bc = lf;
#pragma unroll
            for (int o = 1; o < 64; o <<= 1) { const float t = __shfl_up(bc, o); if (lane >= o) bc += t; }
            const float a = ipre - bc;
            float pm = a;
#pragma unroll
            for (int o = 1; o < 64; o <<= 1) { const float t = __shfl_up(pm, o); if (lane >= o) pm = fmaxf(pm, t); }
            WS[pos] = a; ETS[pos] = bc; WI[pos] = pm;
            if (lane == 63) { PM63[c] = pm; B63[c] = bc; }
        }
        __syncthreads();
        {
            float mw[4] = {0.f, 0.f, 0.f, 0.f}; float mc = 0.f;
#pragma unroll
            for (int c = 0; c < 32; ++c) { if ((c >> 2) == w) mw[c & 3] = mc; mc = B63[c] + fmaxf(mc, PM63[c]); }
#pragma unroll
            for (int cc = 0; cc < 4; ++cc) {
                const int c = 4 * w + cc, pos = c * 64 + lane; const float m_c = mw[cc];
                const float a = WS[pos], bc = ETS[pos], pm = WI[pos];
                const float M63 = fmaxf(m_c, PM63[c]), Mt = fmaxf(m_c, pm);
                const float wsv = __expf(a - M63);
                WS[pos] = wsv; WSB[pos] = (unsigned short)f2bf(wsv); ETS[pos] = __expf(M63 - Mt) * scale; WI[pos] = __expf(m_c - Mt) * scale; EM[pos] = __expf(-(bc + Mt));
                if (lane == 0) DEC[c] = __expf(m_c - M63);
            }
        }
        __syncthreads();
        f32x4 accC[3];
#pragma unroll
        for (int v = 0; v < 3; ++v) accC[v] = (f32x4){0.f, 0.f, 0.f, 0.f};
        const int sr0 = tid >> 4, sc0 = (tid & 15) * 8, svr = (tid >> 2) & 63, svc = (tid & 3) * 8;
        const bf16* gq = qbase + (size_t)sr0 * NPROJ + sc0; const bf16* gv = vbase + (size_t)svr * NPROJ + svc;
        const int lq0 = sr0 * QB + sc0 * 2, lv0 = svr * VB + svc * 2;
        v4u qr[2], kr[2], vr = (v4u){0u, 0u, 0u, 0u};
#pragma unroll
        for (int i = 0; i < 2; ++i) { qr[i] = *(const v4u*)(gq + (size_t)(32 * i) * NPROJ); kr[i] = *(const v4u*)(gq + (size_t)(32 * i) * NPROJ + 512); }
        if (tid < 256) vr = *(const v4u*)gv;
#define SCAN_STAGE(buf, chn) do { \
            _Pragma("unroll") for (int i = 0; i < 2; ++i) { *(LAS v4u*)(L + OFF_Q + (buf) * 64 * QB + lq0 + 32 * i * QB) = qr[i]; *(LAS v4u*)(L + OFF_K + (buf) * 64 * QB + lq0 + 32 * i * QB) = kr[i]; } \
            if (tid < 256) { *(LAS v4u*)(L + OFF_V + (buf) * 64 * VB + lv0) = vr; const float wsr = WS[(chn) * 64 + svr]; \
                v4u sw; sw.x = pg8::cvt_pk_bf16(bflo(vr.x) * wsr, bfhi(vr.x) * wsr); sw.y = pg8::cvt_pk_bf16(bflo(vr.y) * wsr, bfhi(vr.y) * wsr); sw.z = pg8::cvt_pk_bf16(bflo(vr.z) * wsr, bfhi(vr.z) * wsr); sw.w = pg8::cvt_pk_bf16(bflo(vr.w) * wsr, bfhi(vr.w) * wsr); \
                *(LAS v4u*)(L + OFF_VW + (buf) * 64 * VB + lv0) = sw; } } while (0)
        SCAN_STAGE(0, 0);
        __syncthreads();
        bf16* obase = HS + (size_t)(b * SEQ + tb * 16 + 4 * g) * D + hd * 256 + vs * 32 + vt * 16 + l15;
        for (int ch = 0; ch < 32; ++ch) {
            const int cb = ch & 1, nb = cb ^ 1;
            LAS unsigned char* Qs = L + OFF_Q + cb * 64 * QB; LAS unsigned char* Ks = L + OFF_K + cb * 64 * QB; LAS unsigned char* Vs = L + OFF_V + cb * 64 * VB; LAS unsigned char* Vw = L + OFF_VW + cb * 64 * VB;
            LAS unsigned char* Cr = L + OFF_C + cb * 48 * QB; LAS unsigned char* Cw = L + OFF_C + nb * 48 * QB;
            { const size_t nro = (size_t)((ch < 31 ? ch + 1 : ch) * 64) * NPROJ;
#pragma unroll
              for (int i = 0; i < 2; ++i) { qr[i] = *(const v4u*)(gq + nro + (size_t)(32 * i) * NPROJ); kr[i] = *(const v4u*)(gq + nro + (size_t)(32 * i) * NPROJ + 512); }
              if (tid < 256) vr = *(const v4u*)(gv + nro); }
            { bf16* orow = obase + (size_t)(ch * 64) * D;
              if (tb == 0) scan_chunk_body<1>(Qs, Ks, Vs, Vw, Cr, Cw, WS, ETS, WI, EM, WSB, DEC, ch, tb, vt, w, l15, g, ql, pl, accC, orow);
              else if (tb == 1) scan_chunk_body<2>(Qs, Ks, Vs, Vw, Cr, Cw, WS, ETS, WI, EM, WSB, DEC, ch, tb, vt, w, l15, g, ql, pl, accC, orow);
              else if (tb == 2) scan_chunk_body<3>(Qs, Ks, Vs, Vw, Cr, Cw, WS, ETS, WI, EM, WSB, DEC, ch, tb, vt, w, l15, g, ql, pl, accC, orow);
              else scan_chunk_body<4>(Qs, Ks, Vs, Vw, Cr, Cw, WS, ETS, WI, EM, WSB, DEC, ch, tb, vt, w, l15, g, ql, pl, accC, orow); }
#ifdef SCAN_EXTRA_SYNC
            __syncthreads();
#endif
            SCAN_STAGE(nb, (ch < 31 ? ch + 1 : ch));
            __syncthreads();
        }
#undef SCAN_STAGE
    }
}

__device__ __forceinline__ void p_mnorm(Frame& F, int j) {
    const bf16* HS = (const bf16*)(F.ws + WS_HS); const bf16* PROJ = (const bf16*)(F.ws + WS_PROJ); bf16* A2 = (bf16*)(F.ws + WS_A2);
    const float* ng = KIN(I_MNORMG) + j * 1024;
    const int gw = blockIdx.x * NWAVES + F.wave, NGW = F.G * NWAVES, lane = F.lane;
    f32x4 g[4];
#pragma unroll
    for (int hd = 0; hd < 4; ++hd) g[hd] = *((const f32x4*)ng + lane + 64 * hd);
    for (int row0 = gw * 2; row0 < NTOK; row0 += NGW * 2) {
        f32x4 v[2][4]; v2u ow[2][4];
#pragma unroll
        for (int r = 0; r < 2; ++r)
#pragma unroll
            for (int hd = 0; hd < 4; ++hd) { const v2u hw = *((const v2u*)(HS + (size_t)(row0 + r) * D) + lane + 64 * hd); v[r][hd] = (f32x4){bflo(hw.x), bfhi(hw.x), bflo(hw.y), bfhi(hw.y)}; ow[r][hd] = *((const v2u*)(PROJ + (size_t)(row0 + r) * NPROJ + 2048) + lane + 64 * hd); }
#pragma unroll
        for (int r = 0; r < 2; ++r)
#pragma unroll
            for (int hd = 0; hd < 4; ++hd) {
                const f32x4 x = v[r][hd];
                const float ss = wave_sum((x[0] * x[0] + x[1] * x[1]) + (x[2] * x[2] + x[3] * x[3]));
                const float rinv = 1.0f / sqrtf(ss * (1.0f / 256.0f) + EPS);
                const float o0 = bflo(ow[r][hd].x), o1 = bfhi(ow[r][hd].x), o2 = bflo(ow[r][hd].y), o3 = bfhi(ow[r][hd].y);
                f32x4 q;
                q[0] = x[0] * rinv * g[hd][0] * __builtin_amdgcn_rcpf(1.0f + __expf(-o0)); q[1] = x[1] * rinv * g[hd][1] * __builtin_amdgcn_rcpf(1.0f + __expf(-o1));
                q[2] = x[2] * rinv * g[hd][2] * __builtin_amdgcn_rcpf(1.0f + __expf(-o2)); q[3] = x[3] * rinv * g[hd][3] * __builtin_amdgcn_rcpf(1.0f + __expf(-o3));
                v2u o; o.x = pk2(q[0], q[1]); o.y = pk2(q[2], q[3]);
                *((v2u*)(A2 + (size_t)(row0 + r) * D) + lane + 64 * hd) = o;
            }
    }
}

__device__ __forceinline__ void p_conv(Frame& F, int j) {
    const bf16* PROJ = (const bf16*)(F.ws + WS_PROJ); bf16* A2 = (bf16*)(F.ws + WS_A2);
    const float* cw = KIN(I_SCONVW) + (size_t)j * 3 * 1024;
    for (int item = blockIdx.x * NTHR + F.tid; item < (NTOK / 16) * 128; item += F.G * NTHR) {
        const int cg = item & 127, rc = item >> 7, row0 = rc * 16, ch = cg * 8;
        float w0[8], w1[8], w2[8], um2[8], um1[8];
#pragma unroll
        for (int c = 0; c < 8; ++c) { w0[c] = cw[ch + c]; w1[c] = cw[1024 + ch + c]; w2[c] = cw[2048 + ch + c]; um2[c] = 0.f; um1[c] = 0.f; }
        if ((row0 & (SEQ - 1)) != 0) {
            const v4u a = *(const v4u*)(PROJ + (size_t)(row0 - 2) * NPROJ + ch), bq = *(const v4u*)(PROJ + (size_t)(row0 - 1) * NPROJ + ch);
            um2[0] = bflo(a.x); um2[1] = bfhi(a.x); um2[2] = bflo(a.y); um2[3] = bfhi(a.y); um2[4] = bflo(a.z); um2[5] = bfhi(a.z); um2[6] = bflo(a.w); um2[7] = bfhi(a.w);
            um1[0] = bflo(bq.x); um1[1] = bfhi(bq.x); um1[2] = bflo(bq.y); um1[3] = bfhi(bq.y); um1[4] = bflo(bq.z); um1[5] = bfhi(bq.z); um1[6] = bflo(bq.w); um1[7] = bfhi(bq.w);
        }
        for (int r = 0; r < 16; ++r) {
            const v4u uw = *(const v4u*)(PROJ + (size_t)(row0 + r) * NPROJ + ch), gw = *(const v4u*)(PROJ + (size_t)(row0 + r) * NPROJ + 1024 + ch);
            float u0[8], g[8], y[8];
            u0[0] = bflo(uw.x); u0[1] = bfhi(uw.x); u0[2] = bflo(uw.y); u0[3] = bfhi(uw.y); u0[4] = bflo(uw.z); u0[5] = bfhi(uw.z); u0[6] = bflo(uw.w); u0[7] = bfhi(uw.w);
            g[0] = bflo(gw.x); g[1] = bfhi(gw.x); g[2] = bflo(gw.y); g[3] = bfhi(gw.y); g[4] = bflo(gw.z); g[5] = bfhi(gw.z); g[6] = bflo(gw.w); g[7] = bfhi(gw.w);
#pragma unroll
            for (int c = 0; c < 8; ++c) { y[c] = g[c] * (w0[c] * um2[c] + w1[c] * um1[c] + w2[c] * u0[c]); um2[c] = um1[c]; um1[c] = u0[c]; }
            v4u o; o.x = pk2(y[0], y[1]); o.y = pk2(y[2], y[3]); o.z = pk2(y[4], y[5]); o.w = pk2(y[6], y[7]);
            *(v4u*)(A2 + (size_t)(row0 + r) * D + ch) = o;
        }
    }
}

constexpr int N_STEPS = 2 + 2 * (8 + 7);
__global__ void __launch_bounds__(NTHR, 2) trunk_fwd(Args args) {
    extern __shared__ __attribute__((aligned(16))) unsigned char lds_raw[];
    Frame F;
    F.lds = (LAS unsigned char*)lds_raw;
    F.LC = (volatile LAS unsigned*)(F.lds + LDSCTL_OFF);
    F.tid = threadIdx.x; F.lane = F.tid & 63; F.wave = __builtin_amdgcn_readfirstlane(F.tid >> 6); F.G = gridDim.x;
    F.out = as_global(args.out); F.ws = as_global(args.ws); F.ctl = as_global((unsigned*)(args.ws + WS_CTL));
    for (int u = F.tid; u < 256; u += NTHR) F.LC[u] = 0u;
    __syncthreads();
    if (!N_LAUNCH_SPLIT) (void)xcd_barrier_post(F.ctl + CW_BAR, F.LC);
    const int lo = N_LAUNCH_SPLIT ? args.ph_lo : 0, hi = N_LAUNCH_SPLIT ? args.ph_hi : N_STEPS;
    int step = 0;
#ifndef EN_MASK
#define EN_MASK 0xFFFFFFFFu
#endif
#define EN(k) (((EN_MASK) >> (k)) & 1u)
#ifndef OUTPROJ_WGM
#define OUTPROJ_WGM 4
#endif
#ifndef INPROJ_WGM
#define INPROJ_WGM 4
#endif
#ifndef MOE_WGM
#define MOE_WGM 4
#endif
#ifndef BAR_REP
#define BAR_REP 0
#endif
#ifndef REP_MASK
#define REP_MASK 0u
#endif
#define REP(k) for (int _r = 0; _r < 1 + (int)(((REP_MASK) >> (k)) & 1u); ++_r)
#define IN_STEP() (lo <= step && step < hi)
#ifdef TPROBE
    int tp_cur = -1; unsigned long long tp_t0 = 0;
#define TP0(k) tp_cur = (k); if (TPROBE == (k)) tp_t0 = __builtin_amdgcn_s_memrealtime();
#define TP_PRE() unsigned long long _t1 = 0; if (tp_cur == TPROBE) { asm volatile("s_waitcnt vmcnt(0)" ::: "memory"); __syncthreads(); _t1 = __builtin_amdgcn_s_memrealtime(); \
        if (TPMODE == 0 && threadIdx.x == 0) atomicMax(F.ctl + 80, (unsigned)(_t1 - tp_t0)); }
#define TP_POST() if (tp_cur == TPROBE && TPMODE != 0 && threadIdx.x == 0) { const unsigned d = (unsigned)(__builtin_amdgcn_s_memrealtime() - _t1); atomicMax(F.ctl + 80, TPMODE == 1 ? 0x40000000u - d : d); }
#else
#define TP0(k)
#define TP_PRE()
#define TP_POST()
#endif
#define END_STEP() do { TP_PRE(); if (!N_LAUNCH_SPLIT) { XcdBarrier _b; _b.bar = (unsigned*)launder(F.ws) + CW_BAR; _b.x = xb_xcc_id(); _b.st = F.LC; xcd_barrier(_b); if (BAR_REP) xcd_barrier(_b); } TP_POST(); ++step; } while (0)
#define X (launder(F.out))
#define WSB (launder(F.ws))
#define XS ((bf16*)(WSB + WS_X))
#define MOD ((const float*)(WSB + WS_MOD))
#define H ((bf16*)(WSB + WS_H))
#define PROJ ((bf16*)(WSB + WS_PROJ))
#define A2 ((bf16*)(WSB + WS_A2))

    TP0(0) if (EN(0) && IN_STEP()) { Frame P = fresh(F); REP(15) { p_adaln(P); __syncthreads(); } REP(0) { p_convert(P); } } END_STEP();
    TP0(1) if (EN(1) && IN_STEP()) REP(1) { Frame P = fresh(F); p_rtab(P); row_phase<false, 1, false, true>(P, KIN(I_X), nullptr, MOD, KIN(I_NORMG), nullptr, 0, KIN(I_MWIN), nullptr, nullptr, nullptr, 0); } END_STEP();

    for (int l = 0; l < DEPTH; ++l) {
        const int lp = l >> 1;
        if ((l & 1) == 0) {
            TP0(2) if (EN(2) && IN_STEP()) REP(2) { pg8::DenseSched S; S.T.init(NTOK / 256, NPROJ / 256, pg8::opaque_s(F.G), pg8::opaque_s((int)blockIdx.x), INPROJ_WGM); S.A = (const char*)H; S.Bt = (const char*)(WSB + WS_WMIN) + (size_t)lp * 3072 * 1024 * 2; S.K = 1024;
                pg8::EpiStoreBf16 E{PROJ, NPROJ, 1.0f}; pg8::gemm_phase<pg8::EpiStoreBf16, pg8::DenseSched, true>(F.lds, 1024, S, E); } END_STEP();
            TP0(3) if (EN(3) && IN_STEP()) REP(3) { Frame P = fresh(F); p_scan_mfma(P, lp, (bf16*)(P.ws + WS_HS));
#ifdef SCAN_SELFCHECK
                { float* H1 = (float*)(P.ws + WS_HMID); float* H2 = (float*)(P.ws + WS_END);
                  __syncthreads(); p_scan_mfma(P, lp, H1); __syncthreads(); p_scan_mfma(P, lp, H2); asm volatile("s_waitcnt vmcnt(0)" ::: "memory"); __syncthreads();
                  for (int item = blockIdx.x; item < 256; item += P.G) { const int b = item >> 5, hd = (item >> 3) & 3, vs = item & 7; int bad = 0;
                      for (int i = P.tid; i < 2048 * 32; i += NTHR) { const size_t o = (size_t)(b * SEQ + (i >> 5)) * D + hd * 256 + vs * 32 + (i & 31);
                          const unsigned a1 = __hip_atomic_load((const unsigned*)H1 + o, __ATOMIC_RELAXED, __HIP_MEMORY_SCOPE_AGENT), a2 = __hip_atomic_load((const unsigned*)H2 + o, __ATOMIC_RELAXED, __HIP_MEMORY_SCOPE_AGENT); if (a1 != a2) bad = 1; }
                      if (bad) __hip_atomic_fetch_or(P.ctl + 64, 1u, __ATOMIC_RELAXED, __HIP_MEMORY_SCOPE_AGENT); } }
#endif
#ifdef SCAN_BOTH
                __syncthreads(); p_scan(P, lp);
#endif
            } END_STEP();
            TP0(4) if (EN(4) && IN_STEP()) REP(4) { Frame P = fresh(F); p_mnorm(P, lp); } END_STEP();
            TP0(5) if (EN(5) && IN_STEP()) REP(5) { pg8::DenseSched S; S.T.init(NTOK / 256, 4, pg8::opaque_s(F.G), pg8::opaque_s((int)blockIdx.x), OUTPROJ_WGM); S.A = (const char*)A2; S.Bt = (const char*)(WSB + WS_WMOUT) + (size_t)lp * 1024 * 1024 * 2; S.K = 1024;
                pg8::EpiResid E{l == 0 ? KIN(I_X) : (const float*)nullptr, XS, MOD + (size_t)(l * 2) * 8 * 3072 + 2048}; pg8::gemm_phase<pg8::EpiResid, pg8::DenseSched, true>(F.lds, 1024, S, E); } END_STEP();
        } else {
            TP0(10) if (EN(10) && IN_STEP()) REP(10) { pg8::DenseSched S; S.T.init(NTOK / 256, NPROJ / 256, pg8::opaque_s(F.G), pg8::opaque_s((int)blockIdx.x), INPROJ_WGM); S.A = (const char*)H; S.Bt = (const char*)(WSB + WS_WSIN) + (size_t)lp * 3072 * 1024 * 2; S.K = 1024;
                pg8::EpiConvIn E{PROJ, NPROJ}; pg8::gemm_phase<pg8::EpiConvIn, pg8::DenseSched, true>(F.lds, 1024, S, E); } END_STEP();
            TP0(11) if (EN(11) && IN_STEP()) REP(11) { Frame P = fresh(F); p_conv(P, lp); } END_STEP();
            TP0(12) if (EN(12) && IN_STEP()) REP(12) { pg8::DenseSched S; S.T.init(NTOK / 256, 4, pg8::opaque_s(F.G), pg8::opaque_s((int)blockIdx.x), OUTPROJ_WGM); S.A = (const char*)A2; S.Bt = (const char*)(WSB + WS_WSOUT) + (size_t)lp * 1024 * 1024 * 2; S.K = 1024;
                pg8::EpiResid E{nullptr, XS, MOD + (size_t)(l * 2) * 8 * 3072 + 2048}; pg8::gemm_phase<pg8::EpiResid, pg8::DenseSched, true>(F.lds, 1024, S, E); } END_STEP();
        }
        TP0(6) if (EN(6) && IN_STEP()) REP(6) { Frame P = fresh(F); row_phase<false, 2, false>(P, XS, nullptr, MOD + (size_t)(l * 2 + 1) * 8 * 3072, KIN(I_NORMG) + (l * 2 + 1) * 1024, nullptr, 0,
                                                  KIN(I_RWG) + (size_t)l * 1024 * 4, KIN(I_RWE) + (size_t)l * 1024 * 32, KIN(I_RBG) + l * 4, KIN(I_RBE) + l * 32, l + 4 * _r); } END_STEP();
        TP0(7) if (EN(7) && IN_STEP()) REP(7) { Frame P = fresh(F); moe_tables(P, l); pg8::GuSched S; S.T.init((int)F.LC[LC_TOFF + 32], 4, pg8::opaque_s(F.G), pg8::opaque_s((int)blockIdx.x), MOE_WGM); S.A = (const char*)H; S.K = 512; S.Bt = (const char*)(WSB + WS_WGU) + (size_t)l * 32 * 1024 * 1024;
            S.slot_tok = (const int*)(WSB + WS_SLOTTOK); S.toff = (const PG8_LAS int*)(F.lds + LDSCTL_OFF + LC_TOFF * 4); S.cnt = (const PG8_LAS int*)(F.lds + LDSCTL_OFF + LC_CNT * 4); S.soff = (const PG8_LAS int*)(F.lds + LDSCTL_OFF + LC_SOFF * 4); S.sexp = (const PG8_LAS int*)(F.lds + LDSCTL_OFF + LC_SEXP * 4);
            pg8::EpiGateUp E{(unsigned char*)(WSB + WS_HMID)}; pg8::gemm_phase<pg8::EpiGateUp, pg8::GuSched, true, true>(F.lds, 512, S, E); } END_STEP();
        TP0(8) if (EN(8) && IN_STEP()) REP(8) { Frame P = fresh(F); moe_tables(P, l); pg8::DnSched S; S.T.init((int)F.LC[LC_TOFF + 32], 4, pg8::opaque_s(F.G), pg8::opaque_s((int)blockIdx.x), MOE_WGM); S.A = (const char*)(WSB + WS_HMID); S.K = 256; S.Bt = (const char*)(WSB + WS_WDN) + (size_t)l * 32 * 1024 * 512;
            S.toff = (const PG8_LAS int*)(F.lds + LDSCTL_OFF + LC_TOFF * 4); S.soff = (const PG8_LAS int*)(F.lds + LDSCTL_OFF + LC_SOFF * 4); S.sexp = (const PG8_LAS int*)(F.lds + LDSCTL_OFF + LC_SEXP * 4);
            pg8::EpiStoreF8 E{(unsigned char*)(WSB + WS_YR), 1024}; pg8::gemm_phase<pg8::EpiStoreF8, pg8::DnSched, true, true>(F.lds, 256, S, E); } END_STEP();
        if (l == 3) {
            TP0(14) if (EN(14) && IN_STEP()) REP(14) { Frame P = fresh(F); row_phase<true, 0, true>(P, XS, X, nullptr, KIN(I_FINALG), MOD + (size_t)(l * 2 + 1) * 8 * 3072, l, nullptr, nullptr, nullptr, nullptr, 0); } ++step;
        } else if (l == 1) {
            TP0(13) if (EN(13) && IN_STEP()) REP(13) { Frame P = fresh(F); row_phase<true, 1, false>(P, XS, XS, MOD + (size_t)((l + 1) * 2) * 8 * 3072, KIN(I_NORMG) + ((l + 1) * 2) * 1024, MOD + (size_t)(l * 2 + 1) * 8 * 3072, l,
                                                     KIN(I_MWIN) + (size_t)1 * 1024 * M_PROJ, nullptr, nullptr, nullptr, 0); } END_STEP();
        } else {
            TP0(9) if (EN(9) && IN_STEP()) REP(9) { Frame P = fresh(F); row_phase<true, 0, false>(P, XS, XS, MOD + (size_t)((l + 1) * 2) * 8 * 3072, KIN(I_NORMG) + ((l + 1) * 2) * 1024, MOD + (size_t)(l * 2 + 1) * 8 * 3072, l, nullptr, nullptr, nullptr, nullptr, 0); } END_STEP();
        }
    }
#if defined(TPROBE) || defined(TPSUB)
#ifndef TPMODE
#define TPMODE 0
#endif
    __syncthreads();
    if (blockIdx.x == 0 && threadIdx.x == 0) { asm volatile("s_waitcnt vmcnt(0)" ::: "memory"); unsigned d = __hip_atomic_load(F.ctl + 80, __ATOMIC_RELAXED, __HIP_MEMORY_SCOPE_AGENT); if (TPMODE == 1) d = 0x40000000u - d;
        F.out[0] = (float)d * (0.01f / (float)(TPSCALE)); }
#endif
#undef IN_STEP
#undef END_STEP
#undef X
#undef WSB
#undef XS
#undef MOD
#undef H
#undef PROJ
#undef A2
}

extern "C" void kernel_launch(void* const* d_in, const int* in_sizes, int n_in, void* d_out, int out_size, void* d_ws, size_t ws_size, hipStream_t stream) {
    static int grid = 0;
    if (grid == 0) {
        if (n_in != 20 || in_sizes[0] != NTOK * D || out_size != NTOK * D || ws_size < WS_END) { fprintf(stderr, "kernel_launch: unexpected shapes (n_in %d, ws %zu)\n", n_in, ws_size); grid = -1; return; }
        int dev = 0, cus = 0, per_cu = 0;
        if (hipGetDevice(&dev) != hipSuccess || hipDeviceGetAttribute(&cus, hipDeviceAttributeMultiprocessorCount, dev) != hipSuccess) { grid = -1; return; }
        if (hipFuncSetAttribute((const void*)trunk_fwd, hipFuncAttributeMaxDynamicSharedMemorySize, LDS_BYTES) != hipSuccess) { fprintf(stderr, "kernel_launch: hipFuncSetAttribute failed\n"); grid = -1; return; }
        if (hipOccupancyMaxActiveBlocksPerMultiprocessor(&per_cu, (const void*)trunk_fwd, NTHR, LDS_BYTES) != hipSuccess || per_cu < 1) fprintf(stderr, "kernel_launch: occupancy query reports %d\n", per_cu);
        (void)hipGetLastError();
        grid = cus;
    }
    if (grid < 0) return;
    if (hipMemsetAsync((char*)d_ws + WS_CTL, 0, CTL_ZERO_BYTES, stream) != hipSuccess) return;
    Args a{};
    for (int i = 0; i < 20; ++i) a.in[i] = (const float*)d_in[i];
    a.out = (float*)d_out; a.ws = (unsigned char*)d_ws;
    if (N_LAUNCH_SPLIT) {
        for (int s = 0; s < N_STEPS; ++s) { a.ph_lo = s; a.ph_hi = s + 1; hipLaunchKernelGGL(trunk_fwd, dim3(grid), dim3(NTHR), LDS_BYTES, stream, a); }
    } else {
        a.ph_lo = 0; a.ph_hi = N_STEPS; hipLaunchKernelGGL(trunk_fwd, dim3(grid), dim3(NTHR), LDS_BYTES, stream, a);
    }
}
```

```cpp
#include <hip/hip_runtime.h>
#include <cstdio>
#include <cstdint>

#ifndef SCAN_MFMA
#define SCAN_MFMA 1
#endif
#ifndef N_LAUNCH_SPLIT
#define N_LAUNCH_SPLIT 0
#endif

namespace pg8 {
#define PG8_LAS __attribute__((address_space(3)))
typedef unsigned short bf16_t;
typedef short bf16x8 __attribute__((ext_vector_type(8)));
typedef float f32x4 __attribute__((ext_vector_type(4)));
typedef unsigned u32x4 __attribute__((ext_vector_type(4)));
constexpr int BM = 256, BK = 64, HALF = 128, HTB = HALF * BK * 2, STAGE_BYTES = 8 * HTB, NXCD = 8, WGM = 8;

__host__ __device__ __forceinline__ int lds_byte(int r, int c) { const int st = (r >> 4) * 2 + (c >> 5), rr = r & 15, cc = c & 31, ob = rr * 64 + cc * 2; return st * 1024 + (ob ^ (((ob >> 9) & 1) << 5)); }
__host__ __device__ __forceinline__ void stage_rc(int b, int& R, int& C) { const int st = b / 1024, sb = b % 1024, swz = sb ^ (((sb >> 9) & 1) << 5); R = (st >> 1) * 16 + swz / 64; C = (st & 1) * 32 + (swz % 64) / 2; }
__host__ __device__ __forceinline__ int perm32(int rho) { const int n = rho >> 4, i = rho & 15; return 8 * (i >> 2) + 4 * n + (i & 3); }

__device__ __forceinline__ int opaque_v(int x) { asm volatile("" : "+v"(x)); return x; }
__device__ __forceinline__ int opaque_s(int x) { asm volatile("" : "+s"(x)); return x; }
struct Unit { int pm, pn, e, r0, half; };

struct TileOrder {
    int nM, nN, nwg, G, c, wgm;
    __device__ __forceinline__ void init(int nM_, int nN_, int G_, int c_, int wgm_ = WGM) { nM = nM_; nN = nN_; nwg = nM * nN; G = G_; c = c_; wgm = wgm_; }
    __device__ __forceinline__ bool map(int i, int& pm, int& pn) const {
        const long L = (long)i * G + c; if (L >= nwg) return false;
        int wgid = (int)L; { const int q = nwg / NXCD, r = nwg % NXCD, xcd = wgid % NXCD, off = wgid / NXCD; wgid = (xcd < r ? xcd * (q + 1) : r * (q + 1) + (xcd - r) * q) + off; }
        const int nig = wgm * nN, gid = wgid / nig, fm = gid * wgm, gsz = (nM - fm) < wgm ? (nM - fm) : wgm;
        pm = fm + ((wgid % nig) % gsz); pn = (wgid % nig) / gsz; return true;
    }
};
struct DenseSched {
    static constexpr bool GATHER = false;
    TileOrder T; const char* A; const char* Bt; int K;
    __device__ __forceinline__ bool next(int i, Unit& u) const { u.e = 0; u.r0 = 0; u.half = 0; return T.map(i, u.pm, u.pn); }
    __device__ __forceinline__ const char* a_base(const Unit& u) const { return A + (size_t)u.pm * 256 * K * 2; }
    __device__ __forceinline__ const char* b_base(const Unit& u) const { return Bt + (size_t)u.pn * 256 * K * 2; }
    __device__ __forceinline__ void a_voff(const Unit&, int tid, unsigned (&v)[2][2]) const {
#pragma unroll
        for (int i = 0; i < 2; ++i) { int R, C; stage_rc(tid * 16 + i * 8192, R, C); v[0][i] = (unsigned)(R * K + C) * 2u; v[1][i] = v[0][i]; }
    }
};
struct GuSched {
    static constexpr bool GATHER = true;
    TileOrder T; const char* A; const char* Bt; const int* slot_tok; const PG8_LAS int* toff; const PG8_LAS int* cnt; const PG8_LAS int* soff; const PG8_LAS int* sexp; int K;
    __device__ __forceinline__ bool next(int i, Unit& u) const {
        if (T.map(i, u.pm, u.pn)) {
            int e = 0;
#pragma unroll
            for (int j = 1; j < 32; ++j) e += (toff[j] <= u.pm) ? 1 : 0;
            u.e = e; u.r0 = (u.pm - toff[e]) * 256; u.half = 0; return true;
        }
        const long sidx = (long)i * T.G + T.c - T.nwg; if (sidx >= 4 * soff[32]) return false;
        const int t = (int)sidx >> 2; u.pn = (int)sidx & 3; u.pm = toff[32] + t; u.e = sexp[t]; u.r0 = (toff[u.e + 1] - toff[u.e]) * 256; u.half = 1; return true;
    }
    __device__ __forceinline__ const char* a_base(const Unit&) const { return A; }
    __device__ __forceinline__ const char* b_base(const Unit& u) const { return Bt + ((size_t)u.e * 1024 + (size_t)u.pn * 256) * K * 2; }
    __device__ __forceinline__ void a_tok(const Unit& u, int tid, int (&tk)[2][2]) const {
        const int c1 = cnt[u.e] - 1;
#pragma unroll
        for (int h = 0; h < 2; ++h)
#pragma unroll
            for (int i = 0; i < 2; ++i) { int R, C; stage_rc(tid * 16 + i * 8192, R, C); int idx = u.r0 + h * 128 + R; idx = idx < c1 ? idx : c1; tk[h][i] = slot_tok[u.e * 16384 + idx]; }
    }
    __device__ __forceinline__ void a_off(const int (&tk)[2][2], int tid, unsigned (&v)[2][2]) const {
#pragma unroll
        for (int h = 0; h < 2; ++h)
#pragma unroll
            for (int i = 0; i < 2; ++i) { int R, C; stage_rc(tid * 16 + i * 8192, R, C); v[h][i] = (unsigned)(tk[h][i] * K + C) * 2u; }
    }
    __device__ __forceinline__ void a_voff(const Unit& u, int tid, unsigned (&v)[2][2]) const {
        const int c1 = cnt[u.e] - 1;
#pragma unroll
        for (int h = 0; h < 2; ++h)
#pragma unroll
            for (int i = 0; i < 2; ++i) { int R, C; stage_rc(tid * 16 + i * 8192, R, C); int idx = u.r0 + h * 128 + R; idx = idx < c1 ? idx : c1;
                const int tok = slot_tok[u.e * 16384 + idx]; v[h][i] = (unsigned)(tok * K + C) * 2u; }
    }
};
struct DnSched {
    static constexpr bool GATHER = false;
    TileOrder T; const char* A; const char* Bt; const PG8_LAS int* toff; const PG8_LAS int* soff; const PG8_LAS int* sexp; int K;
    __device__ __forceinline__ bool next(int i, Unit& u) const {
        u.r0 = 0;
        if (T.map(i, u.pm, u.pn)) {
            int e = 0;
#pragma unroll
            for (int j = 1; j < 32; ++j) e += (toff[j] <= u.pm) ? 1 : 0;
            u.e = e; u.half = 0; return true;
        }
        const long sidx = (long)i * T.G + T.c - T.nwg; if (sidx >= 4 * soff[32]) return false;
        const int t = (int)sidx >> 2; u.pn = (int)sidx & 3; u.pm = toff[32] + t; u.e = sexp[t]; u.half = 1; return true;
    }
    __device__ __forceinline__ const char* a_base(const Unit& u) const { return A + (size_t)u.pm * 256 * K * 2; }
    __device__ __forceinline__ const char* b_base(const Unit& u) const { return Bt + ((size_t)u.e * 1024 + (size_t)u.pn * 256) * K * 2; }
    __device__ __forceinline__ void a_voff(const Unit&, int tid, unsigned (&v)[2][2]) const {
#pragma unroll
        for (int i = 0; i < 2; ++i) { int R, C; stage_rc(tid * 16 + i * 8192, R, C); v[0][i] = (unsigned)(R * K + C) * 2u; v[1][i] = v[0][i]; }
    }
};

typedef __bf16 bf16x2_t __attribute__((ext_vector_type(2)));
__device__ __forceinline__ unsigned cvt_pk_bf16(float lo, float hi) { bf16x2_t v; v[0] = (__bf16)lo; v[1] = (__bf16)hi; return __builtin_bit_cast(unsigned, v); }
__device__ __forceinline__ u32x4 pack8(const f32x4 a, const f32x4 b) { u32x4 w; w.x = cvt_pk_bf16(a[0], a[1]); w.y = cvt_pk_bf16(a[2], a[3]); w.z = cvt_pk_bf16(b[0], b[1]); w.w = cvt_pk_bf16(b[2], b[3]); return w; }

struct EpiStoreBf16 {
    static constexpr bool PERM = true;
    bf16_t* O; int ldc; float sc;
    __device__ __forceinline__ void operator()(const f32x4 (&acc)[2][2][4][2], const Unit& u, int wr, int wc, int fr, int fq) const {
        const int row0 = u.pm * BM + wr * 64 + fr, col0 = u.pn * BM + wc * 32 + 8 * fq;
#pragma unroll
        for (int ai = 0; ai < 2; ++ai) { if (ai == 1 && u.half) break;
#pragma unroll
            for (int m = 0; m < 4; ++m) { bf16_t* rowp = O + (size_t)(row0 + ai * HALF + m * 16) * ldc + col0;
#pragma unroll
                for (int bj = 0; bj < 2; ++bj) *(u32x4*)(rowp + bj * HALF) = pack8(acc[ai][bj][m][0] * sc, acc[ai][bj][m][1] * sc); } }
    }
};
struct EpiConvIn {
    static constexpr bool PERM = true;
    bf16_t* O; int ldc;
    __device__ __forceinline__ void operator()(const f32x4 (&acc)[2][2][4][2], const Unit& u, int wr, int wc, int fr, int fq) const {
        const int row0 = u.pm * BM + wr * 64 + fr;
        if (u.pn < 8) {
            const int col0 = u.pn * HALF + wc * 32 + 8 * fq;
#pragma unroll
            for (int ai = 0; ai < 2; ++ai)
#pragma unroll
                for (int m = 0; m < 4; ++m) { bf16_t* rowp = O + (size_t)(row0 + ai * HALF + m * 16) * ldc + col0;
                    *(u32x4*)rowp = pack8(acc[ai][0][m][0] * acc[ai][1][m][0], acc[ai][0][m][1] * acc[ai][1][m][1]); }
        } else {
            const int col0 = 1024 + (u.pn - 8) * BM + wc * 32 + 8 * fq;
#pragma unroll
            for (int ai = 0; ai < 2; ++ai)
#pragma unroll
                for (int m = 0; m < 4; ++m) { bf16_t* rowp = O + (size_t)(row0 + ai * HALF + m * 16) * ldc + col0;
#pragma unroll
                    for (int bj = 0; bj < 2; ++bj) *(u32x4*)(rowp + bj * HALF) = pack8(acc[ai][bj][m][0], acc[ai][bj][m][1]); }
        }
    }
};
__device__ __forceinline__ float silu_f(float g) { return g * __builtin_amdgcn_rcpf(1.0f + __expf(-g)); }
__device__ __forceinline__ unsigned pk4_fp8(float a, float b, float c, float d) { unsigned w = 0; w = __builtin_amdgcn_cvt_pk_fp8_f32(a, b, w, false); w = __builtin_amdgcn_cvt_pk_fp8_f32(c, d, w, true); return w; }
constexpr float W8_INV = 1.0f / 32.0f;
struct EpiGateUp {
    static constexpr bool PERM = true;
    unsigned char* O;
    __device__ __forceinline__ void operator()(const f32x4 (&acc)[2][2][4][2], const Unit& u, int wr, int wc, int fr, int fq) const {
        const int row0 = u.pm * BM + wr * 64 + fr, col0 = u.pn * HALF + wc * 32 + 8 * fq;
        typedef unsigned u32x2 __attribute__((ext_vector_type(2)));
#pragma unroll
        for (int ai = 0; ai < 2; ++ai) { if (ai == 1 && u.half) break;
#pragma unroll
            for (int m = 0; m < 4; ++m) { unsigned char* rowp = O + (size_t)(row0 + ai * HALF + m * 16) * 512 + col0;
                f32x4 h0, h1;
#pragma unroll
                for (int j = 0; j < 4; ++j) { h0[j] = silu_f(acc[ai][0][m][0][j] * W8_INV) * (acc[ai][1][m][0][j] * W8_INV); h1[j] = silu_f(acc[ai][0][m][1][j] * W8_INV) * (acc[ai][1][m][1][j] * W8_INV); }
                u32x2 w; w.x = pk4_fp8(h0[0], h0[1], h0[2], h0[3]); w.y = pk4_fp8(h1[0], h1[1], h1[2], h1[3]); *(u32x2*)rowp = w; } }
    }
};
struct EpiStoreF8 {
    static constexpr bool PERM = true;
    unsigned char* O; int ldc;
    __device__ __forceinline__ void operator()(const f32x4 (&acc)[2][2][4][2], const Unit& u, int wr, int wc, int fr, int fq) const {
        const int row0 = u.pm * BM + wr * 64 + fr, col0 = u.pn * BM + wc * 32 + 8 * fq;
        typedef unsigned u32x2 __attribute__((ext_vector_type(2)));
#pragma unroll
        for (int ai = 0; ai < 2; ++ai) { if (ai == 1 && u.half) break;
#pragma unroll
            for (int m = 0; m < 4; ++m) { unsigned char* rowp = O + (size_t)(row0 + ai * HALF + m * 16) * ldc + col0;
#pragma unroll
                for (int bj = 0; bj < 2; ++bj) { u32x2 w; w.x = pk4_fp8(acc[ai][bj][m][0][0], acc[ai][bj][m][0][1], acc[ai][bj][m][0][2], acc[ai][bj][m][0][3]);
                    w.y = pk4_fp8(acc[ai][bj][m][1][0], acc[ai][bj][m][1][1], acc[ai][bj][m][1][2], acc[ai][bj][m][1][3]); *(u32x2*)(rowp + bj * HALF) = w; } } }
    }
};
struct EpiResid {
    static constexpr bool PERM = true;
    const float* xin32; bf16_t* xs; const float* gatev; float sc;
    __device__ __forceinline__ void operator()(const f32x4 (&acc)[2][2][4][2], const Unit& u, int wr, int wc, int fr, int fq) const {
        const int row0 = u.pm * BM + wr * 64 + fr, col0 = u.pn * BM + wc * 32 + 8 * fq, b = u.pm >> 3;
        f32x4 gv[2][2];
#pragma unroll
        for (int bj = 0; bj < 2; ++bj)
#pragma unroll
            for (int n = 0; n < 2; ++n) gv[bj][n] = *(const f32x4*)(gatev + b * 3072 + col0 + bj * HALF + n * 4) * sc;
#pragma unroll
        for (int ai = 0; ai < 2; ++ai) {
            u32x4 w[4][2];
#pragma unroll
            for (int m = 0; m < 4; ++m)
#pragma unroll
                for (int bj = 0; bj < 2; ++bj) w[m][bj] = *(const u32x4*)(xs + (size_t)(row0 + ai * HALF + m * 16) * 1024 + col0 + bj * HALF);
#pragma unroll
            for (int m = 0; m < 4; ++m) { const size_t off = (size_t)(row0 + ai * HALF + m * 16) * 1024 + col0;
#pragma unroll
                for (int bj = 0; bj < 2; ++bj) { const u32x4 q = w[m][bj];
                    const f32x4 x0 = (f32x4){__builtin_bit_cast(float, q.x << 16), __builtin_bit_cast(float, q.x & 0xffff0000u), __builtin_bit_cast(float, q.y << 16), __builtin_bit_cast(float, q.y & 0xffff0000u)};
                    const f32x4 x1 = (f32x4){__builtin_bit_cast(float, q.z << 16), __builtin_bit_cast(float, q.z & 0xffff0000u), __builtin_bit_cast(float, q.w << 16), __builtin_bit_cast(float, q.w & 0xffff0000u)};
                    *(u32x4*)(xs + off + bj * HALF) = pack8(x0 + gv[bj][0] * acc[ai][bj][m][0], x1 + gv[bj][1] * acc[ai][bj][m][1]); } }
        }
    }
};

typedef int i32x8 __attribute__((ext_vector_type(8)));
template <class Epi, class Sched, bool ALIGN_EPI, bool FP8 = false>
__device__ __forceinline__ void gemm_phase(PG8_LAS unsigned char* lds, const int K, const Sched& S, const Epi& E) {
    constexpr bool GATHER = Sched::GATHER;
    const int tid = opaque_v((int)threadIdx.x), wid = __builtin_amdgcn_readfirstlane(tid >> 6), lane = tid & 63, wr = wid >> 2, wc = wid & 3, fr = lane & 15, fq = lane >> 4;
    const int nt = opaque_s(K / BK);
    unsigned voffB[2];
#pragma unroll
    for (int i = 0; i < 2; ++i) { int R, C; stage_rc(tid * 16 + i * 8192, R, C); const int Rb = Epi::PERM ? ((R & ~31) + perm32(R & 31)) : R; voffB[i] = (unsigned)(Rb * K + C) * 2u; }
    const size_t kstep = (size_t)(BK * 2);
    const size_t hstepB = (size_t)HALF * K * 2;
    const size_t hstepA = GATHER ? (size_t)0 : hstepB;
    const unsigned ldsw = (unsigned)wid * 1024u;
    const int aoff = lds_byte(wr * 64 + fr, fq * 8), boff = lds_byte(wc * 32 + fr, fq * 8);
#define PG8_SA(b, h) (((b) * 2 + (h)) * HTB)
#define PG8_SB(b, h) ((4 + (b) * 2 + (h)) * HTB)
#define PG8_STAGE(bufoff, gbase, voff) do { _Pragma("unroll") for (int _i = 0; _i < 2; ++_i) \
        __builtin_amdgcn_global_load_lds((const unsigned*)((const char*)(gbase) + (voff)[_i]), (PG8_LAS unsigned*)(lds + (bufoff) + ldsw + _i * 8192), 16, 0, 0); } while (0)
#define PG8_LDA(dst, b, h) do { _Pragma("unroll") for (int m = 0; m < 4; ++m) _Pragma("unroll") for (int k = 0; k < 2; ++k) dst[m][k] = *(const PG8_LAS bf16x8*)(lds + PG8_SA(b, h) + aoff + m * 2048 + k * 1024); } while (0)
#define PG8_LDB(dst, b, h) do { _Pragma("unroll") for (int n = 0; n < 2; ++n) _Pragma("unroll") for (int k = 0; k < 2; ++k) dst[n][k] = *(const PG8_LAS bf16x8*)(lds + PG8_SB(b, h) + boff + n * 2048 + k * 1024); } while (0)
#define PG8_MMA16(ai, bj, At, Bt) do { __builtin_amdgcn_s_setprio(1); _Pragma("unroll") for (int m = 0; m < 4; ++m) _Pragma("unroll") for (int n = 0; n < 2; ++n) _Pragma("unroll") for (int k = 0; k < 2; ++k) \
        acc[ai][bj][m][n] = __builtin_amdgcn_mfma_f32_16x16x32_bf16(Bt[n][k], At[m][k], acc[ai][bj][m][n], 0, 0, 0); __builtin_amdgcn_s_setprio(0); } while (0)
#define PG8_LDA8(dst, b, h) do { _Pragma("unroll") for (int m = 0; m < 4; ++m) { const u32x4 _lo = *(const PG8_LAS u32x4*)(lds + PG8_SA(b, h) + aoff + m * 2048), _hi = *(const PG8_LAS u32x4*)(lds + PG8_SA(b, h) + aoff + m * 2048 + 1024); \
        dst[m] = __builtin_bit_cast(i32x8, __builtin_shufflevector(_lo, _hi, 0, 1, 2, 3, 4, 5, 6, 7)); } } while (0)
#define PG8_LDB8(dst, b, h) do { _Pragma("unroll") for (int n = 0; n < 2; ++n) { const u32x4 _lo = *(const PG8_LAS u32x4*)(lds + PG8_SB(b, h) + boff + n * 2048), _hi = *(const PG8_LAS u32x4*)(lds + PG8_SB(b, h) + boff + n * 2048 + 1024); \
        dst[n] = __builtin_bit_cast(i32x8, __builtin_shufflevector(_lo, _hi, 0, 1, 2, 3, 4, 5, 6, 7)); } } while (0)
#define PG8_MMA8(ai, bj, At, Bt) do { __builtin_amdgcn_s_setprio(1); asm volatile("s_nop 4"); _Pragma("unroll") for (int m = 0; m < 4; ++m) _Pragma("unroll") for (int n = 0; n < 2; ++n) \
        asm volatile("v_mfma_scale_f32_16x16x128_f8f6f4 %0, %1, %2, %0, %3, %3 op_sel_hi:[0,0,0]" : "+v"(acc[ai][bj][m][n]) : "v"(Bt[n]), "v"(At[m]), "v"(scale1)); __builtin_amdgcn_s_setprio(0); } while (0)
#define PG8_XLDA(b, h) do { if constexpr (FP8) PG8_LDA8(At8, b, h); else PG8_LDA(At, b, h); } while (0)
#define PG8_XLDB(w, b, h) do { if constexpr (FP8) PG8_LDB8(B##w##8, b, h); else PG8_LDB(B##w, b, h); } while (0)
#define PG8_XMMA(ai, bj, w) do { if constexpr (FP8) PG8_MMA8(ai, bj, At8, B##w##8); else PG8_MMA16(ai, bj, At, B##w); } while (0)
#define PG8_WAIT_V(n) asm volatile("s_waitcnt vmcnt(" #n ")" ::: "memory")
#define PG8_WAIT_L(n) asm volatile("s_waitcnt lgkmcnt(" #n ")" ::: "memory")
#define PG8_BAR __builtin_amdgcn_s_barrier()
#define PG8_SCHED __builtin_amdgcn_sched_barrier(0)
    Unit cur, nxt; int ui = 0;
    if (!S.next(0, cur)) return;
    f32x4 acc[2][2][4][2];
#pragma unroll
    for (int a = 0; a < 2; ++a)
#pragma unroll
        for (int b = 0; b < 2; ++b)
#pragma unroll
            for (int m = 0; m < 4; ++m)
#pragma unroll
                for (int n = 0; n < 2; ++n) acc[a][b][m][n] = (f32x4){0.f, 0.f, 0.f, 0.f};
    bf16x8 At[4][2], B0[2][2], B1[2][2]; i32x8 At8[4], B08[2], B18[2]; int scale1 = 0x7F7F7F7F; asm volatile("" : "+v"(scale1));
    const char* cA = S.a_base(cur); const char* cB = S.b_base(cur);
    unsigned vc[2][2], vn[2][2];
    S.a_voff(cur, tid, vc);
    PG8_STAGE(PG8_SB(0, 0), cB, voffB); PG8_STAGE(PG8_SB(0, 1), cB + hstepB, voffB); PG8_STAGE(PG8_SA(0, 0), cA, vc[0]); PG8_STAGE(PG8_SA(0, 1), cA + hstepA, vc[1]);
    if (wr == 1) PG8_BAR;
    PG8_WAIT_V(2); PG8_BAR;
    PG8_STAGE(PG8_SB(1, 0), cB + kstep, voffB); PG8_STAGE(PG8_SA(1, 0), cA + kstep, vc[0]); PG8_STAGE(PG8_SB(1, 1), cB + hstepB + kstep, voffB);
    PG8_WAIT_V(6); PG8_BAR;
    for (;;) {
        const bool has_next = S.next(ui + 1, nxt);
        const char* nA = has_next ? S.a_base(nxt) : cA; const char* nB = has_next ? S.b_base(nxt) : cB;
        int tkn[2][2] = {{0, 0}, {0, 0}};
        if constexpr (GATHER) { if (has_next) S.a_tok(nxt, tid, tkn); }
#pragma unroll 1
        for (int t = 0; t < nt; t += 2) {
            const bool last = (t == nt - 2);
            const char* a1 = cA + (size_t)(t + 1) * kstep;
            const char* a2 = last ? nA : cA + (size_t)(t + 2) * kstep; const char* b2 = last ? nB : cB + (size_t)(t + 2) * kstep;
            const char* a3 = a2 + kstep; const char* b3 = b2 + kstep;
            unsigned v2[2][2];
#pragma unroll
            for (int h = 0; h < 2; ++h)
#pragma unroll
                for (int i = 0; i < 2; ++i) v2[h][i] = vc[h][i];
            if (GATHER && last && has_next) { const u32x4 pk = *(const PG8_LAS u32x4*)(lds + STAGE_BYTES + tid * 16); v2[0][0] = pk[0]; v2[0][1] = pk[1]; v2[1][0] = pk[2]; v2[1][1] = pk[3]; }
            PG8_XLDB(0, 0, 0); PG8_XLDB(1, 0, 1); PG8_SCHED; PG8_XLDA(0, 0); PG8_STAGE(PG8_SA(1, 1), a1 + hstepA, vc[1]);
            PG8_WAIT_V(8); PG8_WAIT_L(0); PG8_BAR; PG8_XMMA(0, 0, 0); PG8_XMMA(0, 1, 1); PG8_BAR; PG8_SCHED;
            if (!cur.half) PG8_XLDA(0, 1); PG8_STAGE(PG8_SB(0, 0), b2, voffB); PG8_STAGE(PG8_SB(0, 1), b2 + hstepB, voffB); PG8_STAGE(PG8_SA(0, 0), a2, v2[0]);
            PG8_WAIT_V(8); PG8_WAIT_L(0); PG8_BAR; if (!cur.half) { PG8_XMMA(1, 0, 0); PG8_XMMA(1, 1, 1); } PG8_BAR; PG8_SCHED;
            PG8_XLDB(0, 1, 0); PG8_XLDB(1, 1, 1); PG8_SCHED; PG8_XLDA(1, 0); PG8_STAGE(PG8_SA(0, 1), a2 + hstepA, v2[1]);
            PG8_WAIT_V(8); PG8_WAIT_L(0); PG8_BAR; PG8_XMMA(0, 0, 0); PG8_XMMA(0, 1, 1); PG8_BAR; PG8_SCHED;
            if (!cur.half) PG8_XLDA(1, 1); PG8_STAGE(PG8_SB(1, 0), b3, voffB); PG8_STAGE(PG8_SB(1, 1), b3 + hstepB, voffB); PG8_STAGE(PG8_SA(1, 0), a3, v2[0]);
            PG8_WAIT_V(8); PG8_WAIT_L(0); PG8_BAR; if (!cur.half) { PG8_XMMA(1, 0, 0); PG8_XMMA(1, 1, 1); } PG8_BAR; PG8_SCHED;
            if constexpr (GATHER) { if (has_next && t == 0) { S.a_off(tkn, tid, vn); *(PG8_LAS u32x4*)(lds + STAGE_BYTES + tid * 16) = (u32x4){vn[0][0], vn[0][1], vn[1][0], vn[1][1]}; } }
        }
        if constexpr (ALIGN_EPI) { if (wr == 0) PG8_BAR; }
        if constexpr (FP8) asm volatile("s_nop 15\n\ts_nop 15" ::: "memory");
        E(acc, cur, wr, wc, fr, fq);
        if (!has_next) break;
#pragma unroll
        for (int a = 0; a < 2; ++a)
#pragma unroll
            for (int b = 0; b < 2; ++b)
#pragma unroll
                for (int m = 0; m < 4; ++m)
#pragma unroll
                    for (int n = 0; n < 2; ++n) acc[a][b][m][n] = (f32x4){0.f, 0.f, 0.f, 0.f};
        cur = nxt; cA = nA; cB = nB; ++ui;
        if (GATHER) { const u32x4 pk = *(const PG8_LAS u32x4*)(lds + STAGE_BYTES + tid * 16); vc[0][0] = pk[0]; vc[0][1] = pk[1]; vc[1][0] = pk[2]; vc[1][1] = pk[3]; }
        if constexpr (ALIGN_EPI) { if (wr == 1) PG8_BAR; }
    }
    PG8_WAIT_V(0);
    if constexpr (!ALIGN_EPI) { if (wr == 0) PG8_BAR; }
    PG8_BAR;
#undef PG8_SA
#undef PG8_SB
#undef PG8_STAGE
#undef PG8_LDA
#undef PG8_LDB
#undef PG8_MMA16
#undef PG8_LDA8
#undef PG8_LDB8
#undef PG8_MMA8
#undef PG8_XLDA
#undef PG8_XLDB
#undef PG8_XMMA
#undef PG8_WAIT_V
#undef PG8_WAIT_L
#undef PG8_BAR
#undef PG8_SCHED
}
}

constexpr int NWAVES = 8, NTHR = 512;
constexpr int D = 1024, BATCH = 8, SEQ = 2048, NTOK = BATCH * SEQ, DEPTH = 4;
constexpr int M_HEADS = 4, M_DK = 128, M_DV = 256, M_PROJ = 3080, NPROJ = 3072;
constexpr int N_EXP = 32, D_FF = 512;
constexpr float EPS = 1e-6f;
constexpr int PMAX = 40960;

constexpr size_t MiB = 1u << 20;
constexpr size_t WS_CTL = 0, CTL_ZERO_BYTES = 128 * 1024;
constexpr size_t WS_MOD = 1 * MiB;
constexpr size_t WS_GATES = 2 * MiB;
constexpr size_t WS_TOKPOS = 3 * MiB;
constexpr size_t WS_TOKW = 3 * MiB + 256 * 1024;
constexpr size_t WS_SLOTTOK = 4 * MiB;
constexpr size_t WS_WMIN = 8 * MiB;
constexpr size_t WS_WMOUT = 20 * MiB;
constexpr size_t WS_WSIN = 24 * MiB;
constexpr size_t WS_WSOUT = 36 * MiB;
constexpr size_t WS_WGU = 40 * MiB;
constexpr size_t WS_WDN = 296 * MiB;
constexpr size_t WS_H = 424 * MiB;
constexpr size_t WS_PROJ = 456 * MiB;
constexpr size_t WS_HS = 552 * MiB;
constexpr size_t WS_A2 = 616 * MiB;
constexpr size_t WS_HMID = 648 * MiB;
constexpr size_t WS_YR = 688 * MiB;
constexpr size_t WS_X = 768 * MiB;
constexpr size_t WS_RTAB = 800 * MiB;
constexpr size_t WS_RCS = 805 * MiB;
constexpr size_t WS_END = 806 * MiB;
constexpr int CW_BAR = 4096;
constexpr int CW_CNT = 16384;

constexpr int LDS_BYTES = 163840;
constexpr int LDSCTL_OFF = 163840 - 1024;
constexpr int LC_TOFF = 16, LC_CNT = 64, LC_LCNT = 96, LC_LBASE = 128, LC_SOFF = 160, LC_SEXP = 200;

#define GAS __attribute__((address_space(1)))
#define LAS __attribute__((address_space(3)))
typedef unsigned short bf16;
typedef unsigned v4u __attribute__((ext_vector_type(4)));
typedef unsigned v2u __attribute__((ext_vector_type(2)));
typedef float f32x4 __attribute__((ext_vector_type(4)));
#define LDS_WAIT() asm volatile("s_waitcnt lgkmcnt(0)" ::: "memory")
__device__ __forceinline__ unsigned f2bf(float f) { unsigned u = __builtin_bit_cast(unsigned, f); return (u + 0x7fffu + ((u >> 16) & 1u)) >> 16; }
__device__ __forceinline__ unsigned pk2(float lo, float hi) { return f2bf(lo) | (f2bf(hi) << 16); }
__device__ __forceinline__ float bflo(unsigned w) { return __builtin_bit_cast(float, w << 16); }
__device__ __forceinline__ float bfhi(unsigned w) { return __builtin_bit_cast(float, w & 0xffff0000u); }
__device__ __forceinline__ float wave_sum(float v) {
#define WS_DPP(ctrl, rowmask) __builtin_bit_cast(float, __builtin_amdgcn_update_dpp(0, __builtin_bit_cast(int, v), ctrl, rowmask, 0xf, false))
    v += WS_DPP(0x111, 0xf); v += WS_DPP(0x112, 0xf); v += WS_DPP(0x114, 0xf); v += WS_DPP(0x118, 0xf); v += WS_DPP(0x142, 0xa); v += WS_DPP(0x143, 0xc);
#undef WS_DPP
    return __builtin_bit_cast(float, __builtin_amdgcn_readlane(__builtin_bit_cast(int, v), 63));
}

#define XB_TMO      128
#define XB_XCNT(j)  (256  + 64 * (j))
#define XB_XSUB(j)  (1280 + 64 * (j))
#define XB_XGEN(j)  (2304 + 64 * (j))
#define XB_TOP      3328
#define XB_TOPGEN   3392
#define XCD_BAR_WORDS 3456
#define XB_SPIN_CAP (1u << 18)
__device__ __forceinline__ unsigned xb_ld(unsigned* p)              { return __hip_atomic_load(p, __ATOMIC_RELAXED, __HIP_MEMORY_SCOPE_AGENT); }
__device__ __forceinline__ unsigned xb_add(unsigned* p, unsigned v) { return __hip_atomic_fetch_add(p, v, __ATOMIC_RELAXED, __HIP_MEMORY_SCOPE_AGENT); }
__device__ __forceinline__ unsigned xb_xcc_id() { return (unsigned)__builtin_amdgcn_s_getreg((3 << 11) | 20) & 0xFu; }
#define XB_SPIN(cond, bar) do { unsigned _sp = 0; while (cond) { __builtin_amdgcn_s_sleep(1); \
    if ((++_sp & 255u) == 0u) { if (xb_ld(&(bar)[XB_TMO])) break; if (_sp > XB_SPIN_CAP) { atomicAdd(&(bar)[XB_TMO], 1u); break; } } } } while (0)
struct XcdBarrier { unsigned* bar; unsigned x; volatile LAS unsigned* st; };
__device__ __forceinline__ XcdBarrier xcd_barrier_post(unsigned* bar, volatile LAS unsigned* st) {
    XcdBarrier b; b.bar = bar; b.x = xb_xcc_id(); b.st = st;
    if (threadIdx.x == 0) (void)xb_add(&bar[XB_XCNT(b.x)], 1u);
    return b;
}
__device__ __forceinline__ void xcd_barrier_complete(unsigned* bar, unsigned x, unsigned& nloc, unsigned& nx) {
    const unsigned G = gridDim.x * gridDim.y * gridDim.z;
    unsigned sum, cnt, mine, sp = 0u;
    for (;;) {
        sum = 0u; cnt = 0u; mine = 0u;
#pragma unroll
        for (unsigned j = 0; j < 16; ++j) { const unsigned c = xb_ld(&bar[XB_XCNT(j)]); sum += c; cnt += (c > 0u) ? 1u : 0u; mine = (j == x) ? c : mine; }
        if (sum == G) break;
        __builtin_amdgcn_s_sleep(1);
        if ((++sp & 255u) == 0u) { if (xb_ld(&bar[XB_TMO])) break; if (sp > XB_SPIN_CAP) { atomicAdd(&bar[XB_TMO], 1u); break; } }
    }
    nloc = mine > 0u ? mine : 1u; nx = cnt > 0u ? cnt : 1u;
}
__device__ __forceinline__ void xcd_barrier(const XcdBarrier& b) {
    asm volatile("s_waitcnt vmcnt(0)" ::: "memory");
    __syncthreads();
    if (threadIdx.x == 0) {
        unsigned* bar = b.bar;
        __builtin_amdgcn_s_waitcnt(0);
        unsigned nloc = b.st[0], nx = b.st[1];
        if (nloc == 0u) { xcd_barrier_complete(bar, b.x, nloc, nx); b.st[0] = nloc; b.st[1] = nx; }
        const unsigned old = xb_add(&bar[XB_XSUB(b.x)], 1u);
        const unsigned gen = old / nloc;
        if (old + 1u == (gen + 1u) * nloc) {
            __builtin_amdgcn_fence(__ATOMIC_RELEASE, "agent");
            asm volatile("s_waitcnt vmcnt(0)" ::: "memory");
            const unsigned og = xb_add(&bar[XB_TOP], 1u);
            const unsigned tg = og / nx;
            if (og + 1u == (tg + 1u) * nx) xb_add(&bar[XB_TOPGEN], 1u);
            else XB_SPIN(xb_ld(&bar[XB_TOPGEN]) == tg, bar);
            __builtin_amdgcn_fence(__ATOMIC_ACQUIRE, "agent");
            xb_add(&bar[XB_XGEN(b.x)], 1u);
            asm volatile("s_waitcnt vmcnt(0)" ::: "memory");
        } else {
            XB_SPIN(xb_ld(&bar[XB_XGEN(b.x)]) == gen, bar);
            __builtin_amdgcn_fence(__ATOMIC_ACQUIRE, "agent");
            asm volatile("s_waitcnt vmcnt(0)" ::: "memory");
        }
    }
    __syncthreads();
}

struct Args { const float* in[20]; float* out; unsigned char* ws; int ph_lo, ph_hi; };
enum InIdx { I_X = 0, I_C, I_ADAW, I_ADAB, I_NORMG, I_FINALG, I_MWIN, I_MBG, I_MNORMG, I_MWOUT, I_SWIN, I_SCONVW, I_SWOUT, I_RWG, I_RBG, I_RWE, I_RBE, I_EWG, I_EWU, I_EWD };

struct Frame {
    LAS unsigned char* lds;
    volatile LAS unsigned* LC;
    unsigned* ctl;
    int tid, lane, wave, G;
    float* out; unsigned char* ws;
};
typedef const __attribute__((address_space(4))) Args* KArgs;
__device__ __forceinline__ KArgs kargs() { auto p = __builtin_amdgcn_kernarg_segment_ptr(); asm volatile("" : "+s"(p)); return (KArgs)p; }
template <class T> __device__ __forceinline__ T* as_global(T* p) { __attribute__((address_space(1))) T* q = (__attribute__((address_space(1))) T*)p; asm volatile("" : "+s"(q)); return (T*)q; }
#define KIN(i) (as_global((const float*)kargs()->in[i]))
template <class T> __device__ __forceinline__ T* launder(T* p) { return as_global(p); }

__device__ __forceinline__ Frame fresh(const Frame& F) { Frame P = F; P.tid = pg8::opaque_v(F.tid); P.lane = P.tid & 63; P.wave = __builtin_amdgcn_readfirstlane(P.tid >> 6); P.G = pg8::opaque_s(F.G); return P; }
__device__ __forceinline__ void p_adaln(Frame& F) {
    LAS float* sc = (LAS float*)F.lds;
    LAS float* red = (LAS float*)(F.lds + 32768);
    const float* c = KIN(I_C); const float* adaw = KIN(I_ADAW); const float* adab = KIN(I_ADAB);
    float* mod = (float*)(F.ws + WS_MOD);
    { float cv[16];
#pragma unroll
      for (int i = 0; i < 16; ++i) cv[i] = c[F.tid + NTHR * i];
#pragma unroll
      for (int i = 0; i < 16; ++i) sc[F.tid + NTHR * i] = cv[i] / (1.0f + __expf(-cv[i])); }
    __syncthreads();
    const int kq = F.lane >> 4, c4 = (F.lane & 15) * 4;
    for (int item = blockIdx.x; item < 8 * 48; item += F.G) {
        const int ls = item / 48, cg = item % 48;
        const float* W = adaw + (size_t)ls * 1024 * 3072 + cg * 64 + c4;
        float acc[8][4];
#pragma unroll
        for (int b = 0; b < 8; ++b) { acc[b][0] = 0.f; acc[b][1] = 0.f; acc[b][2] = 0.f; acc[b][3] = 0.f; }
        f32x4 wr[32];
#pragma unroll
        for (int i = 0; i < 32; ++i) wr[i] = *(const f32x4*)(W + (size_t)(F.wave * 128 + i * 4 + kq) * 3072);
#pragma unroll
        for (int i = 0; i < 32; ++i) {
            const int k = F.wave * 128 + i * 4 + kq;
            const f32x4 w = wr[i];
#pragma unroll
            for (int b = 0; b < 8; ++b) { const float s = sc[b * 1024 + k]; acc[b][0] += s * w[0]; acc[b][1] += s * w[1]; acc[b][2] += s * w[2]; acc[b][3] += s * w[3]; }
        }
#pragma unroll
        for (int b = 0; b < 8; ++b)
#pragma unroll
            for (int j = 0; j < 4; ++j) { float v = acc[b][j]; v += __shfl_xor(v, 16); v += __shfl_xor(v, 32); acc[b][j] = v; }
        if (kq == 0) {
#pragma unroll
            for (int b = 0; b < 8; ++b) *(LAS f32x4*)(red + (F.wave * 8 + b) * 64 + c4) = (f32x4){acc[b][0], acc[b][1], acc[b][2], acc[b][3]};
        }
        __syncthreads();
        { const int b = F.tid >> 6, col = F.tid & 63; float s = 0.f;
#pragma unroll
          for (int w = 0; w < 8; ++w) s += red[(w * 8 + b) * 64 + col];
          mod[((size_t)ls * 8 + b) * 3072 + cg * 64 + col] = s + adab[ls * 3072 + cg * 64 + col]; }
        __syncthreads();
    }
}

__device__ __forceinline__ void tr_item(const float* W, int ldw, bf16* WT, int ldt, LAS float* scr, int lane) {
#pragma unroll 8
    for (int i = 0; i < 32; ++i) { const int kk = 2 * i + (lane >> 5); scr[kk * 33 + (lane & 31)] = W[(size_t)kk * ldw + (lane & 31)]; }
    LDS_WAIT(); asm volatile("" ::: "memory");
    const int c = lane & 7;
#pragma unroll
    for (int j = 0; j < 4; ++j) { const int n = (lane >> 3) + 8 * j; const LAS float* s = scr + (8 * c) * 33 + n;
        v4u o; o.x = pk2(s[0 * 33], s[1 * 33]); o.y = pk2(s[2 * 33], s[3 * 33]); o.z = pk2(s[4 * 33], s[5 * 33]); o.w = pk2(s[6 * 33], s[7 * 33]);
        *(v4u*)(WT + (size_t)n * ldt + 8 * c) = o; }
    LDS_WAIT(); asm volatile("" ::: "memory");
}
__device__ __forceinline__ void tr_item8(const float* W, int ldw, unsigned char* WT, int ldt, LAS float* scr, int lane) {
#pragma unroll 8
    for (int i = 0; i < 64; ++i) { const int kk = 2 * i + (lane >> 5); scr[kk * 33 + (lane & 31)] = W[(size_t)kk * ldw + (lane & 31)] * 32.0f; }
    LDS_WAIT(); asm volatile("" ::: "memory");
    const int n = lane >> 1, kh = (lane & 1) * 64; const LAS float* sp = scr + kh * 33 + n;
    unsigned char* dst = WT + (size_t)n * ldt + kh;
#pragma unroll
    for (int q = 0; q < 4; ++q) { v4u o;
        o.x = pg8::pk4_fp8(sp[(16 * q + 0) * 33], sp[(16 * q + 1) * 33], sp[(16 * q + 2) * 33], sp[(16 * q + 3) * 33]); o.y = pg8::pk4_fp8(sp[(16 * q + 4) * 33], sp[(16 * q + 5) * 33], sp[(16 * q + 6) * 33], sp[(16 * q + 7) * 33]);
        o.z = pg8::pk4_fp8(sp[(16 * q + 8) * 33], sp[(16 * q + 9) * 33], sp[(16 * q + 10) * 33], sp[(16 * q + 11) * 33]); o.w = pg8::pk4_fp8(sp[(16 * q + 12) * 33], sp[(16 * q + 13) * 33], sp[(16 * q + 14) * 33], sp[(16 * q + 15) * 33]);
        *(v4u*)(dst + 16 * q) = o; }
    LDS_WAIT(); asm volatile("" ::: "memory");
}
__device__ __forceinline__ void p_convert(Frame& F) {
    LAS float* scr = (LAS float*)(F.lds + F.wave * 17408);
    const float* in_mwin = KIN(I_MWIN); const float* in_mwout = KIN(I_MWOUT); const float* in_swin = KIN(I_SWIN); const float* in_swout = KIN(I_SWOUT);
    const float* in_ewg = KIN(I_EWG); const float* in_ewu = KIN(I_EWU); const float* in_ewd = KIN(I_EWD);
    const int gw = blockIdx.x * NWAVES + F.wave, NGW = F.G * NWAVES;
    constexpr int I_A = 2 * 16 * 96, I_B = 2 * 16 * 32, I_C2 = I_A, I_D = 2 * 8 * 32, I_E = 128 * 8 * 16, I_F = I_E, I_G = 128 * 4 * 32;
    constexpr int NITEMS = I_A + I_B + I_C2 + I_D + I_E + I_F + I_G;
    static_assert(NITEMS == 27 * 2048 + 3 * 512, "item deal");
    const bool bal = (F.G == 256);
    for (int rr = 0; ; ++rr) {
        int it;
        if (!bal) { it = rr * NGW + gw; if (it >= NITEMS) break; }
        else if (rr < 27) it = rr * 2048 + gw;
        else { if (gw < 1024 || rr >= 29) break; it = 27 * 2048 + (rr - 27) * 1024 + (gw - 1024); if (it >= NITEMS) break; }
        int r = it;
        if (r < I_A) { const int j = r / 1536, q = r % 1536, kb = q / 96, nb = q % 96;
            tr_item(in_mwin + (size_t)j * 1024 * M_PROJ + (size_t)kb * 64 * M_PROJ + nb * 32, M_PROJ, (bf16*)(F.ws + WS_WMIN) + (size_t)j * 3072 * 1024 + (size_t)nb * 32 * 1024 + kb * 64, 1024, scr, F.lane); continue; } r -= I_A;
        if (r < I_B) { const int j = r / 512, q = r % 512, kb = q / 32, nb = q % 32;
            tr_item(in_mwout + (size_t)j * 1024 * 1024 + (size_t)kb * 64 * 1024 + nb * 32, 1024, (bf16*)(F.ws + WS_WMOUT) + (size_t)j * 1024 * 1024 + (size_t)nb * 32 * 1024 + kb * 64, 1024, scr, F.lane); continue; } r -= I_B;
        if (r < I_C2) { const int j = r / 1536, q = r % 1536, kb = q / 96, nb = q % 96, n0 = nb * 32;
            int drow; if (n0 < 1024) drow = 2048 + n0; else if (n0 < 2048) { const int cc = n0 - 1024; drow = 256 * (cc >> 7) + (cc & 127); } else { const int cc = n0 - 2048; drow = 256 * (cc >> 7) + 128 + (cc & 127); }
            tr_item(in_swin + (size_t)j * 1024 * 3072 + (size_t)kb * 64 * 3072 + n0, 3072, (bf16*)(F.ws + WS_WSIN) + (size_t)j * 3072 * 1024 + (size_t)drow * 1024 + kb * 64, 1024, scr, F.lane); continue; } r -= I_C2;
        if (r < I_D) { const int j = r / 256, q = r % 256, kb = q / 32, nb = q % 32;
            tr_item8(in_swout + (size_t)j * 1024 * 1024 + (size_t)kb * 128 * 1024 + nb * 32, 1024, (unsigned char*)(F.ws + WS_WSOUT) + (size_t)j * 1024 * 1024 + (size_t)nb * 32 * 1024 + kb * 128, 1024, scr, F.lane); continue; } r -= I_D;
        if (r < I_E + I_F) { const bool up = r >= I_E; if (up) r -= I_E; const int mat = r / 128, q = r % 128, kb = q / 16, nb = q % 16, n0 = nb * 32;
            const int drow = 256 * (n0 >> 7) + (up ? 128 : 0) + (n0 & 127);
            tr_item8((up ? in_ewu : in_ewg) + (size_t)mat * 1024 * 512 + (size_t)kb * 128 * 512 + n0, 512, (unsigned char*)(F.ws + WS_WGU) + (size_t)mat * 1024 * 1024 + (size_t)drow * 1024 + kb * 128, 1024, scr, F.lane); continue; } r -= I_E + I_F;
        { const int mat = r / 128, q = r % 128, kb = q / 32, nb = q % 32;
            tr_item8(in_ewd + (size_t)mat * 512 * 1024 + (size_t)kb * 128 * 1024 + nb * 32, 1024, (unsigned char*)(F.ws + WS_WDN) + (size_t)mat * 1024 * 512 + (size_t)nb * 32 * 512 + kb * 128, 512, scr, F.lane); }
    }
}

__device__ __forceinline__ void moe_tables(Frame& F, int layer) {
    if (F.tid < 64) {
        const int e = F.tid & 31;
        const int c = (int)__hip_atomic_load(F.ctl + CW_CNT + (layer * 32 + e) * 16, __ATOMIC_RELAXED, __HIP_MEMORY_SCOPE_AGENT);
        const int tl = (c + 255) >> 8, rem = c - (tl - 1) * 256;
        const int sm = (tl > 0 && rem <= 128) ? 1 : 0, nb = tl - sm;
        int incb = (F.tid < 32) ? nb : 0, incs = (F.tid < 32) ? sm : 0;
#define MT_DPP(x, ctrl, rowmask) __builtin_amdgcn_update_dpp(0, x, ctrl, rowmask, 0xf, false)
        incb += MT_DPP(incb, 0x111, 0xf); incb += MT_DPP(incb, 0x112, 0xf); incb += MT_DPP(incb, 0x114, 0xf); incb += MT_DPP(incb, 0x118, 0xf); incb += MT_DPP(incb, 0x142, 0xa); incb += MT_DPP(incb, 0x143, 0xc);
        incs += MT_DPP(incs, 0x111, 0xf); incs += MT_DPP(incs, 0x112, 0xf); incs += MT_DPP(incs, 0x114, 0xf); incs += MT_DPP(incs, 0x118, 0xf); incs += MT_DPP(incs, 0x142, 0xa); incs += MT_DPP(incs, 0x143, 0xc);
#undef MT_DPP
        if (F.tid < 32) { F.LC[LC_TOFF + e] = (unsigned)(incb - nb); F.LC[LC_SOFF + e] = (unsigned)(incs - sm); F.LC[LC_CNT + e] = (unsigned)c;
            if (sm) F.LC[LC_SEXP + (incs - sm)] = (unsigned)e;
            if (e == 31) { F.LC[LC_TOFF + 32] = (unsigned)incb; F.LC[LC_SOFF + 32] = (unsigned)incs; } }
    }
    __syncthreads();
}
__device__ __forceinline__ int moe_slot(Frame& F, int p) {
    const int e = p & 31, pos = p >> 5, k = pos >> 8, b0 = (int)F.LC[LC_TOFF + e], nb = (int)F.LC[LC_TOFF + e + 1] - b0;
    const int tile = (k < nb) ? b0 + k : (int)F.LC[LC_TOFF + 32] + (int)F.LC[LC_SOFF + e];
    return tile * 256 + (pos & 255);
}
__device__ __forceinline__ void p_rtab(Frame& F) {
    constexpr int NC = 36;
    LAS float* gsL = (LAS float*)F.lds; LAS float* shL = gsL + 128; LAS float* r2 = shL + 128;
    const float* MODp = (const float*)(F.ws + WS_MOD);
    for (int job = blockIdx.x; job < 256; job += F.G) {
        const int part = job & 7, tb = job >> 3, l = tb >> 3, b = tb & 7;
        const float* modn = MODp + (size_t)((l * 2 + 1) * 8 + b) * 3072; const float* ng = KIN(I_NORMG) + (l * 2 + 1) * 1024;
        const float* wg = KIN(I_RWG) + (size_t)l * 1024 * 4; const float* we = KIN(I_RWE) + (size_t)l * 1024 * 32;
        if (F.tid < 128) { const int k = part * 128 + F.tid; gsL[F.tid] = ng[k] * (1.0f + modn[1024 + k]); shL[F.tid] = modn[k]; }
        __syncthreads();
        unsigned char* tab = F.ws + WS_RTAB + (size_t)tb * (NC * 4096);
        for (int t = F.tid; t < 16 * NC; t += NTHR) {
            const int n = t % NC, kcl = t / NC, kc = part * 16 + kcl;
            const float* wcol = (n < 4) ? wg + n : we + (n - 4); const int wstr = (n < 4) ? 4 : 32;
            float wv[8];
#pragma unroll
            for (int jj = 0; jj < 8; ++jj) wv[jj] = wcol[(size_t)(8 * kc + jj) * wstr];
            float cs = 0.f, pv[8];
#pragma unroll
            for (int jj = 0; jj < 8; ++jj) { cs += shL[8 * kcl + jj] * wv[jj]; pv[jj] = wv[jj] * gsL[8 * kcl + jj]; }
            v4u hi, lo; unsigned* hp = (unsigned*)&hi; unsigned* lp = (unsigned*)&lo;
#pragma unroll
            for (int e = 0; e < 4; ++e) { const unsigned w2 = pg8::cvt_pk_bf16(pv[2 * e], pv[2 * e + 1]); hp[e] = w2;
                lp[e] = pg8::cvt_pk_bf16(pv[2 * e] - __builtin_bit_cast(float, w2 << 16), pv[2 * e + 1] - __builtin_bit_cast(float, w2 & 0xffff0000u)); }
            *(v4u*)(tab + (kc * NC + n) * 16) = hi; *(v4u*)(tab + NC * 2048 + (kc * NC + n) * 16) = lo;
            r2[kcl * NC + n] = cs;
        }
        __syncthreads();
        if (F.tid < NC) { float sacc = 0.f;
#pragma unroll
            for (int q = 0; q < 16; ++q) sacc += r2[q * NC + F.tid];
            ((float*)(F.ws + WS_RCS))[(tb * 8 + part) * NC + F.tid] = sacc; }
        __syncthreads();
    }
}
template <int NC> __device__ __forceinline__ void wtab_put(LAS unsigned char* base, int k, int n, float v) {
    const unsigned hi = f2bf(v); const unsigned lo = f2bf(v - __builtin_bit_cast(float, hi << 16));
    const int off = ((k >> 3) * NC + n) * 16 + (k & 7) * 2;
    *(LAS unsigned short*)(base + off) = (unsigned short)hi; *(LAS unsigned short*)(base + NC * 2048 + off) = (unsigned short)lo;
}
typedef short rbf16x8 __attribute__((ext_vector_type(8)));
template <bool COMBINE, int AUX, bool FINAL, bool XF32 = false>
__device__ __forceinline__ void row_phase(Frame& F, const void* xsrc_, void* xdst_, const float* modn, const float* ng, const float* modprev, int prev_layer,
                                          const float* auxw0, const float* auxw1, const float* auxb0, const float* auxb1, int layer) {
    constexpr int NC = (AUX == 2) ? 36 : 8, NT = (NC + 15) / 16;
    constexpr int OFF_RINV = 147456, OFF_LOGIT = OFF_RINV + 256, OFF_ROWE = OFF_LOGIT + 64 * 36 * 4, OFF_ROWW = OFF_ROWE + 512, OFF_CB = OFF_ROWW + 512, OFF_R2 = OFF_CB + 256;
    static_assert(OFF_R2 + 14 * 36 * 4 <= LDSCTL_OFF && 64 * 8 * 4 <= 14 * 36 * 4 + 64, "row phase LDS map");
    const int lane = F.lane;
    const float* xsrc32 = (const float*)xsrc_; const bf16* xsrc16 = (const bf16*)xsrc_;
    float* xdst32 = (float*)xdst_; bf16* xdst16 = (bf16*)xdst_;
    if (COMBINE && N_LAUNCH_SPLIT) moe_tables(F, prev_layer);
    const int* tokpos = (const int*)(F.ws + WS_TOKPOS); const float* tokw = (const float*)(F.ws + WS_TOKW);
    const unsigned char* YR = (const unsigned char*)(F.ws + WS_YR);
    bf16* H = (bf16*)(F.ws + WS_H);
    LAS float* rinvL = (LAS float*)(F.lds + OFF_RINV);
    LAS float* logit = (LAS float*)(F.lds + OFF_LOGIT);
    LAS int* rowE = (LAS int*)(F.lds + OFF_ROWE);
    LAS float* rowW = (LAS float*)(F.lds + OFF_ROWW);
    LAS float* cbL = (LAS float*)(F.lds + OFF_CB);
    LAS float* r2 = (LAS float*)(F.lds + OFF_R2);
    int tab_b = -1;
#ifdef SCAN_SELFCHECK
    const float FLAGSCALE = (FINAL && __hip_atomic_load(F.ctl + 64, __ATOMIC_RELAXED, __HIP_MEMORY_SCOPE_AGENT) != 0u) ? 2.0f : 1.0f;
#else
    const float FLAGSCALE = 1.0f;
#endif
#if defined(TPSUB)
    unsigned long long ts0 = __builtin_amdgcn_s_memrealtime(), ts1 = ts0;
#define TS_MARK(k) do { if (AUX == 2) { asm volatile("s_waitcnt vmcnt(0)" ::: "memory"); __syncthreads(); ts1 = __builtin_amdgcn_s_memrealtime(); if (TPSUB == (k) && F.tid == 0) atomicMax(F.ctl + 80, (unsigned)(ts1 - ts0)); ts0 = ts1; } } while (0)
#else
#define TS_MARK(k)
#endif
    for (int rg = blockIdx.x; rg < NTOK / 64; rg += F.G) {
        const int b = rg >> 5;
        if (AUX == 2 && b != tab_b) {
            tab_b = b;
            const unsigned char* tab = F.ws + WS_RTAB + (size_t)(layer * 8 + b) * (NC * 4096);
#pragma unroll
            for (int i = 0; i < 18; ++i) __builtin_amdgcn_global_load_lds((const unsigned*)(tab + (size_t)(F.tid + NTHR * i) * 16), (LAS unsigned*)(F.lds + F.wave * 1024 + i * 8192), 16, 0, 0);
            if (F.tid < NC) { const float* rcs = (const float*)(F.ws + WS_RCS) + (size_t)(layer * 8 + b) * 8 * NC; float sacc = 0.f;
#pragma unroll
                for (int q = 0; q < 8; ++q) sacc += rcs[q * NC + F.tid];
                cbL[F.tid] = sacc; }
        } else if (AUX == 1 && b != tab_b) {
            tab_b = b;
            const float* shp = modn + b * 3072; const float* scp = shp + 1024;
            LAS float* gsL = logit; LAS float* shL = logit + 1024;
            for (int k = F.tid; k < 1024; k += NTHR) { gsL[k] = ng[k] * (1.0f + scp[k]); shL[k] = shp[k]; }
            __syncthreads();
            constexpr int NQ = (AUX == 2) ? 14 : 4, NI = (AUX == 2) ? 10 : 1;
            if (AUX == 1) {
                float cs4[4] = {0.f, 0.f, 0.f, 0.f};
                if (F.tid < 256) { const int kc = F.tid >> 1, c4 = F.tid & 1; f32x4 wq[8];
#pragma unroll
                    for (int jj = 0; jj < 8; ++jj) wq[jj] = *(const f32x4*)(auxw0 + (size_t)(8 * kc + jj) * M_PROJ + NPROJ + 4 * c4);
#pragma unroll
                    for (int e = 0; e < 4; ++e) { float pv[8];
#pragma unroll
                        for (int jj = 0; jj < 8; ++jj) { const int k = 8 * kc + jj; cs4[e] += shL[k] * wq[jj][e]; pv[jj] = wq[jj][e] * gsL[k]; }
                        v4u hi, lo; unsigned* hp = (unsigned*)&hi; unsigned* lp = (unsigned*)&lo;
#pragma unroll
                        for (int q = 0; q < 4; ++q) { const unsigned w2 = pg8::cvt_pk_bf16(pv[2 * q], pv[2 * q + 1]); hp[q] = w2;
                            lp[q] = pg8::cvt_pk_bf16(pv[2 * q] - __builtin_bit_cast(float, w2 << 16), pv[2 * q + 1] - __builtin_bit_cast(float, w2 & 0xffff0000u)); }
                        *(LAS v4u*)(F.lds + (kc * NC + 4 * c4 + e) * 16) = hi; *(LAS v4u*)(F.lds + NC * 2048 + (kc * NC + 4 * c4 + e) * 16) = lo; } }
#pragma unroll
                for (int e = 0; e < 4; ++e) { float t = cs4[e]; t += __shfl_xor(t, 2); t += __shfl_xor(t, 4); t += __shfl_xor(t, 8); t += __shfl_xor(t, 16); t += __shfl_xor(t, 32); cs4[e] = t; }
                if (F.tid < 256 && lane < 2) {
#pragma unroll
                    for (int e = 0; e < 4; ++e) r2[F.wave * NC + 4 * lane + e] = cs4[e]; }
            } else {
            if (F.tid < NQ * NC) {
                const int n = F.tid % NC, kcq = F.tid / NC; float cs = 0.f;
                const float* wcol = (AUX == 1) ? auxw0 + NPROJ + n : ((n < 4) ? auxw0 + n : auxw1 + (n - 4));
                const int wstr = (AUX == 1) ? M_PROJ : ((n < 4) ? 4 : 32);
                constexpr int NB = (NI + 4) / 5;
#pragma unroll 1
                for (int bt = 0; bt < NB; ++bt) {
                    float wv[5][8];
#pragma unroll
                    for (int i = 0; i < 5; ++i) { const int kcr = kcq + NQ * (5 * bt + i); const int kc = kcr < 128 ? kcr : 127; const float* wp = wcol + (size_t)(8 * kc) * wstr;
#pragma unroll
                        for (int jj = 0; jj < 8; ++jj) wv[i][jj] = wp[jj * wstr]; }
#pragma unroll
                    for (int i = 0; i < 5; ++i) { const int kcr = kcq + NQ * (5 * bt + i); const bool valid = kcr < 128 && (5 * bt + i) < NI; const int kc = kcr < 128 ? kcr : 127;
                        float pv[8];
#pragma unroll
                        for (int jj = 0; jj < 8; ++jj) { const int k = 8 * kc + jj; cs += valid ? shL[k] * wv[i][jj] : 0.f; pv[jj] = wv[i][jj] * gsL[k]; }
                        v4u hi, lo; unsigned* hp = (unsigned*)&hi; unsigned* lp = (unsigned*)&lo;
#pragma unroll
                        for (int e = 0; e < 4; ++e) { const unsigned w2 = pg8::cvt_pk_bf16(pv[2 * e], pv[2 * e + 1]); hp[e] = w2;
                            lp[e] = pg8::cvt_pk_bf16(pv[2 * e] - __builtin_bit_cast(float, w2 << 16), pv[2 * e + 1] - __builtin_bit_cast(float, w2 & 0xffff0000u)); }
                        *(LAS v4u*)(F.lds + (kc * NC + n) * 16) = hi; *(LAS v4u*)(F.lds + NC * 2048 + (kc * NC + n) * 16) = lo;
                    }
                }
                r2[kcq * NC + n] = cs;
            }
            }
            __syncthreads();
            if (F.tid < NC) { float sacc = 0.f; for (int q = 0; q < NQ; ++q) sacc += r2[q * NC + F.tid]; cbL[F.tid] = sacc; }
            __syncthreads();
        }
        TS_MARK(1);
        if (AUX == 2 && F.tid < 32) F.LC[LC_LCNT + F.tid] = 0u;
        {
            constexpr int RB = COMBINE ? 2 : 4;
            LAS int* slotP = (LAS int*)r2 + F.wave * 32; LAS float* slotW = (LAS float*)r2 + F.wave * 32 + 16;
            int tpw = 0; float tww = 0.f;
            if (COMBINE) { const int sb0 = (rg * 64 + F.wave * 8) * 2 + (lane & 15); tpw = tokpos[sb0]; tww = tokw[sb0]; }
            f32x4 gsv[4], shv[4], gtv[4];
#pragma unroll
            for (int j = 0; j < 4; ++j) {
                const f32x4 g = *((const f32x4*)ng + lane + 64 * j);
                if (FINAL) { gsv[j] = g; shv[j] = (f32x4){0.f, 0.f, 0.f, 0.f}; }
                else { const f32x4 scl = *((const f32x4*)(modn + b * 3072 + 1024) + lane + 64 * j); gsv[j] = g * (1.0f + scl); shv[j] = *((const f32x4*)(modn + b * 3072) + lane + 64 * j); }
                if (COMBINE) gtv[j] = *((const f32x4*)(modprev + b * 3072 + 2048) + lane + 64 * j);
            }
            if (COMBINE) { if (lane < 16) { slotP[lane] = tpw; slotW[lane] = tww; } }
            for (int i0 = 0; i0 < 8; i0 += RB) {
                const int rowb = rg * 64 + F.wave * 8 + i0;
                f32x4 v[RB][4]; unsigned y0[RB][4], y1[RB][4]; float w0[RB], w1[RB];
#pragma unroll
                for (int r = 0; r < RB; ++r) {
#pragma unroll
                    for (int j = 0; j < 4; ++j) {
                        if (XF32) v[r][j] = *((const f32x4*)(xsrc32 + (size_t)(rowb + r) * D) + lane + 64 * j);
                        else { const v2u w = *((const v2u*)(xsrc16 + (size_t)(rowb + r) * D) + lane + 64 * j); v[r][j] = (f32x4){bflo(w.x), bfhi(w.x), bflo(w.y), bfhi(w.y)}; } }
                }
#pragma unroll
                for (int r = 0; r < RB; ++r) {
                    if (COMBINE) {
                        const int p0 = __builtin_amdgcn_readfirstlane(slotP[2 * (i0 + r)]), p1 = __builtin_amdgcn_readfirstlane(slotP[2 * (i0 + r) + 1]);
                        w0[r] = slotW[2 * (i0 + r)] * pg8::W8_INV; w1[r] = slotW[2 * (i0 + r) + 1] * pg8::W8_INV;
                        const int s0 = moe_slot(F, p0), s1 = moe_slot(F, p1);
#pragma unroll
                        for (int j = 0; j < 4; ++j) { y0[r][j] = *((const unsigned*)(YR + (size_t)s0 * D) + lane + 64 * j); y1[r][j] = *((const unsigned*)(YR + (size_t)s1 * D) + lane + 64 * j); }
                    }
                }
#pragma unroll
                for (int r = 0; r < RB; ++r) {
                    const int row = rowb + r;
                    if (COMBINE) {
#pragma unroll
                        for (int j = 0; j < 4; ++j) {
                            v[r][j][0] += gtv[j][0] * (w0[r] * __builtin_amdgcn_cvt_f32_fp8(y0[r][j], 0) + w1[r] * __builtin_amdgcn_cvt_f32_fp8(y1[r][j], 0)); v[r][j][1] += gtv[j][1] * (w0[r] * __builtin_amdgcn_cvt_f32_fp8(y0[r][j], 1) + w1[r] * __builtin_amdgcn_cvt_f32_fp8(y1[r][j], 1));
                            v[r][j][2] += gtv[j][2] * (w0[r] * __builtin_amdgcn_cvt_f32_fp8(y0[r][j], 2) + w1[r] * __builtin_amdgcn_cvt_f32_fp8(y1[r][j], 2)); v[r][j][3] += gtv[j][3] * (w0[r] * __builtin_amdgcn_cvt_f32_fp8(y0[r][j], 3) + w1[r] * __builtin_amdgcn_cvt_f32_fp8(y1[r][j], 3));
                        }
                        if (!FINAL) {
#pragma unroll
                            for (int j = 0; j < 4; ++j) { v2u o; o.x = pk2(v[r][j][0], v[r][j][1]); o.y = pk2(v[r][j][2], v[r][j][3]); *((v2u*)(xdst16 + (size_t)row * D) + lane + 64 * j) = o;
                                v[r][j] = (f32x4){bflo(o.x), bfhi(o.x), bflo(o.y), bfhi(o.y)}; }
                        }
                    }
                    if (XF32 && !COMBINE) {
#pragma unroll
                        for (int j = 0; j < 4; ++j) { v2u o; o.x = pk2(v[r][j][0], v[r][j][1]); o.y = pk2(v[r][j][2], v[r][j][3]); *((v2u*)(xdst16 + (size_t)row * D) + lane + 64 * j) = o;
                            v[r][j] = (f32x4){bflo(o.x), bfhi(o.x), bflo(o.y), bfhi(o.y)}; }
                    }
                    float ss = 0.f;
#pragma unroll
                    for (int j = 0; j < 4; ++j) ss += (v[r][j][0] * v[r][j][0] + v[r][j][1] * v[r][j][1]) + (v[r][j][2] * v[r][j][2] + v[r][j][3] * v[r][j][3]);
                    const float rinv = 1.0f / sqrtf(wave_sum(ss) * (1.0f / D) + EPS);
                    if (FINAL) {
#pragma unroll
                        for (int j = 0; j < 4; ++j) *((f32x4*)(xdst32 + (size_t)row * D) + lane + 64 * j) = v[r][j] * (rinv * FLAGSCALE) * gsv[j];
                    } else {
                        if (AUX != 0 && lane == 0) rinvL[F.wave * 8 + i0 + r] = rinv;
#pragma unroll
                        for (int j = 0; j < 4; ++j) { const f32x4 h = (v[r][j] * rinv) * gsv[j] + shv[j];
                            if (AUX == 2) *((unsigned*)((unsigned char*)H + (size_t)row * D) + lane + 64 * j) = pg8::pk4_fp8(h[0], h[1], h[2], h[3]);
                            else { v2u o; o.x = pk2(h[0], h[1]); o.y = pk2(h[2], h[3]); *((v2u*)(H + (size_t)row * D) + lane + 64 * j) = o; } }
                    }
                }
            }
        }
        TS_MARK(2);
        if (AUX != 0) {
            if (AUX == 2) asm volatile("s_waitcnt vmcnt(0)" ::: "memory");
            __syncthreads();
            const int l15 = lane & 15, g4 = lane >> 4, tile = F.wave >> 1, kh = F.wave & 1;
            const int trow = rg * 64 + tile * 16 + l15;
            constexpr bool XLO = false;
            const float* xr32 = xsrc32 + (size_t)trow * D; const bf16* xr16 = ((COMBINE || XF32) ? (const bf16*)xdst16 : xsrc16) + (size_t)trow * D;
            f32x4 acc[NT];
#pragma unroll
            for (int nt = 0; nt < NT; ++nt) acc[nt] = (f32x4){0.f, 0.f, 0.f, 0.f};
#pragma unroll 8
            for (int ks = kh * 16; ks < kh * 16 + 16; ++ks) {
                const int k0 = 32 * ks + 8 * g4;
                v4u hi, lo = (v4u){0u, 0u, 0u, 0u};
                if (XLO) {
                    const f32x4 x0 = *(const f32x4*)(xr32 + k0), x1 = *(const f32x4*)(xr32 + k0 + 4);
                    const float hv[8] = {x0[0], x0[1], x0[2], x0[3], x1[0], x1[1], x1[2], x1[3]};
                    unsigned* hp = (unsigned*)&hi; unsigned* lp = (unsigned*)&lo;
#pragma unroll
                    for (int e = 0; e < 4; ++e) { const unsigned w2 = pg8::cvt_pk_bf16(hv[2 * e], hv[2 * e + 1]); hp[e] = w2;
                        lp[e] = pg8::cvt_pk_bf16(hv[2 * e] - __builtin_bit_cast(float, w2 << 16), hv[2 * e + 1] - __builtin_bit_cast(float, w2 & 0xffff0000u)); }
                } else hi = *(const v4u*)(xr16 + k0);
                const rbf16x8 Ahi = __builtin_bit_cast(rbf16x8, hi), Alo = __builtin_bit_cast(rbf16x8, lo);
#pragma unroll
                for (int nt = 0; nt < NT; ++nt) {
                    const int n = (16 * nt + l15) < NC ? (16 * nt + l15) : (NC - 1);
                    const LAS unsigned char* tp = F.lds + ((4 * ks + g4) * NC + n) * 16;
                    const rbf16x8 Bhi = *(const LAS rbf16x8*)tp, Blo = *(const LAS rbf16x8*)(tp + NC * 2048);
                    acc[nt] = __builtin_amdgcn_mfma_f32_16x16x32_bf16(Ahi, Bhi, acc[nt], 0, 0, 0);
                    if (XLO) acc[nt] = __builtin_amdgcn_mfma_f32_16x16x32_bf16(Alo, Bhi, acc[nt], 0, 0, 0);
                    acc[nt] = __builtin_amdgcn_mfma_f32_16x16x32_bf16(Ahi, Blo, acc[nt], 0, 0, 0);
                }
            }
            TS_MARK(5);
            if (kh == 1) {
#pragma unroll
                for (int nt = 0; nt < NT; ++nt) { const int n = 16 * nt + l15;
                    if (n < NC) {
#pragma unroll
                        for (int r = 0; r < 4; ++r) logit[(tile * 16 + 4 * g4 + r) * NC + n] = acc[nt][r]; } }
            }
            __syncthreads();
            if (kh == 0) {
#pragma unroll
                for (int nt = 0; nt < NT; ++nt) { const int n = 16 * nt + l15;
                    if (n < NC) {
#pragma unroll
                        for (int r = 0; r < 4; ++r) logit[(tile * 16 + 4 * g4 + r) * NC + n] += acc[nt][r]; } }
            }
            __syncthreads();
        }
        TS_MARK(3);
        if (AUX == 1) {
            if (F.tid < 64) { const int row = rg * 64 + F.tid; const LAS float* lg = logit + F.tid * NC; const float ri = rinvL[F.tid]; float* gp = (float*)(F.ws + WS_GATES) + (size_t)row * 8;
                *(f32x4*)gp = (f32x4){lg[0] * ri + cbL[0], lg[1] * ri + cbL[1], lg[2] * ri + cbL[2], lg[3] * ri + cbL[3]};
                *(f32x4*)(gp + 4) = (f32x4){lg[4] * ri + cbL[4], lg[5] * ri + cbL[5], lg[6] * ri + cbL[6], lg[7] * ri + cbL[7]}; }
            __syncthreads();
        }
        if (AUX == 2) {
            if (F.tid < 64) {
                const LAS float* lg = logit + F.tid * NC; const float ri = rinvL[F.tid];
                float gl[4];
#pragma unroll
                for (int g = 0; g < 4; ++g) gl[g] = lg[g] * ri + cbL[g] + auxb0[g];
                int gs = 0; float gm = gl[0];
#pragma unroll
                for (int g = 1; g < 4; ++g) if (gl[g] > gm) { gm = gl[g]; gs = g; }
                float den = 0.f;
#pragma unroll
                for (int g = 0; g < 4; ++g) den += __expf(gl[g] - gm);
                const float psel = 1.0f / den;
                float el[8];
#pragma unroll
                for (int q = 0; q < 8; ++q) el[q] = lg[4 + gs * 8 + q] * ri + cbL[4 + gs * 8 + q] + auxb1[gs * 8 + q];
                int i1 = 0; float l1 = el[0];
#pragma unroll
                for (int q = 1; q < 8; ++q) if (el[q] > l1) { l1 = el[q]; i1 = q; }
                int i2 = -1; float l2 = -3.0e38f;
#pragma unroll
                for (int q = 0; q < 8; ++q) if (q != i1 && el[q] > l2) { l2 = el[q]; i2 = q; }
                const float ex = __expf(l2 - l1), w1 = psel / (1.0f + ex), w2 = psel * ex / (1.0f + ex);
                rowE[2 * F.tid] = gs * 8 + i1; rowE[2 * F.tid + 1] = gs * 8 + i2; rowW[2 * F.tid] = w1; rowW[2 * F.tid + 1] = w2;
            }
            __syncthreads();
            int e = 0, lp = 0;
            if (F.tid < 128) { e = rowE[F.tid]; lp = (int)__hip_atomic_fetch_add((LAS unsigned*)(F.LC + LC_LCNT + e), 1u, __ATOMIC_RELAXED, __HIP_MEMORY_SCOPE_WORKGROUP); }
            __syncthreads();
            if (F.tid < 32) F.LC[LC_LBASE + F.tid] = __hip_atomic_fetch_add(F.ctl + CW_CNT + (layer * 32 + F.tid) * 16, F.LC[LC_LCNT + F.tid], __ATOMIC_RELAXED, __HIP_MEMORY_SCOPE_AGENT);
            __syncthreads();
            if (F.tid < 128) { const int row = rg * 64 + (F.tid >> 1); const int pos = (int)F.LC[LC_LBASE + e] + lp;
                ((int*)(F.ws + WS_SLOTTOK))[e * 16384 + pos] = row; ((int*)(F.ws + WS_TOKPOS))[row * 2 + (F.tid & 1)] = pos * 32 + e; ((float*)(F.ws + WS_TOKW))[row * 2 + (F.tid & 1)] = rowW[F.tid]; }
            __syncthreads();
        }
        TS_MARK(4);
    }
}

__device__ __forceinline__ float logsigmoid_f(float x) { return fminf(x, 0.f) - __logf(1.0f + __expf(-fabsf(x))); }
__device__ __forceinline__ void p_scan(Frame& F, int j  ) {
    constexpr int QS = 132;
    LAS float* q = (LAS float*)F.lds;
    LAS float* k = q + 64 * QS;
    LAS float* Cm = k + 64 * QS;
    LAS float* vv = Cm + 32 * QS;
    LAS float* vw = vv + 64 * 32;
    LAS float* Sm = vw + 64 * 32;
    LAS float* nn = Sm + 64 * 68;
    LAS float* ga = nn + 128;
    LAS float* gM = ga + 64;
    LAS float* gb = gM + 64;
    LAS float* gden = gb + 64;
    LAS float* gm = gden + 64;
    const bf16* PROJ = (const bf16*)(F.ws + WS_PROJ);
    const float* GATES = (const float*)(F.ws + WS_GATES);
    float* HS = (float*)(F.ws + WS_HS);
    const float* bg = KIN(I_MBG) + j * 8;
    const int tid = F.tid;
    for (int item = blockIdx.x; item < 256; item += F.G) {
        const int b = item >> 5, hd = (item >> 3) & 3, vs = item & 7;
        for (int i = tid; i < 32 * QS; i += NTHR) Cm[i] = 0.f;
        if (tid < 128) nn[tid] = 0.f;
        if (tid == 0) gm[0] = 0.f;
        __syncthreads();
        for (int ch = 0; ch < 32; ++ch) {
            const int row0 = b * SEQ + ch * 64;
            for (int p = tid; p < 2048; p += NTHR) { const int isk = p >> 10, pp = p & 1023, r = pp >> 4, c8 = (pp & 15) * 8;
                const v4u w = *(const v4u*)(PROJ + (size_t)(row0 + r) * NPROJ + isk * 512 + hd * 128 + c8);
                const float sc = isk ? 1.0f : 0.08838834764831845f;
                LAS float* dst = (isk ? k : q) + r * QS + c8;
                *(LAS f32x4*)dst = (f32x4){bflo(w.x) * sc, bfhi(w.x) * sc, bflo(w.y) * sc, bfhi(w.y) * sc};
                *(LAS f32x4*)(dst + 4) = (f32x4){bflo(w.z) * sc, bfhi(w.z) * sc, bflo(w.w) * sc, bfhi(w.w) * sc}; }
            if (tid < 256) { const int r = tid >> 2, c8 = (tid & 3) * 8;
                const v4u w = *(const v4u*)(PROJ + (size_t)(row0 + r) * NPROJ + 1024 + hd * 256 + vs * 32 + c8);
                LAS float* dst = vv + r * 32 + c8;
                *(LAS f32x4*)dst = (f32x4){bflo(w.x), bfhi(w.x), bflo(w.y), bfhi(w.y)}; *(LAS f32x4*)(dst + 4) = (f32x4){bflo(w.z), bfhi(w.z), bflo(w.w), bfhi(w.w)}; }
            if (tid < 64) {
                const float ig = GATES[(size_t)(row0 + tid) * 8 + hd] + bg[hd];
                const float lf = logsigmoid_f(GATES[(size_t)(row0 + tid) * 8 + 4 + hd] + bg[4 + hd]);
                float bc = lf;
#pragma unroll
                for (int o = 1; o < 64; o <<= 1) { const float t = __shfl_up(bc, o); if (tid >= o) bc += t; }
                const float a = ig - bc;
                float pm = a;
#pragma unroll
                for (int o = 1; o < 64; o <<= 1) { const float t = __shfl_up(pm, o); if (tid >= o) pm = fmaxf(pm, t); }
                const float m = gm[0];
                ga[tid] = a; gM[tid] = fmaxf(m, pm); gb[tid] = bc;
            }
            __syncthreads();
            {
                const int s = tid & 63, t0 = (tid >> 6) * 8;
                float acc[8];
#pragma unroll
                for (int i = 0; i < 8; ++i) acc[i] = 0.f;
                for (int d4 = 0; d4 < 32; ++d4) {
                    const f32x4 kv = *(const LAS f32x4*)(k + s * QS + d4 * 4);
#pragma unroll
                    for (int i = 0; i < 8; ++i) { const f32x4 qv = *(const LAS f32x4*)(q + (t0 + i) * QS + d4 * 4); acc[i] += qv[0] * kv[0] + qv[1] * kv[1] + qv[2] * kv[2] + qv[3] * kv[3]; }
                }
                const float as = ga[s];
#pragma unroll
                for (int i = 0; i < 8; ++i) { const int t = t0 + i; Sm[t * 68 + s] = (s <= t) ? acc[i] * __expf(as - gM[t]) : 0.f; }
            }
            __syncthreads();
            {
                const int t = tid >> 3, part = tid & 7; float sden = 0.f, nq = 0.f;
#pragma unroll
                for (int s = 0; s < 8; ++s) sden += Sm[t * 68 + part * 8 + s];
#pragma unroll
                for (int d = 0; d < 16; ++d) nq += nn[part * 16 + d] * q[t * QS + part * 16 + d];
                float tot = sden + __expf(gm[0] - gM[t]) * nq;
                tot += __shfl_xor(tot, 1); tot += __shfl_xor(tot, 2); tot += __shfl_xor(tot, 4);
                if (part == 0) gden[t] = tot;
            }
            __syncthreads();
            {
                const int v = tid & 31, t0 = (tid >> 5) * 4;
                float a1[4] = {0.f, 0.f, 0.f, 0.f}, a2[4] = {0.f, 0.f, 0.f, 0.f};
                for (int s4 = 0; s4 < 16; ++s4) {
                    float vx[4];
#pragma unroll
                    for (int e = 0; e < 4; ++e) vx[e] = vv[(s4 * 4 + e) * 32 + v];
#pragma unroll
                    for (int i = 0; i < 4; ++i) { const f32x4 sv = *(const LAS f32x4*)(Sm + (t0 + i) * 68 + s4 * 4); a1[i] += sv[0] * vx[0] + sv[1] * vx[1] + sv[2] * vx[2] + sv[3] * vx[3]; }
                }
                for (int d4 = 0; d4 < 32; ++d4) {
                    const f32x4 cv = *(const LAS f32x4*)(Cm + v * QS + d4 * 4);
#pragma unroll
                    for (int i = 0; i < 4; ++i) { const f32x4 qv = *(const LAS f32x4*)(q + (t0 + i) * QS + d4 * 4); a2[i] += qv[0] * cv[0] + qv[1] * cv[1] + qv[2] * cv[2] + qv[3] * cv[3]; }
                }
                const float m = gm[0];
#pragma unroll
                for (int i = 0; i < 4; ++i) { const int t = t0 + i; const float Mt = gM[t];
                    const float num = a1[i] + __expf(m - Mt) * a2[i];
                    const float dn = fmaxf(fabsf(gden[t]), __expf(-(gb[t] + Mt)));
                    HS[(size_t)(row0 + t) * D + hd * 256 + vs * 32 + v] = num / dn; }
            }
            for (int p = tid; p < 2048; p += NTHR) { const int s = p >> 5; vw[p] = vv[p] * __expf(ga[s] - gM[63]); }
            __syncthreads();
            {
                const float decay = __expf(gm[0] - gM[63]);
                const int d = tid & 127, v0 = (tid >> 7) * 8;
                float acc[8];
#pragma unroll
                for (int i = 0; i < 8; ++i) acc[i] = decay * Cm[(v0 + i) * QS + d];
                for (int s = 0; s < 64; ++s) {
                    const float kv = k[s * QS + d];
                    const f32x4 w0 = *(const LAS f32x4*)(vw + s * 32 + v0), w1 = *(const LAS f32x4*)(vw + s * 32 + v0 + 4);
                    acc[0] += w0[0] * kv; acc[1] += w0[1] * kv; acc[2] += w0[2] * kv; acc[3] += w0[3] * kv;
                    acc[4] += w1[0] * kv; acc[5] += w1[1] * kv; acc[6] += w1[2] * kv; acc[7] += w1[3] * kv;
                }
                float nacc = 0.f;
                if (tid < 128) { nacc = decay * nn[d]; for (int s = 0; s < 64; ++s) nacc += __expf(ga[s] - gM[63]) * k[s * QS + d]; }
                __syncthreads();
#pragma unroll
                for (int i = 0; i < 8; ++i) Cm[(v0 + i) * QS + d] = acc[i];
                if (tid < 128) nn[d] = nacc;
                if (tid == 0) gm[0] = gb[63] + gM[63];
            }
            __syncthreads();
        }
    }
}

typedef short s16x4 __attribute__((ext_vector_type(4)));
typedef short sbf16x8 __attribute__((ext_vector_type(8)));
#define TR16(p) __builtin_amdgcn_ds_read_tr16_b64_v4i16((LAS s16x4*)(p))
__device__ __forceinline__ sbf16x8 cat4(s16x4 a, s16x4 b) { return __builtin_shufflevector(a, b, 0, 1, 2, 3, 4, 5, 6, 7); }
__device__ __forceinline__ f32x4 mfma16(sbf16x8 a, sbf16x8 b, f32x4 c) { return __builtin_amdgcn_mfma_f32_16x16x32_bf16(a, b, c, 0, 0, 0); }
__device__ __forceinline__ sbf16x8 pack8s(float a0, float a1, float a2, float a3, float a4, float a5, float a6, float a7) {
    v4u w; w.x = pg8::cvt_pk_bf16(a0, a1); w.y = pg8::cvt_pk_bf16(a2, a3); w.z = pg8::cvt_pk_bf16(a4, a5); w.w = pg8::cvt_pk_bf16(a6, a7); return __builtin_bit_cast(sbf16x8, w); }
__device__ __forceinline__ float bf_s(short x) { return __builtin_bit_cast(float, ((unsigned)(unsigned short)x) << 16); }
template <int CTRL, int ROWMASK> __device__ __forceinline__ float dpp_mov(float old, float src) {
    return __builtin_bit_cast(float, __builtin_amdgcn_update_dpp(__builtin_bit_cast(int, old), __builtin_bit_cast(int, src), CTRL, ROWMASK, 0xf, false)); }
__device__ __forceinline__ float wave_scan_sum(float v) {
    v += dpp_mov<0x111, 0xf>(0.f, v); v += dpp_mov<0x112, 0xf>(0.f, v); v += dpp_mov<0x114, 0xf>(0.f, v); v += dpp_mov<0x118, 0xf>(0.f, v);
    v += dpp_mov<0x142, 0xa>(0.f, v); v += dpp_mov<0x143, 0xc>(0.f, v); return v; }
__device__ __forceinline__ float wave_scan_max(float v) {
    v = fmaxf(v, dpp_mov<0x111, 0xf>(v, v)); v = fmaxf(v, dpp_mov<0x112, 0xf>(v, v)); v = fmaxf(v, dpp_mov<0x114, 0xf>(v, v)); v = fmaxf(v, dpp_mov<0x118, 0xf>(v, v));
    v = fmaxf(v, dpp_mov<0x142, 0xa>(v, v)); v = fmaxf(v, dpp_mov<0x143, 0xc>(v, v)); return v; }
template <int NSB>
__device__ __forceinline__ void scan_chunk_body(LAS unsigned char* Qs, LAS unsigned char* Ks, LAS unsigned char* Vs, LAS unsigned char* Vw, LAS unsigned char* Cr, LAS unsigned char* Cw,
                                                const LAS float* WS, const LAS float* ETS, const LAS float* WI, const LAS float* EM, const LAS unsigned short* WSB, const LAS float* DEC,
                                                const int ch, const int tb, const int vt, const int w, const int l15, const int g, const int ql, const int pl, f32x4 (&accC)[3], bf16* orow) {
            constexpr int QB = 272, VB = 80;
            const sbf16x8 ones = (sbf16x8){0x3F80, 0x3F80, 0x3F80, 0x3F80, 0x3F80, 0x3F80, 0x3F80, 0x3F80};
            const int tt = tb * 16 + l15;
            sbf16x8 qf[4], kf[NSB][4]; f32x4 wv[NSB];
#pragma unroll
            for (int kd = 0; kd < 4; ++kd) qf[kd] = *(const LAS sbf16x8*)(Qs + (tb * 16 + l15) * 256 + (((4 * kd + g) ^ l15) * 16));
#pragma unroll
            for (int kd = 0; kd < 4; ++kd)
#pragma unroll
                for (int sb = 0; sb < NSB; ++sb) kf[sb][kd] = *(const LAS sbf16x8*)(Ks + (sb * 16 + l15) * 256 + (((4 * kd + g) ^ l15) * 16));
            const float ets = ETS[ch * 64 + tt];
#pragma unroll
            for (int sb = 0; sb < NSB; ++sb) wv[sb] = *(const LAS f32x4*)(WS + ch * 64 + sb * 16 + 4 * g);
            __builtin_amdgcn_sched_barrier(0);
            f32x4 sacc[NSB]; f32x4 pv = (f32x4){0.f, 0.f, 0.f, 0.f}, qc = pv, qn = pv, psum = pv;
#pragma unroll
            for (int sb = 0; sb < NSB; ++sb) sacc[sb] = (f32x4){0.f, 0.f, 0.f, 0.f};
#pragma unroll
            for (int kd = 0; kd < 4; ++kd) {
#pragma unroll
                for (int sb = 0; sb < NSB; ++sb) sacc[sb] = mfma16(kf[sb][kd], qf[kd], sacc[sb]);
            }
            __builtin_amdgcn_sched_barrier(0);
            sbf16x8 cf[4], nf[4]; s16x4 va[2], vb[2];
#pragma unroll
            for (int ks = 0; ks < 2; ++ks) { va[ks] = TR16(Vs + (32 * ks + 4 * g + ql) * VB + (16 * vt + 4 * pl) * 2); vb[ks] = TR16(Vs + (32 * ks + 16 + 4 * g + ql) * VB + (16 * vt + 4 * pl) * 2); }
#pragma unroll
            for (int kd = 0; kd < 4; ++kd) { cf[kd] = *(const LAS sbf16x8*)(Cr + (16 * vt + l15) * QB + (32 * kd + 8 * g) * 2); nf[kd] = *(const LAS sbf16x8*)(Cr + (32 + l15) * QB + (32 * kd + 8 * g) * 2); }
            const f32x4 wiv = *(const LAS f32x4*)(WI + ch * 64 + tb * 16 + 4 * g), emv = *(const LAS f32x4*)(EM + ch * 64 + tb * 16 + 4 * g);
            __builtin_amdgcn_sched_barrier(0);
            float P[4][4];
#pragma unroll
            for (int sb = 0; sb < 4; ++sb) {
                if (sb < NSB) {
#pragma unroll
                    for (int r = 0; r < 4; ++r) P[sb][r] = ((sb * 16 + 4 * g + r) <= tt) ? sacc[sb < NSB ? sb : 0][r] * wv[sb < NSB ? sb : 0][r] * ets : 0.f;
                } else {
#pragma unroll
                    for (int r = 0; r < 4; ++r) P[sb][r] = 0.f;
                }
            }
#pragma unroll
            for (int ks = 0; ks < 2; ++ks) {
                const sbf16x8 pf = pack8s(P[2 * ks][0], P[2 * ks][1], P[2 * ks][2], P[2 * ks][3], P[2 * ks + 1][0], P[2 * ks + 1][1], P[2 * ks + 1][2], P[2 * ks + 1][3]);
                pv = mfma16(pf, cat4(va[ks], vb[ks]), pv); psum = mfma16(pf, ones, psum);
            }
#pragma unroll
            for (int kd = 0; kd < 4; ++kd) { qc = mfma16(qf[kd], cf[kd], qc); qn = mfma16(qf[kd], nf[kd], qn); }
            __builtin_amdgcn_sched_barrier(0);
            s16x4 k0[2], k1[2], x0[2][2], x1[2][2]; sbf16x8 of[2];
#pragma unroll
            for (int ks = 0; ks < 2; ++ks) {
                const int sr = 32 * ks + 8 * g;
                { const int cq = 2 * w + (pl >> 1), sub = 8 * (pl & 1), rl = 8 * (g & 1) + ql;
                  k0[ks] = TR16(Ks + (sr + ql) * 256 + ((cq ^ rl) * 16) + sub); k1[ks] = TR16(Ks + (sr + 4 + ql) * 256 + ((cq ^ (rl + 4)) * 16) + sub); }
#pragma unroll
                for (int v = 0; v < 2; ++v) { x0[ks][v] = TR16(Vw + (sr + ql) * VB + (16 * v + 4 * pl) * 2); x1[ks][v] = TR16(Vw + (sr + 4 + ql) * VB + (16 * v + 4 * pl) * 2); }
                of[ks] = *(const LAS sbf16x8*)(WSB + ch * 64 + sr);
            }
            const float decay = DEC[ch];
            __builtin_amdgcn_sched_barrier(0);
#pragma unroll
            for (int r = 0; r < 4; ++r) { const float den = psum[r] + wiv[r] * qn[r], num = pv[r] + wiv[r] * qc[r]; orow[(size_t)r * D] = (bf16)f2bf(num * __builtin_amdgcn_rcpf(fmaxf(fabsf(den), emv[r]))); }
#pragma unroll
            for (int v = 0; v < 3; ++v) accC[v] = accC[v] * decay;
#pragma unroll
            for (int ks = 0; ks < 2; ++ks) {
                const sbf16x8 kt = cat4(k0[ks], k1[ks]);
#pragma unroll
                for (int v = 0; v < 2; ++v) accC[v] = mfma16(kt, cat4(x0[ks][v], x1[ks][v]), accC[v]);
                accC[2] = mfma16(kt, of[ks], accC[2]);
            }
#pragma unroll
            for (int v = 0; v < 3; ++v) { v2u o; o.x = pg8::cvt_pk_bf16(accC[v][0], accC[v][1]); o.y = pg8::cvt_pk_bf16(accC[v][2], accC[v][3]); *(LAS v2u*)(Cw + (16 * v + l15) * QB + (16 * w + 4 * g) * 2) = o; }
}
__device__ __forceinline__ void p_scan_mfma(Frame& F, int j, bf16* HS) {
    constexpr int QB = 272, VB = 80;
    constexpr int OFF_Q = 0, OFF_K = 2 * 64 * QB, OFF_V = 4 * 64 * QB, OFF_VW = OFF_V + 2 * 64 * VB, OFF_C = OFF_VW + 2 * 64 * VB;
    constexpr int OFF_WS = OFF_C + 2 * 48 * QB, OFF_ETS = OFF_WS + 8192, OFF_WI = OFF_ETS + 8192, OFF_EM = OFF_WI + 8192, OFF_WSB = OFF_EM + 8192, OFF_DEC = OFF_WSB + 4096, OFF_PM63 = OFF_DEC + 128, OFF_B63 = OFF_PM63 + 128;
    static_assert(OFF_B63 + 128 <= LDSCTL_OFF, "scan LDS map");
    LAS unsigned char* L = F.lds;
    const int tid = F.tid, lane = F.lane, w = F.wave, l15 = lane & 15, g = lane >> 4, ql = l15 >> 2, pl = l15 & 3, tb = w & 3, vt = w >> 2;
    LAS float* WS = (LAS float*)(L + OFF_WS); LAS float* ETS = (LAS float*)(L + OFF_ETS); LAS float* WI = (LAS float*)(L + OFF_WI); LAS float* EM = (LAS float*)(L + OFF_EM);
    LAS unsigned short* WSB = (LAS unsigned short*)(L + OFF_WSB); LAS float* DEC = (LAS float*)(L + OFF_DEC); LAS float* PM63 = (LAS float*)(L + OFF_PM63); LAS float* B63 = (LAS float*)(L + OFF_B63);
    const bf16* PROJ = (const bf16*)(F.ws + WS_PROJ);
    const float* GATES = (const float*)(F.ws + WS_GATES);
    const float* bg = KIN(I_MBG) + j * 8;
    const float scale = 0.08838834764831845f;
    const sbf16x8 ones = (sbf16x8){0x3F80, 0x3F80, 0x3F80, 0x3F80, 0x3F80, 0x3F80, 0x3F80, 0x3F80};
    for (int item0 = blockIdx.x; item0 < 256; item0 += F.G) {
        const int item = (((item0 & 7) * 4 + (item0 >> 6)) << 3) | ((item0 >> 3) & 7);
        const int b = item >> 5, hd = (item >> 3) & 3, vs = item & 7;
        const float bi = bg[hd], bfg = bg[4 + hd];
        const bf16* qbase = PROJ + (size_t)(b * SEQ) * NPROJ + hd * 128;
        const bf16* vbase = PROJ + (size_t)(b * SEQ) * NPROJ + 1024 + hd * 256 + vs * 32;
        const float* gbase = GATES + (size_t)(b * SEQ) * 8 + hd;
        const int svr = (tid >> 2) & 63, svc = (tid & 3) * 8;
        const bf16* gv = vbase + (size_t)svr * NPROJ + svc;
        const int lv0 = svr * VB + svc * 2;
        const int drow = 16 * (w & 3) + (lane >> 4), dch = (lane & 15) ^ (drow & 15);
        const bf16* gqk = qbase + (w >= 4 ? 512 : 0) + (size_t)drow * NPROJ;
        const int qk_lds = (w >= 4 ? OFF_K : OFF_Q) + (w & 3) * 4096;
#define SCAN_DMA(buf, chn) do { _Pragma("unroll") for (int j = 0; j < 4; ++j) \
            __builtin_amdgcn_global_load_lds((const unsigned*)(gqk + (size_t)((chn) * 64 + 4 * j) * NPROJ + (((lane & 15) ^ ((drow + 4 * j) & 15)) * 8)), (LAS unsigned*)(L + qk_lds + (buf) * 64 * QB + j * 1024), 16, 0, 0); } while (0)
        v4u vr = (v4u){0u, 0u, 0u, 0u};
        SCAN_DMA(0, 0);
        if (tid < 256) vr = *(const v4u*)gv;
#ifdef SCAN_ZERO_LDS
        for (int i = tid; i < (OFF_B63 + 128) / 4; i += NTHR) ((LAS unsigned*)L)[i] = 0u;
        __syncthreads();
#endif
        for (int i = tid; i < 48 * QB / 4; i += NTHR) ((LAS unsigned*)(L + OFF_C))[i] = 0u;
#pragma unroll
        for (int cc = 0; cc < 4; ++cc) {
            const int c = 4 * w + cc, pos = c * 64 + lane;
            const float ipre = gbase[(size_t)pos * 8] + bi, lf = logsigmoid_f(gbase[(size_t)pos * 8 + 4] + bfg);
            const float bc = wave_scan_sum(lf);
            const float a = ipre - bc;
            const float pm = wave_scan_max(a);
            WS[pos] = a; ETS[pos] = bc; WI[pos] = pm;
            if (lane == 63) { PM63[c] = pm; B63[c] = bc; }
        }
        __syncthreads();
        {
            float mw[4] = {0.f, 0.f, 0.f, 0.f}; float mc = 0.f;
#pragma unroll
            for (int c = 0; c < 32; ++c) { if ((c >> 2) == w) mw[c & 3] = mc; mc = B63[c] + fmaxf(mc, PM63[c]); }
#pragma unroll
            for (int cc = 0; cc < 4; ++cc) {
                const int c = 4 * w + cc, pos = c * 64 + lane; const float m_c = mw[cc];
                const float a = WS[pos], bc = ETS[pos], pm = WI[pos];
                const float M63 = fmaxf(m_c, PM63[c]), Mt = fmaxf(m_c, pm);
                const float wsv = __expf(a - M63);
                WS[pos] = wsv; WSB[pos] = (unsigned short)f2bf(wsv); ETS[pos] = __expf(M63 - Mt) * scale; WI[pos] = __expf(m_c - Mt) * scale; EM[pos] = __expf(-(bc + Mt));
                if (lane == 0) DEC[c] = __expf(m_c - M63);
            }
        }
        __syncthreads();
        f32x4 accC[3];
#pragma unroll
        for (int v = 0; v < 3; ++v) accC[v] = (f32x4){0.f, 0.f, 0.f, 0.f};
#define SCAN_STAGE(buf, chn) do { \
            if (tid < 256) { *(LAS v4u*)(L + OFF_V + (buf) * 64 * VB + lv0) = vr; const float wsr = WS[(chn) * 64 + svr]; \
                v4u sw; sw.x = pg8::cvt_pk_bf16(bflo(vr.x) * wsr, bfhi(vr.x) * wsr); sw.y = pg8::cvt_pk_bf16(bflo(vr.y) * wsr, bfhi(vr.y) * wsr); sw.z = pg8::cvt_pk_bf16(bflo(vr.z) * wsr, bfhi(vr.z) * wsr); sw.w = pg8::cvt_pk_bf16(bflo(vr.w) * wsr, bfhi(vr.w) * wsr); \
                *(LAS v4u*)(L + OFF_VW + (buf) * 64 * VB + lv0) = sw; } } while (0)
        SCAN_STAGE(0, 0);
        asm volatile("s_waitcnt vmcnt(0)" ::: "memory");
        __syncthreads();
        bf16* obase = HS + (size_t)(b * SEQ + tb * 16 + 4 * g) * D + hd * 256 + vs * 32 + vt * 16 + l15;
        for (int ch = 0; ch < 32; ++ch) {
            const int cb = ch & 1, nb = cb ^ 1;
            LAS unsigned char* Qs = L + OFF_Q + cb * 64 * QB; LAS unsigned char* Ks = L + OFF_K + cb * 64 * QB; LAS unsigned char* Vs = L + OFF_V + cb * 64 * VB; LAS unsigned char* Vw = L + OFF_VW + cb * 64 * VB;
            LAS unsigned char* Cr = L + OFF_C + cb * 48 * QB; LAS unsigned char* Cw = L + OFF_C + nb * 48 * QB;
            { const int nch = (ch < 31 ? ch + 1 : ch); const size_t nro = (size_t)(nch * 64) * NPROJ;
              SCAN_DMA(nb, nch);
              if (tid < 256) vr = *(const v4u*)(gv + nro); }
            { bf16* orow = obase + (size_t)(ch * 64) * D;
              if (tb == 0) scan_chunk_body<1>(Qs, Ks, Vs, Vw, Cr, Cw, WS, ETS, WI, EM, WSB, DEC, ch, tb, vt, w, l15, g, ql, pl, accC, orow);
              else if (tb == 1) scan_chunk_body<2>(Qs, Ks, Vs, Vw, Cr, Cw, WS, ETS, WI, EM, WSB, DEC, ch, tb, vt, w, l15, g, ql, pl, accC, orow);
              else if (tb == 2) scan_chunk_body<3>(Qs, Ks, Vs, Vw, Cr, Cw, WS, ETS, WI, EM, WSB, DEC, ch, tb, vt, w, l15, g, ql, pl, accC, orow);
              else scan_chunk_body<4>(Qs, Ks, Vs, Vw, Cr, Cw, WS, ETS, WI, EM, WSB, DEC, ch, tb, vt, w, l15, g, ql, pl, accC, orow); }
#ifdef SCAN_EXTRA_SYNC
            __syncthreads();
#endif
            SCAN_STAGE(nb, (ch < 31 ? ch + 1 : ch));
            asm volatile("s_waitcnt vmcnt(0)" ::: "memory");
            __syncthreads();
        }
#undef SCAN_STAGE
#undef SCAN_DMA
    }
}

constexpr float A2M_SC = 8.0f, A2C_SC = 1.0f;
__device__ __forceinline__ void p_mnorm(Frame& F, int j) {
    const bf16* HS = (const bf16*)(F.ws + WS_HS); const bf16* PROJ = (const bf16*)(F.ws + WS_PROJ); bf16* A2 = (bf16*)(F.ws + WS_A2);
    const float* ng = KIN(I_MNORMG) + j * 1024;
    const int gw = blockIdx.x * NWAVES + F.wave, NGW = F.G * NWAVES, lane = F.lane;
    f32x4 g[4];
#pragma unroll
    for (int hd = 0; hd < 4; ++hd) g[hd] = *((const f32x4*)ng + lane + 64 * hd);
    for (int row0 = gw * 2; row0 < NTOK; row0 += NGW * 2) {
        f32x4 v[2][4]; v2u ow[2][4];
#pragma unroll
        for (int r = 0; r < 2; ++r)
#pragma unroll
            for (int hd = 0; hd < 4; ++hd) { const v2u hw = *((const v2u*)(HS + (size_t)(row0 + r) * D) + lane + 64 * hd); v[r][hd] = (f32x4){bflo(hw.x), bfhi(hw.x), bflo(hw.y), bfhi(hw.y)}; ow[r][hd] = *((const v2u*)(PROJ + (size_t)(row0 + r) * NPROJ + 2048) + lane + 64 * hd); }
#pragma unroll
        for (int r = 0; r < 2; ++r)
#pragma unroll
            for (int hd = 0; hd < 4; ++hd) {
                const f32x4 x = v[r][hd];
                const float ss = wave_sum((x[0] * x[0] + x[1] * x[1]) + (x[2] * x[2] + x[3] * x[3]));
                const float rinv = 1.0f / sqrtf(ss * (1.0f / 256.0f) + EPS);
                const float o0 = bflo(ow[r][hd].x), o1 = bfhi(ow[r][hd].x), o2 = bflo(ow[r][hd].y), o3 = bfhi(ow[r][hd].y);
                f32x4 q;
                q[0] = x[0] * rinv * g[hd][0] * __builtin_amdgcn_rcpf(1.0f + __expf(-o0)); q[1] = x[1] * rinv * g[hd][1] * __builtin_amdgcn_rcpf(1.0f + __expf(-o1));
                q[2] = x[2] * rinv * g[hd][2] * __builtin_amdgcn_rcpf(1.0f + __expf(-o2)); q[3] = x[3] * rinv * g[hd][3] * __builtin_amdgcn_rcpf(1.0f + __expf(-o3));
                v2u o; o.x = pk2(q[0], q[1]); o.y = pk2(q[2], q[3]);
                *((v2u*)(A2 + (size_t)(row0 + r) * D) + lane + 64 * hd) = o;
            }
    }
}

__device__ __forceinline__ void p_conv(Frame& F, int j) {
    const bf16* PROJ = (const bf16*)(F.ws + WS_PROJ); bf16* A2 = (bf16*)(F.ws + WS_A2);
    const float* cw = KIN(I_SCONVW) + (size_t)j * 3 * 1024;
    for (int item = blockIdx.x * NTHR + F.tid; item < (NTOK / 16) * 128; item += F.G * NTHR) {
        const int cg = item & 127, rc = item >> 7, row0 = rc * 16, ch = cg * 8;
        float w0[8], w1[8], w2[8], um2[8], um1[8];
#pragma unroll
        for (int c = 0; c < 8; ++c) { w0[c] = cw[ch + c]; w1[c] = cw[1024 + ch + c]; w2[c] = cw[2048 + ch + c]; um2[c] = 0.f; um1[c] = 0.f; }
        if ((row0 & (SEQ - 1)) != 0) {
            const v4u a = *(const v4u*)(PROJ + (size_t)(row0 - 2) * NPROJ + ch), bq = *(const v4u*)(PROJ + (size_t)(row0 - 1) * NPROJ + ch);
            um2[0] = bflo(a.x); um2[1] = bfhi(a.x); um2[2] = bflo(a.y); um2[3] = bfhi(a.y); um2[4] = bflo(a.z); um2[5] = bfhi(a.z); um2[6] = bflo(a.w); um2[7] = bfhi(a.w);
            um1[0] = bflo(bq.x); um1[1] = bfhi(bq.x); um1[2] = bflo(bq.y); um1[3] = bfhi(bq.y); um1[4] = bflo(bq.z); um1[5] = bfhi(bq.z); um1[6] = bflo(bq.w); um1[7] = bfhi(bq.w);
        }
#pragma unroll 4
        for (int r = 0; r < 16; ++r) {
            const v4u uw = *(const v4u*)(PROJ + (size_t)(row0 + r) * NPROJ + ch), gw = *(const v4u*)(PROJ + (size_t)(row0 + r) * NPROJ + 1024 + ch);
            float u0[8], g[8], y[8];
            u0[0] = bflo(uw.x); u0[1] = bfhi(uw.x); u0[2] = bflo(uw.y); u0[3] = bfhi(uw.y); u0[4] = bflo(uw.z); u0[5] = bfhi(uw.z); u0[6] = bflo(uw.w); u0[7] = bfhi(uw.w);
            g[0] = bflo(gw.x); g[1] = bfhi(gw.x); g[2] = bflo(gw.y); g[3] = bfhi(gw.y); g[4] = bflo(gw.z); g[5] = bfhi(gw.z); g[6] = bflo(gw.w); g[7] = bfhi(gw.w);
#pragma unroll
            for (int c = 0; c < 8; ++c) { y[c] = g[c] * (w0[c] * um2[c] + w1[c] * um1[c] + w2[c] * u0[c]); um2[c] = um1[c]; um1[c] = u0[c]; }
            v2u o; o.x = pg8::pk4_fp8(y[0] * A2C_SC, y[1] * A2C_SC, y[2] * A2C_SC, y[3] * A2C_SC); o.y = pg8::pk4_fp8(y[4] * A2C_SC, y[5] * A2C_SC, y[6] * A2C_SC, y[7] * A2C_SC);
            *(v2u*)((unsigned char*)A2 + (size_t)(row0 + r) * D + ch) = o;
        }
    }
}

constexpr int N_STEPS = 2 + 2 * (8 + 7);
__global__ void __launch_bounds__(NTHR, 2) trunk_fwd(Args args) {
    extern __shared__ __attribute__((aligned(16))) unsigned char lds_raw[];
    Frame F;
    F.lds = (LAS unsigned char*)lds_raw;
    F.LC = (volatile LAS unsigned*)(F.lds + LDSCTL_OFF);
    F.tid = threadIdx.x; F.lane = F.tid & 63; F.wave = __builtin_amdgcn_readfirstlane(F.tid >> 6); F.G = gridDim.x;
    F.out = as_global(args.out); F.ws = as_global(args.ws); F.ctl = as_global((unsigned*)(args.ws + WS_CTL));
    for (int u = F.tid; u < 256; u += NTHR) F.LC[u] = 0u;
    __syncthreads();
    if (!N_LAUNCH_SPLIT) (void)xcd_barrier_post(F.ctl + CW_BAR, F.LC);
    const int lo = N_LAUNCH_SPLIT ? args.ph_lo : 0, hi = N_LAUNCH_SPLIT ? args.ph_hi : N_STEPS;
    int step = 0;
#ifndef EN_MASK
#define EN_MASK 0xFFFFFFFFu
#endif
#define EN(k) (((EN_MASK) >> (k)) & 1u)
#ifndef OUTPROJ_WGM
#define OUTPROJ_WGM 4
#endif
#ifndef INPROJ_WGM
#define INPROJ_WGM 4
#endif
#ifndef MOE_WGM
#define MOE_WGM 4
#endif
#ifndef BAR_REP
#define BAR_REP 0
#endif
#ifndef REP_MASK
#define REP_MASK 0u
#endif
#define REP(k) for (int _r = 0; _r < 1 + (int)(((REP_MASK) >> (k)) & 1u); ++_r)
#define IN_STEP() (lo <= step && step < hi)
#ifdef TPROBE
    int tp_cur = -1; unsigned long long tp_t0 = 0;
#define TP0(k) tp_cur = (k); if (TPROBE == (k)) tp_t0 = __builtin_amdgcn_s_memrealtime();
#define TP_PRE() unsigned long long _t1 = 0; if (tp_cur == TPROBE) { asm volatile("s_waitcnt vmcnt(0)" ::: "memory"); __syncthreads(); _t1 = __builtin_amdgcn_s_memrealtime(); \
        if (TPMODE == 0 && threadIdx.x == 0) atomicMax(F.ctl + 80, (unsigned)(_t1 - tp_t0)); }
#define TP_POST() if (tp_cur == TPROBE && TPMODE != 0 && threadIdx.x == 0) { const unsigned d = (unsigned)(__builtin_amdgcn_s_memrealtime() - _t1); atomicMax(F.ctl + 80, TPMODE == 1 ? 0x40000000u - d : d); }
#else
#define TP0(k)
#define TP_PRE()
#define TP_POST()
#endif
#define END_STEP() do { TP_PRE(); if (!N_LAUNCH_SPLIT) { XcdBarrier _b; _b.bar = (unsigned*)launder(F.ws) + CW_BAR; _b.x = xb_xcc_id(); _b.st = F.LC; xcd_barrier(_b); if (BAR_REP) xcd_barrier(_b); } TP_POST(); ++step; } while (0)
#define X (launder(F.out))
#define WSB (launder(F.ws))
#define XS ((bf16*)(WSB + WS_X))
#define MOD ((const float*)(WSB + WS_MOD))
#define H ((bf16*)(WSB + WS_H))
#define PROJ ((bf16*)(WSB + WS_PROJ))
#define A2 ((bf16*)(WSB + WS_A2))

    TP0(0) if (EN(0) && IN_STEP()) { Frame P = fresh(F); REP(15) { p_adaln(P); __syncthreads(); } REP(0) { p_convert(P); } } END_STEP();
    TP0(1) if (EN(1) && IN_STEP()) REP(1) { Frame P = fresh(F); p_rtab(P); row_phase<false, 1, false, true>(P, KIN(I_X), XS, MOD, KIN(I_NORMG), nullptr, 0, KIN(I_MWIN), nullptr, nullptr, nullptr, 0); } END_STEP();

    for (int l = 0; l < DEPTH; ++l) {
        const int lp = l >> 1;
        if ((l & 1) == 0) {
            TP0(2) if (EN(2) && IN_STEP()) REP(2) { pg8::DenseSched S; S.T.init(NTOK / 256, NPROJ / 256, pg8::opaque_s(F.G), pg8::opaque_s((int)blockIdx.x), INPROJ_WGM); S.A = (const char*)H; S.Bt = (const char*)(WSB + WS_WMIN) + (size_t)lp * 3072 * 1024 * 2; S.K = 1024;
                pg8::EpiStoreBf16 E{PROJ, NPROJ, 1.0f}; pg8::gemm_phase<pg8::EpiStoreBf16, pg8::DenseSched, true>(F.lds, 1024, S, E); } END_STEP();
            TP0(3) if (EN(3) && IN_STEP()) REP(3) { Frame P = fresh(F); p_scan_mfma(P, lp, (bf16*)(P.ws + WS_HS));
#ifdef SCAN_SELFCHECK
                { float* H1 = (float*)(P.ws + WS_HMID); float* H2 = (float*)(P.ws + WS_END);
                  __syncthreads(); p_scan_mfma(P, lp, H1); __syncthreads(); p_scan_mfma(P, lp, H2); asm volatile("s_waitcnt vmcnt(0)" ::: "memory"); __syncthreads();
                  for (int item = blockIdx.x; item < 256; item += P.G) { const int b = item >> 5, hd = (item >> 3) & 3, vs = item & 7; int bad = 0;
                      for (int i = P.tid; i < 2048 * 32; i += NTHR) { const size_t o = (size_t)(b * SEQ + (i >> 5)) * D + hd * 256 + vs * 32 + (i & 31);
                          const unsigned a1 = __hip_atomic_load((const unsigned*)H1 + o, __ATOMIC_RELAXED, __HIP_MEMORY_SCOPE_AGENT), a2 = __hip_atomic_load((const unsigned*)H2 + o, __ATOMIC_RELAXED, __HIP_MEMORY_SCOPE_AGENT); if (a1 != a2) bad = 1; }
                      if (bad) __hip_atomic_fetch_or(P.ctl + 64, 1u, __ATOMIC_RELAXED, __HIP_MEMORY_SCOPE_AGENT); } }
#endif
#ifdef SCAN_BOTH
                __syncthreads(); p_scan(P, lp);
#endif
            } END_STEP();
            TP0(4) if (EN(4) && IN_STEP()) REP(4) { Frame P = fresh(F); p_mnorm(P, lp); } END_STEP();
            TP0(5) if (EN(5) && IN_STEP()) REP(5) { pg8::DenseSched S; S.T.init(NTOK / 256, 4, pg8::opaque_s(F.G), pg8::opaque_s((int)blockIdx.x), OUTPROJ_WGM); S.A = (const char*)A2; S.Bt = (const char*)(WSB + WS_WMOUT) + (size_t)lp * 1024 * 1024 * 2; S.K = 1024;
                pg8::EpiResid E{(const float*)nullptr, XS, MOD + (size_t)(l * 2) * 8 * 3072 + 2048, 1.0f}; pg8::gemm_phase<pg8::EpiResid, pg8::DenseSched, true>(F.lds, 1024, S, E); } END_STEP();
        } else {
            TP0(10) if (EN(10) && IN_STEP()) REP(10) { pg8::DenseSched S; S.T.init(NTOK / 256, NPROJ / 256, pg8::opaque_s(F.G), pg8::opaque_s((int)blockIdx.x), INPROJ_WGM); S.A = (const char*)H; S.Bt = (const char*)(WSB + WS_WSIN) + (size_t)lp * 3072 * 1024 * 2; S.K = 1024;
                pg8::EpiConvIn E{PROJ, NPROJ}; pg8::gemm_phase<pg8::EpiConvIn, pg8::DenseSched, true>(F.lds, 1024, S, E); } END_STEP();
            TP0(11) if (EN(11) && IN_STEP()) REP(11) { Frame P = fresh(F); p_conv(P, lp); } END_STEP();
            TP0(12) if (EN(12) && IN_STEP()) REP(12) { pg8::DenseSched S; S.T.init(NTOK / 256, 4, pg8::opaque_s(F.G), pg8::opaque_s((int)blockIdx.x), OUTPROJ_WGM); S.A = (const char*)A2; S.Bt = (const char*)(WSB + WS_WSOUT) + (size_t)lp * 1024 * 1024; S.K = 512;
                pg8::EpiResid E{nullptr, XS, MOD + (size_t)(l * 2) * 8 * 3072 + 2048, pg8::W8_INV / A2C_SC}; pg8::gemm_phase<pg8::EpiResid, pg8::DenseSched, true, true>(F.lds, 512, S, E); } END_STEP();
        }
        TP0(6) if (EN(6) && IN_STEP()) REP(6) { Frame P = fresh(F); row_phase<false, 2, false>(P, XS, nullptr, MOD + (size_t)(l * 2 + 1) * 8 * 3072, KIN(I_NORMG) + (l * 2 + 1) * 1024, nullptr, 0,
                                                  KIN(I_RWG) + (size_t)l * 1024 * 4, KIN(I_RWE) + (size_t)l * 1024 * 32, KIN(I_RBG) + l * 4, KIN(I_RBE) + l * 32, l + 4 * _r); } END_STEP();
        TP0(7) if (EN(7) && IN_STEP()) REP(7) { Frame P = fresh(F); moe_tables(P, l); pg8::GuSched S; S.T.init((int)F.LC[LC_TOFF + 32], 4, pg8::opaque_s(F.G), pg8::opaque_s((int)blockIdx.x), MOE_WGM); S.A = (const char*)H; S.K = 512; S.Bt = (const char*)(WSB + WS_WGU) + (size_t)l * 32 * 1024 * 1024;
            S.slot_tok = (const int*)(WSB + WS_SLOTTOK); S.toff = (const PG8_LAS int*)(F.lds + LDSCTL_OFF + LC_TOFF * 4); S.cnt = (const PG8_LAS int*)(F.lds + LDSCTL_OFF + LC_CNT * 4); S.soff = (const PG8_LAS int*)(F.lds + LDSCTL_OFF + LC_SOFF * 4); S.sexp = (const PG8_LAS int*)(F.lds + LDSCTL_OFF + LC_SEXP * 4);
            pg8::EpiGateUp E{(unsigned char*)(WSB + WS_HMID)}; pg8::gemm_phase<pg8::EpiGateUp, pg8::GuSched, true, true>(F.lds, 512, S, E); } END_STEP();
        TP0(8) if (EN(8) && IN_STEP()) REP(8) { Frame P = fresh(F); if (N_LAUNCH_SPLIT) moe_tables(P, l);        pg8::DnSched S; S.T.init((int)F.LC[LC_TOFF + 32], 4, pg8::opaque_s(F.G), pg8::opaque_s((int)blockIdx.x), MOE_WGM); S.A = (const char*)(WSB + WS_HMID); S.K = 256; S.Bt = (const char*)(WSB + WS_WDN) + (size_t)l * 32 * 1024 * 512;
            S.toff = (const PG8_LAS int*)(F.lds + LDSCTL_OFF + LC_TOFF * 4); S.soff = (const PG8_LAS int*)(F.lds + LDSCTL_OFF + LC_SOFF * 4); S.sexp = (const PG8_LAS int*)(F.lds + LDSCTL_OFF + LC_SEXP * 4);
            pg8::EpiStoreF8 E{(unsigned char*)(WSB + WS_YR), 1024}; pg8::gemm_phase<pg8::EpiStoreF8, pg8::DnSched, true, true>(F.lds, 256, S, E); } END_STEP();
        if (l == 3) {
            TP0(14) if (EN(14) && IN_STEP()) REP(14) { Frame P = fresh(F); row_phase<true, 0, true>(P, XS, X, nullptr, KIN(I_FINALG), MOD + (size_t)(l * 2 + 1) * 8 * 3072, l, nullptr, nullptr, nullptr, nullptr, 0); } ++step;
        } else if (l == 1) {
            TP0(13) if (EN(13) && IN_STEP()) REP(13) { Frame P = fresh(F); row_phase<true, 1, false>(P, XS, XS, MOD + (size_t)((l + 1) * 2) * 8 * 3072, KIN(I_NORMG) + ((l + 1) * 2) * 1024, MOD + (size_t)(l * 2 + 1) * 8 * 3072, l,
                                                     KIN(I_MWIN) + (size_t)1 * 1024 * M_PROJ, nullptr, nullptr, nullptr, 0); } END_STEP();
        } else {
            TP0(9) if (EN(9) && IN_STEP()) REP(9) { Frame P = fresh(F); row_phase<true, 0, false>(P, XS, XS, MOD + (size_t)((l + 1) * 2) * 8 * 3072, KIN(I_NORMG) + ((l + 1) * 2) * 1024, MOD + (size_t)(l * 2 + 1) * 8 * 3072, l, nullptr, nullptr, nullptr, nullptr, 0); } END_STEP();
        }
    }
#if defined(TPROBE) || defined(TPSUB)
#ifndef TPMODE
#define TPMODE 0
#endif
    __syncthreads();
    if (blockIdx.x == 0 && threadIdx.x == 0) { asm volatile("s_waitcnt vmcnt(0)" ::: "memory"); unsigned d = __hip_atomic_load(F.ctl + 80, __ATOMIC_RELAXED, __HIP_MEMORY_SCOPE_AGENT); if (TPMODE == 1) d = 0x40000000u - d;
        F.out[0] = (float)d * (0.01f / (float)(TPSCALE)); }
#endif
#undef IN_STEP
#undef END_STEP
#undef X
#undef WSB
#undef XS
#undef MOD
#undef H
#undef PROJ
#undef A2
}

extern "C" void kernel_launch(void* const* d_in, const int* in_sizes, int n_in, void* d_out, int out_size, void* d_ws, size_t ws_size, hipStream_t stream) {
    static int grid = 0;
    if (grid == 0) {
        if (n_in != 20 || in_sizes[0] != NTOK * D || out_size != NTOK * D || ws_size < WS_END) { fprintf(stderr, "kernel_launch: unexpected shapes (n_in %d, ws %zu)\n", n_in, ws_size); grid = -1; return; }
        int dev = 0, cus = 0, per_cu = 0;
        if (hipGetDevice(&dev) != hipSuccess || hipDeviceGetAttribute(&cus, hipDeviceAttributeMultiprocessorCount, dev) != hipSuccess) { grid = -1; return; }
        if (hipFuncSetAttribute((const void*)trunk_fwd, hipFuncAttributeMaxDynamicSharedMemorySize, LDS_BYTES) != hipSuccess) { fprintf(stderr, "kernel_launch: hipFuncSetAttribute failed\n"); grid = -1; return; }
        if (hipOccupancyMaxActiveBlocksPerMultiprocessor(&per_cu, (const void*)trunk_fwd, NTHR, LDS_BYTES) != hipSuccess || per_cu < 1) fprintf(stderr, "kernel_launch: occupancy query reports %d\n", per_cu);
        (void)hipGetLastError();
        grid = cus;
    }
    if (grid < 0) return;
    if (hipMemsetAsync((char*)d_ws + WS_CTL, 0, CTL_ZERO_BYTES, stream) != hipSuccess) return;
    Args a{};
    for (int i = 0; i < 20; ++i) a.in[i] = (const float*)d_in[i];
    a.out = (float*)d_out; a.ws = (unsigned char*)d_ws;
    if (N_LAUNCH_SPLIT) {
        for (int s = 0; s < N_STEPS; ++s) { a.ph_lo = s; a.ph_hi = s + 1; hipLaunchKernelGGL(trunk_fwd, dim3(grid), dim3(NTHR), LDS_BYTES, stream, a); }
    } else {
        a.ph_lo = 0; a.ph_hi = N_STEPS; hipLaunchKernelGGL(trunk_fwd, dim3(grid), dim3(NTHR), LDS_BYTES, stream, a);
    }
}
```
